# Optimizing an MI355X kernel written in HIP

```python
import math
import jax, jax.numpy as jnp
from jax import lax
import numpy as np

D_MODEL = 1024
BATCH = 1
SEQ = 16384
DEPTH = 1

D_MIX = D_MODEL
ATT_WIDTH = D_MIX // 2
HGRN_WIDTH = D_MIX - ATT_WIDTH
ATT_HEADS = 4
ATT_VDIM = ATT_WIDTH // ATT_HEADS
ATT_QKDIM = ATT_VDIM // 2
HGRN_HEADS = 4
HGRN_VDIM = HGRN_WIDTH // HGRN_HEADS
HGRN_EXPAND = 128
HGRN_FDIM = HGRN_HEADS * HGRN_EXPAND
N_GROUPS = 4
EXPERTS_PER_GROUP = 8
TOP_K = 2
D_EXPERT = 512
ROPE_THETA = 10000.0
NORM_EPS = 1e-6
SUBLN_EPS = 1e-5
Q_BLOCK = 128
CHUNK = 64
IN_COLS = 3 * ATT_WIDTH + 3 * HGRN_FDIM + 2 * HGRN_WIDTH

kernel_name = 'hymba_diffattn_hgrn2_hmoe_encoder'


def rmsnorm(x, g, eps=NORM_EPS):
    xf = x.astype(jnp.float32)
    y = xf * lax.rsqrt(jnp.mean(xf * xf, axis=-1, keepdims=True) + eps)
    return (y * g.astype(jnp.float32)).astype(x.dtype)


def rope_tables(seq, dim):
    inv = ROPE_THETA ** (-jnp.arange(0, dim, 2, dtype=jnp.float32) / dim)
    ang = jnp.arange(seq, dtype=jnp.float32)[:, None] * inv[None, :]
    return jnp.cos(ang), jnp.sin(ang)


def apply_rope(x, cos, sin):
    half = x.shape[-1] // 2
    xf = x.astype(jnp.float32)
    x1, x2 = xf[..., :half], xf[..., half:]
    c = cos[None, :, None, None, :]
    s = sin[None, :, None, None, :]
    return jnp.concatenate([x1 * c - x2 * s, x1 * s + x2 * c], axis=-1).astype(x.dtype)


def diff_attention(qa, ka, va, lam_p, subln_g, lambda_init):
    B, T = qa.shape[0], qa.shape[1]
    q = qa.reshape(B, T, ATT_HEADS, 2, ATT_QKDIM)
    k = ka.reshape(B, T, ATT_HEADS, 2, ATT_QKDIM)
    v = va.reshape(B, T, ATT_HEADS, ATT_VDIM)
    cos, sin = rope_tables(T, ATT_QKDIM)
    q = apply_rope(q, cos, sin)
    k = apply_rope(k, cos, sin)
    lp = lam_p.astype(jnp.float32)
    lam = jnp.exp(jnp.sum(lp[0] * lp[1])) - jnp.exp(jnp.sum(lp[2] * lp[3])) + lambda_init
    scale = ATT_QKDIM ** -0.5
    nb = T // Q_BLOCK
    qb = q.reshape(B, nb, Q_BLOCK, ATT_HEADS, 2, ATT_QKDIM).transpose(1, 0, 2, 3, 4, 5)

    def block(qblk):
        s = jnp.einsum('bqhcd,bkhcd->bhcqk', qblk, k,
                       preferred_element_type=jnp.float32) * scale
        p = jax.nn.softmax(s, axis=-1)
        a = p[:, :, 0] - lam * p[:, :, 1]
        return jnp.einsum('bhqk,bkhv->bqhv', a.astype(v.dtype), v)

    o = lax.map(block, qb)
    o = o.transpose(1, 0, 2, 3, 4).reshape(B, T, ATT_HEADS, ATT_VDIM)
    o = rmsnorm(o, subln_g, SUBLN_EPS) * (1.0 - lambda_init)
    return o.reshape(B, T, ATT_WIDTH)


def gla_chunk_scan(q, k, v, logf):
    B, T, H, K = q.shape
    V = v.shape[-1]
    nc = T // CHUNK

    def to_chunks(a):
        a = a.astype(jnp.float32)
        return a.reshape(B, nc, CHUNK, H, a.shape[-1]).transpose(1, 0, 3, 2, 4)

    mask = jnp.tril(jnp.ones((CHUNK, CHUNK), dtype=bool))

    def step(S, xs):
        qc, kc, vc, gc = xs
        b = jnp.cumsum(gc, axis=2)
        o_inter = jnp.einsum('bhtk,bhkv->bhtv', qc * jnp.exp(b), S)
        diff = b[:, :, :, None, :] - b[:, :, None, :, :]
        decay = jnp.exp(jnp.where(mask[:, :, None], diff, -jnp.inf))
        A = jnp.einsum('bhtk,bhsk,bhtsk->bhts', qc, kc, decay)
        o = o_inter + jnp.einsum('bhts,bhsv->bhtv', A, vc)
        b_last = b[:, :, -1:, :]
        S = jnp.exp(b_last[:, :, 0, :])[..., None] * S + jnp.einsum(
            'bhsk,bhsv->bhkv', kc * jnp.exp(b_last - b), vc)
        return S, o

    S0 = jnp.zeros((B, H, K, V), jnp.float32)
    xs = (to_chunks(q), to_chunks(k), to_chunks(v), to_chunks(logf))
    _, o = lax.scan(step, S0, xs)
    return o.transpose(1, 0, 3, 2, 4).reshape(B, T, H, V)


def hgrn2_bidir(hq, hf_f, hf_b, hi, hg, lb_logits, layer_idx, gnorm_g):
    B, T = hq.shape[0], hq.shape[1]
    lb = jnp.cumsum(jax.nn.softmax(lb_logits.astype(jnp.float32), axis=1), axis=1)[:, layer_idx]
    q = jax.nn.silu(hq.astype(jnp.float32)).reshape(B, T, HGRN_HEADS, HGRN_EXPAND)
    v = hi.reshape(B, T, HGRN_HEADS, HGRN_VDIM)

    def gates(z, lbd):
        z = z.astype(jnp.float32)
        f = lbd + (1.0 - lbd) * jax.nn.sigmoid(z)
        k = (1.0 - lbd) * jax.nn.sigmoid(-z)
        shp = (B, T, HGRN_HEADS, HGRN_EXPAND)
        return k.reshape(shp), jnp.log(f).reshape(shp)

    k_f, g_f = gates(hf_f, lb[0])
    k_b, g_b = gates(hf_b, lb[1])
    o_f = gla_chunk_scan(q, k_f, v, g_f)
    flip = lambda a: jnp.flip(a, axis=1)
    o_b = flip(gla_chunk_scan(flip(q), flip(k_b), flip(v), flip(g_b)))
    o = (o_f + o_b).astype(hi.dtype)
    gate = jax.nn.silu(hg.reshape(B, T, HGRN_HEADS, HGRN_VDIM))
    o = rmsnorm(o, gnorm_g) * gate
    return o.reshape(B, T, HGRN_WIDTH)


def hier_moe(h, w_gr, b_gr, w_er, b_er, w_gate, w_up, w_down):
    B, T, D = h.shape
    xt = h.reshape(B * T, D)
    g_prob = jax.nn.softmax(jnp.dot(xt, w_gr).astype(jnp.float32) + b_gr.astype(jnp.float32), axis=-1)
    p_top, g_top = lax.top_k(g_prob, 1)
    p_g, g_idx = p_top[:, 0], g_top[:, 0]
    e_logits = jnp.einsum('nd,gde->nge', xt, w_er).astype(jnp.float32) + b_er.astype(jnp.float32)
    e_sel = jnp.take_along_axis(e_logits, g_idx[:, None, None], axis=1)[:, 0]
    e_prob = jax.nn.softmax(e_sel, axis=-1)
    top_w, top_i = lax.top_k(e_prob, TOP_K)
    top_w = top_w / jnp.sum(top_w, axis=-1, keepdims=True)
    w_e = jnp.sum(jax.nn.one_hot(top_i, EXPERTS_PER_GROUP, dtype=jnp.float32) * top_w[..., None], axis=1)
    combine = (jax.nn.one_hot(g_idx, N_GROUPS, dtype=jnp.float32)[:, :, None]
               * w_e[:, None, :] * p_g[:, None, None]).astype(xt.dtype)
    y = jnp.zeros_like(xt)
    for gi in range(N_GROUPS):
        a = jnp.einsum('nd,edf->nef', xt, w_gate[gi])
        u = jnp.einsum('nd,edf->nef', xt, w_up[gi])
        hid = jax.nn.silu(a) * u * combine[:, gi, :, None]
        y = y + jnp.einsum('nef,efd->nd', hid, w_down[gi])
    return y.reshape(B, T, D)


def setup_inputs(seed: int = 0) -> dict:
    key = jax.random.key(seed)
    ks = jax.random.split(key, 20)
    f32 = jnp.float32
    nrm = lambda k, shp, s: jax.random.normal(k, shp, f32) * s
    L, D, G, E, F = DEPTH, D_MODEL, N_GROUPS, EXPERTS_PER_GROUP, D_EXPERT
    return {
        'x': nrm(ks[0], (BATCH, SEQ, D), 1.0),
        'w_in': nrm(ks[1], (L, D, IN_COLS), D ** -0.5),
        'w_out': nrm(ks[2], (L, D_MIX, D), D_MIX ** -0.5),
        'g_mix': 1.0 + nrm(ks[3], (L, D), 0.02),
        'lam_params': nrm(ks[4], (L, 4, ATT_QKDIM), 0.1),
        'subln_g': 1.0 + nrm(ks[5], (L, ATT_VDIM), 0.02),
        'hgrn_gnorm_g': 1.0 + nrm(ks[6], (L, HGRN_VDIM), 0.02),
        'hgrn_lb': nrm(ks[7], (2, L + 1, HGRN_FDIM), 0.1),
        'g_ffn': 1.0 + nrm(ks[8], (L, D), 0.02),
        'w_gr': nrm(ks[9], (L, D, G), D ** -0.5),
        'b_gr': nrm(ks[10], (L, G), 0.01),
        'w_er': nrm(ks[11], (L, G, D, E), D ** -0.5),
        'b_er': nrm(ks[12], (L, G, E), 0.01),
        'w_gate': nrm(ks[13], (L, G, E, D, F), D ** -0.5),
        'w_up': nrm(ks[14], (L, G, E, D, F), D ** -0.5),
        'w_down': nrm(ks[15], (L, G, E, F, D), F ** -0.5),
        'g_final': 1.0 + nrm(ks[16], (D,), 0.02),
    }


def reference(x, w_in, w_out, g_mix, lam_params, subln_g, hgrn_gnorm_g, hgrn_lb, g_ffn,
              w_gr, b_gr, w_er, b_er, w_gate, w_up, w_down, g_final):
    widths = [ATT_WIDTH, ATT_WIDTH, ATT_WIDTH, HGRN_FDIM, HGRN_FDIM, HGRN_FDIM, HGRN_WIDTH, HGRN_WIDTH]
    splits = [int(s) for s in np.cumsum(widths)[:-1]]
    h_res = x
    for l in range(DEPTH):
        h = rmsnorm(h_res, g_mix[l])
        proj = jnp.dot(h, w_in[l])
        qa, ka, va, hq, hf_f, hf_b, hi, hg = jnp.split(proj, splits, axis=-1)
        lambda_init = 0.8 - 0.6 * math.exp(-0.3 * l)
        att = diff_attention(qa, ka, va, lam_params[l], subln_g[l], lambda_init)
        rec = hgrn2_bidir(hq, hf_f, hf_b, hi, hg, hgrn_lb, l, hgrn_gnorm_g[l])
        mix = jnp.dot(jnp.concatenate([att, rec], axis=-1), w_out[l])
        h_res = h_res + mix
        h_res = h_res + hier_moe(rmsnorm(h_res, g_ffn[l]), w_gr[l], b_gr[l], w_er[l], b_er[l],
                                 w_gate[l], w_up[l], w_down[l])
    return rmsnorm(h_res, g_final)
```

```cpp
#include <hip/hip_runtime.h>
#include <cstdio>
#include <cstdint>
#include <cmath>
namespace nv {
constexpr int T = 16384, DM = 1024, NCOL = 4096, NE = 32, FE = 512;

__device__ __forceinline__ float wsum(float v) {
#pragma unroll
  for (int o = 1; o < 64; o <<= 1) v += __shfl_xor(v, o);
  return v;
}
__device__ __forceinline__ float sigm(float z) { return 1.f / (1.f + expf(-z)); }
__device__ __forceinline__ float silu(float z) { return z / (1.f + expf(-z)); }

__global__ void k_rstd(const float* __restrict__ x, float* __restrict__ rstd, float eps) {
  const int row = blockIdx.x * 4 + (threadIdx.x >> 6), lane = threadIdx.x & 63;
  const float4* xr = (const float4*)(x + (size_t)row * DM);
  float s = 0.f;
#pragma unroll
  for (int j = 0; j < 4; ++j) { float4 v = xr[lane + 64 * j]; s += v.x * v.x + v.y * v.y + v.z * v.z + v.w * v.w; }
  s = wsum(s);
  if (lane == 0) rstd[row] = 1.f / sqrtf(s * (1.f / DM) + eps);
}
__global__ void k_rmsnorm(const float* x, const float* __restrict__ g, float* out, float eps) {
  const int row = blockIdx.x * 4 + (threadIdx.x >> 6), lane = threadIdx.x & 63;
  const float4* xr = (const float4*)(x + (size_t)row * DM);
  float4 v[4]; float s = 0.f;
#pragma unroll
  for (int j = 0; j < 4; ++j) { v[j] = xr[lane + 64 * j]; s += v[j].x * v[j].x + v[j].y * v[j].y + v[j].z * v[j].z + v[j].w * v[j].w; }
  s = wsum(s);
  const float r = 1.f / sqrtf(s * (1.f / DM) + eps);
  float4* o = (float4*)(out + (size_t)row * DM);
#pragma unroll
  for (int j = 0; j < 4; ++j) { float4 gg = ((const float4*)g)[lane + 64 * j]; float4 w; w.x = v[j].x * r * gg.x; w.y = v[j].y * r * gg.y; w.z = v[j].z * r * gg.z; w.w = v[j].w * r * gg.w; o[lane + 64 * j] = w; }
}

struct GemmArgs {
  const float* A; int lda;
  const float* B; int ldb;
  float* C; int ldc;
  int M, N, K;
  const float* rscale;
  const float* kscale;
  const float* resid; int ldr;
  const int* list; const int* cnt;
  const int* off;
  const float* B2;
  const float* cw;
  size_t bstride;
  float* out2; const float* hres;
  int mode;
  int pass;
};

__global__ void __launch_bounds__(256) k_gemm(GemmArgs g) {
  __shared__ float As[16][65];
  __shared__ float Bs[16][64];
  __shared__ float Bs2[16][64];
  const int tid = threadIdx.x, tx = tid & 15, ty = tid >> 4;
  const int z = blockIdx.z;
  int M = g.M; const float* Bp = g.B; const float* Bp2 = g.B2;
  int slot0 = 0; const int* lst = nullptr;
  if (g.mode == 2 && (z & 1) != g.pass) return;
  if (g.mode != 0) { M = g.cnt[z]; slot0 = g.off[z]; lst = g.list + (size_t)z * T; const int e = z >> 1; Bp = g.B + (size_t)e * g.bstride; if (Bp2) Bp2 = g.B2 + (size_t)e * g.bstride; }
  const int m0 = blockIdx.y * 64, n0 = blockIdx.x * 64;
  if (m0 >= M) return;
  const int ar = tid >> 2, ak = (tid & 3) * 4;
  int am = m0 + ar; const bool aval = am < M; if (!aval) am = M - 1;
  size_t arow;
  if (g.mode == 1) arow = (size_t)lst[am]; else if (g.mode == 2) arow = (size_t)(slot0 + am); else arow = (size_t)am;
  const float* Ap = g.A + arow * g.lda;
  const float rs = g.rscale ? g.rscale[arow] : 1.f;
  const int br = tid >> 4, bc = (tid & 15) * 4;
  float acc[4][4] = {}, acc2[4][4] = {};
  for (int k0 = 0; k0 < g.K; k0 += 16) {
    float4 a = *(const float4*)(Ap + k0 + ak);
    if (g.kscale) { float4 ks = *(const float4*)(g.kscale + k0 + ak); a.x *= ks.x; a.y *= ks.y; a.z *= ks.z; a.w *= ks.w; }
    a.x *= rs; a.y *= rs; a.z *= rs; a.w *= rs;
    float4 b = *(const float4*)(Bp + (size_t)(k0 + br) * g.ldb + n0 + bc);
    float4 b2; if (Bp2) b2 = *(const float4*)(Bp2 + (size_t)(k0 + br) * g.ldb + n0 + bc);
    __syncthreads();
    As[ak + 0][ar] = a.x; As[ak + 1][ar] = a.y; As[ak + 2][ar] = a.z; As[ak + 3][ar] = a.w;
    *(float4*)&Bs[br][bc] = b; if (Bp2) *(float4*)&Bs2[br][bc] = b2;
    __syncthreads();
#pragma unroll
    for (int kk = 0; kk < 16; ++kk) {
      float av[4], bv[4];
#pragma unroll
      for (int i = 0; i < 4; ++i) av[i] = As[kk][ty * 4 + i];
#pragma unroll
      for (int j = 0; j < 4; ++j) bv[j] = Bs[kk][tx * 4 + j];
#pragma unroll
      for (int i = 0; i < 4; ++i)
#pragma unroll
        for (int j = 0; j < 4; ++j) acc[i][j] += av[i] * bv[j];
      if (Bp2) {
#pragma unroll
        for (int j = 0; j < 4; ++j) bv[j] = Bs2[kk][tx * 4 + j];
#pragma unroll
        for (int i = 0; i < 4; ++i)
#pragma unroll
          for (int j = 0; j < 4; ++j) acc2[i][j] += av[i] * bv[j];
      }
    }
  }
#pragma unroll
  for (int i = 0; i < 4; ++i) {
    const int m = m0 + ty * 4 + i; if (m >= M) continue;
#pragma unroll
    for (int j = 0; j < 4; ++j) {
      const int n = n0 + tx * 4 + j;
      if (g.mode == 0) { float v = acc[i][j]; if (g.resid) v += g.resid[(size_t)m * g.ldr + n]; g.C[(size_t)m * g.ldc + n] = v; }
      else if (g.mode == 1) { const int slot = slot0 + m; const float a = acc[i][j], u = acc2[i][j]; g.C[(size_t)slot * g.ldc + n] = silu(a) * u * g.cw[slot]; }
      else { const int tok = lst[m]; const size_t o = (size_t)tok * DM + n; g.out2[o] = (g.pass == 0 ? g.hres[o] : g.out2[o]) + acc[i][j]; }
    }
  }
}

__global__ void k_rope(float* P, int ldp) {
  const int idx = blockIdx.x * 256 + threadIdx.x;
  const int j = idx & 31, hc = (idx >> 5) & 7, qk = (idx >> 8) & 1, t = idx >> 9;
  const float inv = powf(10000.0f, -(float)(2 * j) / 64.0f);
  const float ang = (float)t * inv;
  const double a = (double)ang;
  const float c = (float)cos(a), s = (float)sin(a);
  float* p = P + (size_t)t * ldp + qk * 512 + hc * 64;
  const float x1 = p[j], x2 = p[j + 32];
  p[j] = x1 * c - x2 * s; p[j + 32] = x1 * s + x2 * c;
}

__global__ void __launch_bounds__(256) k_attn(const float* __restrict__ P, int ldp, float* __restrict__ Oc) {
  __shared__ float Ks[32][64];
  __shared__ float Vs[32][128];
  const int hc = blockIdx.y, h = hc >> 1, c = hc & 1, tid = threadIdx.x;
  const int qrow = blockIdx.x * 256 + tid;
  float q[64];
  { const float* qp = P + (size_t)qrow * ldp + h * 128 + c * 64;
#pragma unroll
    for (int d = 0; d < 64; d += 4) { float4 v = *(const float4*)(qp + d); q[d] = v.x * 0.125f; q[d + 1] = v.y * 0.125f; q[d + 2] = v.z * 0.125f; q[d + 3] = v.w * 0.125f; } }
  float o[128];
#pragma unroll
  for (int v = 0; v < 128; ++v) o[v] = 0.f;
  float m = -1e30f, l = 0.f;
  for (int k0 = 0; k0 < T; k0 += 32) {
    __syncthreads();
    {
      const int r = tid >> 3, cc = (tid & 7) * 8;
      const float* kp = P + (size_t)(k0 + r) * ldp + 512 + h * 128 + c * 64 + cc;
      *(float4*)&Ks[r][cc] = *(const float4*)kp; *(float4*)&Ks[r][cc + 4] = *(const float4*)(kp + 4);
      const int cv = (tid & 7) * 16;
      const float* vp = P + (size_t)(k0 + r) * ldp + 1024 + h * 128 + cv;
#pragma unroll
      for (int u = 0; u < 4; ++u) *(float4*)&Vs[r][cv + 4 * u] = *(const float4*)(vp + 4 * u);
    }
    __syncthreads();
    float s[32]; float tm = -1e30f;
#pragma unroll
    for (int j = 0; j < 32; ++j) { float a = 0.f;
#pragma unroll
      for (int d = 0; d < 64; ++d) a += q[d] * Ks[j][d];
      s[j] = a; tm = fmaxf(tm, a); }
    if (tm > m) { const float al = expf(m - tm); l *= al;
#pragma unroll
      for (int v = 0; v < 128; ++v) o[v] *= al;
      m = tm; }
#pragma unroll
    for (int j = 0; j < 32; ++j) { const float p = expf(s[j] - m); l += p;
#pragma unroll
      for (int v = 0; v < 128; ++v) o[v] += p * Vs[j][v]; }
  }
  const float il = 1.f / l;
  float* op = Oc + ((size_t)hc * T + qrow) * 128;
#pragma unroll
  for (int v = 0; v < 128; v += 4) { float4 w; w.x = o[v] * il; w.y = o[v + 1] * il; w.z = o[v + 2] * il; w.w = o[v + 3] * il; *(float4*)(op + v) = w; }
}

__global__ void k_attcomb(const float* __restrict__ Oc, const float* __restrict__ lamp, const float* __restrict__ sg, float* __restrict__ mix) {
  const int w = blockIdx.x * 4 + (threadIdx.x >> 6), lane = threadIdx.x & 63;
  const int t = w >> 2, h = w & 3;
  float d1 = lamp[lane] * lamp[64 + lane], d2 = lamp[128 + lane] * lamp[192 + lane];
  d1 = wsum(d1); d2 = wsum(d2);
  const float lam = expf(d1) - expf(d2) + 0.2f;
  const float* o1 = Oc + ((size_t)(2 * h) * T + t) * 128; const float* o2 = Oc + ((size_t)(2 * h + 1) * T + t) * 128;
  const float a0 = o1[lane] - lam * o2[lane], a1 = o1[lane + 64] - lam * o2[lane + 64];
  const float ss = wsum(a0 * a0 + a1 * a1);
  const float r = 1.f / sqrtf(ss * (1.f / 128.f) + 1e-5f) * 0.8f;
  float* mp = mix + (size_t)t * DM + h * 128;
  mp[lane] = a0 * r * sg[lane]; mp[lane + 64] = a1 * r * sg[lane + 64];
}

__global__ void __launch_bounds__(128) k_hgrn(const float* __restrict__ P2, int ldp, const float* __restrict__ lbl, float* __restrict__ od) {
  __shared__ float qs[16][128], fs[16][128], ks[16][128];
  const int h = blockIdx.x & 3, dir = blockIdx.x >> 2, v = threadIdx.x;
  const float a0 = lbl[(dir * 2 + 0) * 512 + h * 128 + v], a1 = lbl[(dir * 2 + 1) * 512 + h * 128 + v];
  const float mx = fmaxf(a0, a1); const float e0 = expf(a0 - mx), e1 = expf(a1 - mx);
  const float lb = e0 / (e0 + e1);
  float S[128];
#pragma unroll
  for (int k = 0; k < 128; ++k) S[k] = 0.f;
  float* op = od + ((size_t)(dir * 4 + h) * T) * 128;
  for (int c0 = 0; c0 < T; c0 += 16) {
    __syncthreads();
#pragma unroll 4
    for (int i = 0; i < 16; ++i) { const int t = dir == 0 ? (c0 + i) : (T - 1 - (c0 + i));
      const float* row = P2 + (size_t)t * ldp;
      const float z = row[512 + dir * 512 + h * 128 + v];
      const float sg = sigm(z);
      fs[i][v] = lb + (1.f - lb) * sg; ks[i][v] = (1.f - lb) * sigm(-z); qs[i][v] = silu(row[h * 128 + v]); }
    __syncthreads();
    for (int i = 0; i < 16; ++i) { const int t = dir == 0 ? (c0 + i) : (T - 1 - (c0 + i));
      const float vv = P2[(size_t)t * ldp + 1536 + h * 128 + v];
      float o = 0.f;
#pragma unroll
      for (int k = 0; k < 128; ++k) { S[k] = fs[i][k] * S[k] + ks[i][k] * vv; o += qs[i][k] * S[k]; }
      op[(size_t)t * 128 + v] = o; }
  }
}
__global__ void k_reccomb(const float* __restrict__ od, const float* __restrict__ P2, int ldp, const float* __restrict__ gg, float* __restrict__ mix) {
  const int w = blockIdx.x * 4 + (threadIdx.x >> 6), lane = threadIdx.x & 63;
  const int t = w >> 2, h = w & 3;
  const float* f = od + ((size_t)h * T + t) * 128; const float* b = od + ((size_t)(4 + h) * T + t) * 128;
  const float a0 = f[lane] + b[lane], a1 = f[lane + 64] + b[lane + 64];
  const float ss = wsum(a0 * a0 + a1 * a1);
  const float r = 1.f / sqrtf(ss * (1.f / 128.f) + 1e-6f);
  const float* hg = P2 + (size_t)t * ldp + 2048 + h * 128;
  float* mp = mix + (size_t)t * DM + 512 + h * 128;
  mp[lane] = a0 * r * gg[lane] * silu(hg[lane]); mp[lane + 64] = a1 * r * gg[lane + 64] * silu(hg[lane + 64]);
}

__global__ void k_router(const float* __restrict__ xt, const float* __restrict__ wgr, const float* __restrict__ bgr, const float* __restrict__ wer, const float* __restrict__ ber,
                         int* __restrict__ cnt, int* __restrict__ list, int* __restrict__ tpos, float* __restrict__ tcw) {
  const int tok = blockIdx.x * 4 + (threadIdx.x >> 6), lane = threadIdx.x & 63;
  const float* xr = xt + (size_t)tok * DM;
  float gl[4] = {0.f, 0.f, 0.f, 0.f};
  for (int k = lane; k < DM; k += 64) { const float x = xr[k]; const float4 w = *(const float4*)(wgr + (size_t)k * 4); gl[0] += x * w.x; gl[1] += x * w.y; gl[2] += x * w.z; gl[3] += x * w.w; }
#pragma unroll
  for (int i = 0; i < 4; ++i) gl[i] = wsum(gl[i]) + bgr[i];
  int gi = 0; float gm = gl[0];
#pragma unroll
  for (int i = 1; i < 4; ++i) if (gl[i] > gm) { gm = gl[i]; gi = i; }
  float den = 0.f;
#pragma unroll
  for (int i = 0; i < 4; ++i) den += expf(gl[i] - gm);
  const float pg = 1.f / den;
  float el[8] = {0.f, 0.f, 0.f, 0.f, 0.f, 0.f, 0.f, 0.f};
  const float* we = wer + (size_t)gi * DM * 8;
  for (int k = lane; k < DM; k += 64) { const float x = xr[k]; const float4 w0 = *(const float4*)(we + (size_t)k * 8), w1 = *(const float4*)(we + (size_t)k * 8 + 4);
    el[0] += x * w0.x; el[1] += x * w0.y; el[2] += x * w0.z; el[3] += x * w0.w; el[4] += x * w1.x; el[5] += x * w1.y; el[6] += x * w1.z; el[7] += x * w1.w; }
#pragma unroll
  for (int i = 0; i < 8; ++i) el[i] = wsum(el[i]) + ber[gi * 8 + i];
  int i1 = 0; float m1 = el[0];
#pragma unroll
  for (int i = 1; i < 8; ++i) if (el[i] > m1) { m1 = el[i]; i1 = i; }
  int i2 = -1; float m2 = -1e30f;
#pragma unroll
  for (int i = 0; i < 8; ++i) if (i != i1 && el[i] > m2) { m2 = el[i]; i2 = i; }
  const float e2 = expf(m2 - m1); const float w1 = 1.f / (1.f + e2), w2 = e2 / (1.f + e2);
  if (lane == 0) {
    const int z1 = (gi * 8 + i1) * 2 + 0, z2 = (gi * 8 + i2) * 2 + 1;
    const int p1 = atomicAdd(&cnt[z1], 1), p2 = atomicAdd(&cnt[z2], 1);
    list[(size_t)z1 * T + p1] = tok; list[(size_t)z2 * T + p2] = tok;
    tpos[tok * 4 + 0] = z1; tpos[tok * 4 + 1] = p1; tpos[tok * 4 + 2] = z2; tpos[tok * 4 + 3] = p2;
    tcw[tok * 2 + 0] = w1 * pg; tcw[tok * 2 + 1] = w2 * pg;
  }
}
__global__ void k_offsets(const int* __restrict__ cnt, int* __restrict__ off) {
  if (threadIdx.x == 0) { int s = 0; for (int z = 0; z < 64; ++z) { off[z] = s; s += cnt[z]; } }
}
__global__ void k_slotcw(const int* __restrict__ tpos, const float* __restrict__ tcw, const int* __restrict__ off, float* __restrict__ cw) {
  const int tok = blockIdx.x * 256 + threadIdx.x;
  cw[off[tpos[tok * 4 + 0]] + tpos[tok * 4 + 1]] = tcw[tok * 2 + 0];
  cw[off[tpos[tok * 4 + 2]] + tpos[tok * 4 + 3]] = tcw[tok * 2 + 1];
}

inline void run(void* const* d_in, float* out, unsigned char* ws, hipStream_t st) {
  const float* x = (const float*)d_in[0]; const float* w_in = (const float*)d_in[1]; const float* w_out = (const float*)d_in[2];
  const float* g_mix = (const float*)d_in[3]; const float* lamp = (const float*)d_in[4]; const float* subln = (const float*)d_in[5];
  const float* gnorm = (const float*)d_in[6]; const float* lbl = (const float*)d_in[7]; const float* g_ffn = (const float*)d_in[8];
  const float* w_gr = (const float*)d_in[9]; const float* b_gr = (const float*)d_in[10]; const float* w_er = (const float*)d_in[11]; const float* b_er = (const float*)d_in[12];
  const float* w_gate = (const float*)d_in[13]; const float* w_up = (const float*)d_in[14]; const float* w_down = (const float*)d_in[15]; const float* g_final = (const float*)d_in[16];
  const size_t MiB = 1u << 20;
  float* rstd = (float*)(ws);
  int* cnt = (int*)(ws + 128 * 1024);
  int* off = cnt + 64;
  int* tpos = (int*)(ws + 256 * 1024);
  float* tcw = (float*)(ws + 512 * 1024);
  float* cw = (float*)(ws + 640 * 1024);
  int* list = (int*)(ws + 1 * MiB);
  float* P = (float*)(ws + 8 * MiB);
  float* mix = (float*)(ws + 168 * MiB);
  float* scratch = out;
  k_rstd<<<T / 4, 256, 0, st>>>(x, rstd, 1e-6f);
  { GemmArgs g{}; g.A = x; g.lda = DM; g.B = w_in; g.ldb = NCOL; g.C = P; g.ldc = 1536; g.M = T; g.N = 1536; g.K = DM; g.rscale = rstd; g.kscale = g_mix; g.mode = 0;
    k_gemm<<<dim3(1536 / 64, T / 64, 1), 256, 0, st>>>(g); }
  k_rope<<<T * 2 * 8 * 32 / 256, 256, 0, st>>>(P, 1536);
  k_attn<<<dim3(T / 256, 8), 256, 0, st>>>(P, 1536, scratch);
  k_attcomb<<<T * 4 / 4, 256, 0, st>>>(scratch, lamp, subln, mix);
  { GemmArgs g{}; g.A = x; g.lda = DM; g.B = w_in + 1536; g.ldb = NCOL; g.C = P; g.ldc = 2560; g.M = T; g.N = 2560; g.K = DM; g.rscale = rstd; g.kscale = g_mix; g.mode = 0;
    k_gemm<<<dim3(2560 / 64, T / 64, 1), 256, 0, st>>>(g); }
  k_hgrn<<<8, 128, 0, st>>>(P, 2560, lbl, scratch);
  k_reccomb<<<T * 4 / 4, 256, 0, st>>>(scratch, P, 2560, gnorm, mix);
  { GemmArgs g{}; g.A = mix; g.lda = DM; g.B = w_out; g.ldb = DM; g.C = out; g.ldc = DM; g.M = T; g.N = DM; g.K = DM; g.resid = x; g.ldr = DM; g.mode = 0;
    k_gemm<<<dim3(DM / 64, T / 64, 1), 256, 0, st>>>(g); }
  float* xt = P;
  float* hid = P + (size_t)T * DM;
  k_rmsnorm<<<T / 4, 256, 0, st>>>(out, g_ffn, xt, 1e-6f);
  hipMemsetAsync(cnt, 0, 64 * sizeof(int), st);
  k_router<<<T / 4, 256, 0, st>>>(xt, w_gr, b_gr, w_er, b_er, cnt, list, tpos, tcw);
  k_offsets<<<1, 64, 0, st>>>(cnt, off);
  k_slotcw<<<T / 256, 256, 0, st>>>(tpos, tcw, off, cw);
  { GemmArgs g{}; g.A = xt; g.lda = DM; g.B = w_gate; g.B2 = w_up; g.ldb = FE; g.bstride = (size_t)DM * FE; g.C = hid; g.ldc = FE; g.N = FE; g.K = DM; g.list = list; g.cnt = cnt; g.off = off; g.cw = cw; g.mode = 1;
    k_gemm<<<dim3(FE / 64, T / 64, 64), 256, 0, st>>>(g); }
  for (int pass = 0; pass < 2; ++pass) {
    GemmArgs g{}; g.A = hid; g.lda = FE; g.B = w_down; g.ldb = DM; g.bstride = (size_t)FE * DM; g.N = DM; g.K = FE; g.list = list; g.cnt = cnt; g.off = off; g.mode = 2; g.out2 = out; g.hres = out; g.pass = pass;
    k_gemm<<<dim3(DM / 64, T / 64, 64), 256, 0, st>>>(g);
  }
  k_rmsnorm<<<T / 4, 256, 0, st>>>(out, g_final, out, 1e-6f);
}
}
extern "C" void kernel_launch(void* const* d_in, const int* in_sizes, int n_in, void* d_out, int out_size, void* d_ws, size_t ws_size, hipStream_t stream) {
  if (n_in != 17 || out_size != nv::T * nv::DM || ws_size < (size_t)232 * 1024 * 1024) { fprintf(stderr, "kernel_launch: unexpected shapes n_in %d out %d ws %zu\n", n_in, out_size, ws_size); return; }
  nv::run(d_in, (float*)d_out, (unsigned char*)d_ws, stream);
}
```

```cpp
#define MK_STAGE 5
#include <hip/hip_runtime.h>
#include <cstdio>
#include <cstdint>
#include <cmath>
namespace mk {
#define LAS __attribute__((address_space(3)))
#define GAS __attribute__((address_space(1)))
typedef unsigned short bf16_t;
typedef short bf16x8 __attribute__((ext_vector_type(8)));
typedef short s16x4 __attribute__((ext_vector_type(4)));
typedef float f32x4 __attribute__((ext_vector_type(4)));
typedef float f32x2 __attribute__((ext_vector_type(2)));
typedef float f32x16 __attribute__((ext_vector_type(16)));
typedef unsigned u32x4 __attribute__((ext_vector_type(4)));
typedef unsigned u32x2 __attribute__((ext_vector_type(2)));
typedef GAS unsigned gu32;

constexpr int T = 16384, DM = 1024, NCOL = 4096, NEXP = 32, FE = 512;
constexpr int NWAVES = 8, NTHR = 512;
constexpr float LOG2E = 1.4426950408889634f;

__device__ __forceinline__ unsigned cvt_pk_bf16(float lo, float hi) { unsigned r; asm volatile("v_cvt_pk_bf16_f32 %0, %1, %2" : "=v"(r) : "v"(lo), "v"(hi)); return r; }
__device__ __forceinline__ float bf2f(unsigned short h) { return __uint_as_float((unsigned)h << 16); }
__device__ __forceinline__ float bflo(unsigned w) { return __uint_as_float(w << 16); }
__device__ __forceinline__ float bfhi(unsigned w) { return __uint_as_float(w & 0xffff0000u); }
__device__ __forceinline__ float wave_sum(float v) {
#pragma unroll
  for (int o = 1; o < 64; o <<= 1) v += __shfl_xor(v, o);
  return v;
}
__device__ __forceinline__ float fsigm(float z) { return 1.f / (1.f + __expf(-z)); }
__device__ __forceinline__ float fsilu(float z) { return z / (1.f + __expf(-z)); }
#define LDS_WAIT() asm volatile("s_waitcnt lgkmcnt(0)" ::: "memory")
#define VM_WAIT() asm volatile("s_waitcnt vmcnt(0)" ::: "memory")

#define XB_TMO      128
#define XB_XCNT(j)  (256  + 64 * (j))
#define XB_XSUB(j)  (1280 + 64 * (j))
#define XB_XGEN(j)  (2304 + 64 * (j))
#define XB_TOP      3328
#define XB_TOPGEN   3392
#define XCD_BAR_WORDS 3456
#define XB_SPIN_CAP (1u << 22)
__device__ __forceinline__ unsigned xb_ld(unsigned* p)              { return __hip_atomic_load(p, __ATOMIC_RELAXED, __HIP_MEMORY_SCOPE_AGENT); }
__device__ __forceinline__ unsigned xb_add(unsigned* p, unsigned v) { return __hip_atomic_fetch_add(p, v, __ATOMIC_RELAXED, __HIP_MEMORY_SCOPE_AGENT); }
__device__ __forceinline__ unsigned xb_xcc_id() { return (unsigned)__builtin_amdgcn_s_getreg((3 << 11) | 20) & 0xFu; }
#define XB_SPIN(cond, bar) do { unsigned _sp = 0; while (cond) { __builtin_amdgcn_s_sleep(1); \
    if ((++_sp & 255u) == 0u) { if (xb_ld(&(bar)[XB_TMO])) break; if (_sp > XB_SPIN_CAP) { atomicAdd(&(bar)[XB_TMO], 1u); break; } } } } while (0)
struct XcdBarrier { unsigned* bar; unsigned x; volatile LAS unsigned* st; };
__device__ __forceinline__ XcdBarrier xcd_barrier_post(unsigned* bar, volatile LAS unsigned* st) {
  XcdBarrier b; b.bar = bar; b.x = xb_xcc_id(); b.st = st;
  if (threadIdx.x == 0) (void)xb_add(&bar[XB_XCNT(b.x)], 1u);
  return b;
}
__device__ __forceinline__ void xcd_barrier_complete(unsigned* bar, unsigned x, unsigned& nloc, unsigned& nx) {
  const unsigned G = gridDim.x * gridDim.y * gridDim.z;
  unsigned sum, cnt, mine, sp = 0u;
  for (;;) {
    sum = 0u; cnt = 0u; mine = 0u;
#pragma unroll
    for (unsigned j = 0; j < 16; ++j) { const unsigned c = xb_ld(&bar[XB_XCNT(j)]); sum += c; cnt += (c > 0u) ? 1u : 0u; mine = (j == x) ? c : mine; }
    if (sum == G) break;
    __builtin_amdgcn_s_sleep(1);
    if ((++sp & 255u) == 0u) { if (xb_ld(&bar[XB_TMO])) break; if (sp > XB_SPIN_CAP) { atomicAdd(&bar[XB_TMO], 1u); break; } }
  }
  nloc = mine > 0u ? mine : 1u; nx = cnt > 0u ? cnt : 1u;
}
__device__ __forceinline__ void xcd_barrier(const XcdBarrier& b) {
  asm volatile("s_waitcnt vmcnt(0)" ::: "memory");
  __syncthreads();
  if (threadIdx.x == 0) {
    unsigned* bar = b.bar;
    __builtin_amdgcn_s_waitcnt(0);
    unsigned nloc = b.st[0], nx = b.st[1];
    if (nloc == 0u) { xcd_barrier_complete(bar, b.x, nloc, nx); b.st[0] = nloc; b.st[1] = nx; }
    const unsigned old = xb_add(&bar[XB_XSUB(b.x)], 1u);
    const unsigned gen = old / nloc;
    if (old + 1u == (gen + 1u) * nloc) {
      __builtin_amdgcn_fence(__ATOMIC_RELEASE, "agent");
      asm volatile("s_waitcnt vmcnt(0)" ::: "memory");
      const unsigned og = xb_add(&bar[XB_TOP], 1u);
      const unsigned tg = og / nx;
      if (og + 1u == (tg + 1u) * nx) xb_add(&bar[XB_TOPGEN], 1u);
      else XB_SPIN(xb_ld(&bar[XB_TOPGEN]) == tg, bar);
      __builtin_amdgcn_fence(__ATOMIC_ACQUIRE, "agent");
      xb_add(&bar[XB_XGEN(b.x)], 1u);
      asm volatile("s_waitcnt vmcnt(0)" ::: "memory");
    } else {
      XB_SPIN(xb_ld(&bar[XB_XGEN(b.x)]) == gen, bar);
      __builtin_amdgcn_fence(__ATOMIC_ACQUIRE, "agent");
      asm volatile("s_waitcnt vmcnt(0)" ::: "memory");
    }
  }
  __syncthreads();
}

constexpr int BM = 256, BK = 64, HALF = 128, HTB = HALF * BK * 2, STAGE_BYTES = 8 * HTB, NXCD = 8, WGM = 8;
__device__ __forceinline__ int lds_byte(int r, int c) { const int st = (r >> 4) * 2 + (c >> 5), rr = r & 15, cc = c & 31, ob = rr * 64 + cc * 2; return st * 1024 + (ob ^ (((ob >> 9) & 1) << 5)); }
__device__ __forceinline__ void stage_rc(int b, int& R, int& C) { const int st = b / 1024, sb = b % 1024, swz = sb ^ (((sb >> 9) & 1) << 5); R = (st >> 1) * 16 + swz / 64; C = (st & 1) * 32 + (swz % 64) / 2; }
__device__ __forceinline__ int perm32(int rho) { const int n = rho >> 4, i = rho & 15; return 8 * (i >> 2) + 4 * n + (i & 3); }

struct Unit { int pm, pn, e, nrows, row0; };

template <class Prob, class Epi, bool ALIGN_EPI>
__device__ __forceinline__ void gemm_phase(LAS unsigned char* lds, const Prob& P, const Epi& E) {
  const int tid = threadIdx.x, wid = __builtin_amdgcn_readfirstlane(tid >> 6), lane = tid & 63, wr = wid >> 2, wc = wid & 3, fr = lane & 15, fq = lane >> 4;
  const int K = P.K, nt = K / BK;
  int Rr[2], Cc[2]; unsigned voffB[2];
#pragma unroll
  for (int i = 0; i < 2; ++i) { int R, C; stage_rc(tid * 16 + i * 8192, R, C); Rr[i] = R; Cc[i] = C; const int Rb = (R & ~31) + perm32(R & 31); voffB[i] = (unsigned)(Rb * K + C) * 2u; }
  const size_t kstep = (size_t)(BK * 2);
  const size_t hstep = (size_t)HALF * K * 2;
  const unsigned ldsw = (unsigned)wid * 1024u;
  const int aoff = lds_byte(wr * 64 + fr, fq * 8), boff = lds_byte(wc * 32 + fr, fq * 8);
#define PG8_SA(b, h) (((b) * 2 + (h)) * HTB)
#define PG8_SB(b, h) ((4 + (b) * 2 + (h)) * HTB)
#define PG8_STAGE(bufoff, gbase, voff) do { _Pragma("unroll") for (int _i = 0; _i < 2; ++_i) \
        __builtin_amdgcn_global_load_lds((const unsigned*)((const char*)(gbase) + (voff)[_i]), (LAS unsigned*)(lds + (bufoff) + ldsw + _i * 8192), 16, 0, 0); } while (0)
#define PG8_LDA(dst, b, h) do { _Pragma("unroll") for (int m = 0; m < 4; ++m) _Pragma("unroll") for (int k = 0; k < 2; ++k) dst[m][k] = *(const LAS bf16x8*)(lds + PG8_SA(b, h) + aoff + m * 2048 + k * 1024); } while (0)
#define PG8_LDB(dst, b, h) do { _Pragma("unroll") for (int n = 0; n < 2; ++n) _Pragma("unroll") for (int k = 0; k < 2; ++k) dst[n][k] = *(const LAS bf16x8*)(lds + PG8_SB(b, h) + boff + n * 2048 + k * 1024); } while (0)
#define PG8_MMA(ai, bj, At, Bt) do { __builtin_amdgcn_s_setprio(1); _Pragma("unroll") for (int m = 0; m < 4; ++m) _Pragma("unroll") for (int n = 0; n < 2; ++n) _Pragma("unroll") for (int k = 0; k < 2; ++k) \
        acc[ai][bj][m][n] = __builtin_amdgcn_mfma_f32_16x16x32_bf16(Bt[n][k], At[m][k], acc[ai][bj][m][n], 0, 0, 0); __builtin_amdgcn_s_setprio(0); } while (0)
#define PG8_WAIT_V(n) asm volatile("s_waitcnt vmcnt(" #n ")" ::: "memory")
#define PG8_WAIT_L(n) asm volatile("s_waitcnt lgkmcnt(" #n ")" ::: "memory")
#define PG8_BAR __builtin_amdgcn_s_barrier()
#define PG8_SCHED __builtin_amdgcn_sched_barrier(0)
  Unit cur, nxt; int ui = 0;
  if (!P.next(0, cur)) return;
  f32x4 acc[2][2][4][2];
#pragma unroll
  for (int a = 0; a < 2; ++a)
#pragma unroll
    for (int b = 0; b < 2; ++b)
#pragma unroll
      for (int m = 0; m < 4; ++m)
#pragma unroll
        for (int n = 0; n < 2; ++n) acc[a][b][m][n] = (f32x4){0.f, 0.f, 0.f, 0.f};
  bf16x8 At[4][2], B0[2][2], B1[2][2];
  unsigned aC0[2], aC1[2], aN0[2], aN1[2];
#pragma unroll
  for (int i = 0; i < 2; ++i) { aC0[i] = P.a_row_off(cur, Rr[i]) + (unsigned)Cc[i] * 2u; aC1[i] = P.a_row_off(cur, HALF + Rr[i]) + (unsigned)Cc[i] * 2u; aN0[i] = aC0[i]; aN1[i] = aC1[i]; }
  const char* const cAb = P.Abase;
  const char* cB = P.b_rows(cur);
  PG8_STAGE(PG8_SB(0, 0), cB, voffB); PG8_STAGE(PG8_SB(0, 1), cB + hstep, voffB); PG8_STAGE(PG8_SA(0, 0), cAb, aC0); PG8_STAGE(PG8_SA(0, 1), cAb, aC1);
  if (wr == 1) PG8_BAR;
  PG8_WAIT_V(2); PG8_BAR;
  PG8_STAGE(PG8_SB(1, 0), cB + kstep, voffB); PG8_STAGE(PG8_SA(1, 0), cAb + kstep, aC0); PG8_STAGE(PG8_SB(1, 1), cB + hstep + kstep, voffB);
  PG8_WAIT_V(6); PG8_BAR;
  for (;;) {
    const bool has_next = P.next(ui + 1, nxt);
    const char* nB = cB;
    if (has_next) { nB = P.b_rows(nxt);
#pragma unroll
      for (int i = 0; i < 2; ++i) { aN0[i] = P.a_row_off(nxt, Rr[i]) + (unsigned)Cc[i] * 2u; aN1[i] = P.a_row_off(nxt, HALF + Rr[i]) + (unsigned)Cc[i] * 2u; }
    } else {
#pragma unroll
      for (int i = 0; i < 2; ++i) { aN0[i] = aC0[i]; aN1[i] = aC1[i]; }
    }
    for (int t = 0; t < nt; t += 2) {
      const bool last = (t == nt - 2);
      const char* a1 = cAb + (size_t)(t + 1) * kstep;
      const char* a2 = last ? cAb : cAb + (size_t)(t + 2) * kstep; const char* b2 = last ? nB : cB + (size_t)(t + 2) * kstep;
      const char* a3 = a2 + kstep; const char* b3 = b2 + kstep;
      unsigned s0[2], s1[2];
#pragma unroll
      for (int i = 0; i < 2; ++i) { s0[i] = last ? aN0[i] : aC0[i]; s1[i] = last ? aN1[i] : aC1[i]; }
      PG8_LDB(B0, 0, 0); PG8_LDB(B1, 0, 1); PG8_SCHED; PG8_LDA(At, 0, 0); PG8_STAGE(PG8_SA(1, 1), a1, aC1);
      PG8_WAIT_V(8); PG8_WAIT_L(0); PG8_BAR; PG8_MMA(0, 0, At, B0); PG8_MMA(0, 1, At, B1); PG8_BAR; PG8_SCHED;
      PG8_LDA(At, 0, 1); PG8_STAGE(PG8_SB(0, 0), b2, voffB); PG8_STAGE(PG8_SB(0, 1), b2 + hstep, voffB); PG8_STAGE(PG8_SA(0, 0), a2, s0);
      PG8_WAIT_V(8); PG8_WAIT_L(0); PG8_BAR; PG8_MMA(1, 0, At, B0); PG8_MMA(1, 1, At, B1); PG8_BAR; PG8_SCHED;
      PG8_LDB(B0, 1, 0); PG8_LDB(B1, 1, 1); PG8_SCHED; PG8_LDA(At, 1, 0); PG8_STAGE(PG8_SA(0, 1), a2, s1);
      PG8_WAIT_V(8); PG8_WAIT_L(0); PG8_BAR; PG8_MMA(0, 0, At, B0); PG8_MMA(0, 1, At, B1); PG8_BAR; PG8_SCHED;
      PG8_LDA(At, 1, 1); PG8_STAGE(PG8_SB(1, 0), b3, voffB); PG8_STAGE(PG8_SB(1, 1), b3 + hstep, voffB); PG8_STAGE(PG8_SA(1, 0), a3, s0);
      PG8_WAIT_V(8); PG8_WAIT_L(0); PG8_BAR; PG8_MMA(1, 0, At, B0); PG8_MMA(1, 1, At, B1); PG8_BAR; PG8_SCHED;
    }
    if constexpr (ALIGN_EPI) { if (wr == 0) PG8_BAR; }
    E(acc, cur, wr, wc, fr, fq);
    if (!has_next) break;
#pragma unroll
    for (int a = 0; a < 2; ++a)
#pragma unroll
      for (int b = 0; b < 2; ++b)
#pragma unroll
        for (int m = 0; m < 4; ++m)
#pragma unroll
          for (int n = 0; n < 2; ++n) acc[a][b][m][n] = (f32x4){0.f, 0.f, 0.f, 0.f};
    cur = nxt; cB = nB; ++ui;
#pragma unroll
    for (int i = 0; i < 2; ++i) { aC0[i] = aN0[i]; aC1[i] = aN1[i]; }
    if constexpr (ALIGN_EPI) { if (wr == 1) PG8_BAR; }
  }
  PG8_WAIT_V(0);
  if constexpr (!ALIGN_EPI) { if (wr == 0) PG8_BAR; }
  PG8_BAR;
#undef PG8_SA
#undef PG8_SB
#undef PG8_STAGE
#undef PG8_LDA
#undef PG8_LDB
#undef PG8_MMA
#undef PG8_WAIT_V
#undef PG8_WAIT_L
#undef PG8_BAR
#undef PG8_SCHED
}
}
namespace mk {
constexpr size_t MiB = 1u << 20;
constexpr size_t WS_CTL = 0, CTL_ZERO_BYTES = 256 * 1024;
constexpr size_t WS_SMALL = 512 * 1024;
constexpr size_t WS_WIN = 1 * MiB;
constexpr size_t WS_WOUT = 9 * MiB;
constexpr size_t WS_ROPE = 11 * MiB;
constexpr size_t WS_ROUTE = 15 * MiB;
constexpr size_t WS_WGU = 20 * MiB;
constexpr size_t WS_XN = 84 * MiB;
constexpr size_t WS_Q = 116 * MiB;
constexpr size_t WS_K = 132 * MiB;
constexpr size_t WS_V = 148 * MiB;
constexpr size_t WS_HQ = 164 * MiB;
constexpr size_t WS_ZF = 180 * MiB;
constexpr size_t WS_ZB = 196 * MiB;
constexpr size_t WS_HI = 212 * MiB;
constexpr size_t WS_HG = 228 * MiB;
constexpr size_t WS_WD = 244 * MiB;
constexpr size_t WS_END = 276 * MiB;
constexpr int CW_BAR = 1024;
constexpr int CW_CNT = 8192;

constexpr int RING_BYTES = 131072;
constexpr int MISC_OFF = RING_BYTES + 320;
constexpr int LDS_BYTES = 147456;

struct Args {
  const float* in[17]; float* out; unsigned char* ws; int ph_lo, ph_hi;
};

struct Frame {
  LAS unsigned char* lds;
  volatile LAS unsigned* MISC;
  int tid, lane, wave, vcu, G;
};

__device__ __forceinline__ void transpose_item(const float* W, int ldw, int k0, int n0, bf16_t* WT, int Kdst, int dst_row0, LAS float* scr, int lane) {
#pragma unroll 8
  for (int i = 0; i < 32; ++i) { const int kk = 2 * i + (lane >> 5); scr[kk * 33 + (lane & 31)] = W[(size_t)(k0 + kk) * ldw + n0 + (lane & 31)]; }
  LDS_WAIT(); asm volatile("" ::: "memory");
  const int c = lane & 7;
#pragma unroll
  for (int j = 0; j < 4; ++j) { const int n = (lane >> 3) + 8 * j; const LAS float* s = scr + (8 * c) * 33 + n;
    u32x4 o; o.x = cvt_pk_bf16(s[0 * 33], s[1 * 33]); o.y = cvt_pk_bf16(s[2 * 33], s[3 * 33]); o.z = cvt_pk_bf16(s[4 * 33], s[5 * 33]); o.w = cvt_pk_bf16(s[6 * 33], s[7 * 33]);
    *(GAS u32x4*)(WT + (size_t)(dst_row0 + n) * Kdst + k0 + 8 * c) = o; }
  LDS_WAIT(); asm volatile("" ::: "memory");
}
__device__ __forceinline__ int inproj_dst_col(int n0) {
  if (n0 >= 1024) return n0;
  const int R = n0 >> 9, rem = n0 & 511, hc = rem >> 6, bj = (rem >> 5) & 1;
  return R * 512 + (hc >> 2) * 256 + bj * 128 + (hc & 3) * 32;
}
__device__ __forceinline__ void rms_row_to_bf16(const float* xrow, const float* g, bf16_t* orow, int lane) {
  const GAS f32x4* xr = (const GAS f32x4*)xrow + lane;
  f32x4 v[4]; float s = 0.f;
#pragma unroll
  for (int j = 0; j < 4; ++j) { v[j] = xr[64 * j]; s += (v[j].x * v[j].x + v[j].y * v[j].y) + (v[j].z * v[j].z + v[j].w * v[j].w); }
  const float rstd = 1.f / sqrtf(wave_sum(s) * (1.f / DM) + 1e-6f);
  GAS u32x2* o8 = (GAS u32x2*)orow + lane;
#pragma unroll
  for (int j = 0; j < 4; ++j) { const f32x4 gg = ((const GAS f32x4*)g)[lane + 64 * j]; u32x2 w; w.x = cvt_pk_bf16(v[j].x * rstd * gg.x, v[j].y * rstd * gg.y); w.y = cvt_pk_bf16(v[j].z * rstd * gg.z, v[j].w * rstd * gg.w); o8[64 * j] = w; }
}

template <bool MOE_W>
__device__ __forceinline__ void p0_prologue(Frame& F, const Args& a) {
  LAS float* scr = (LAS float*)(F.lds + F.wave * 16384);
  const int gw = F.vcu * NWAVES + F.wave, NGW = F.G * NWAVES;
  const float* w_in = a.in[1]; const float* w_out = a.in[2];
  bf16_t* WinT = (bf16_t*)(a.ws + WS_WIN); bf16_t* WoutT = (bf16_t*)(a.ws + WS_WOUT);
  constexpr int I_IN = 16 * 128, I_OUT = 16 * 32, I_G = 32 * 16 * 16, I_D = 32 * 8 * 32;
  const int NITEMS = I_IN + I_OUT + (MOE_W ? (2 * I_G + I_D) : 0);
  for (int it = gw; it < NITEMS; it += NGW) {
    int r = it;
    if (r < I_IN) { const int kb = r / 128, nb = r % 128; transpose_item(w_in, NCOL, 64 * kb, 32 * nb, WinT, DM, inproj_dst_col(32 * nb), scr, F.lane); continue; } r -= I_IN;
    if (r < I_OUT) { const int kb = r / 32, nb = r % 32; transpose_item(w_out, DM, 64 * kb, 32 * nb, WoutT, DM, 32 * nb, scr, F.lane); continue; } r -= I_OUT;
    if (MOE_W) {
      bf16_t* WguT = (bf16_t*)(a.ws + WS_WGU); bf16_t* WdT = (bf16_t*)(a.ws + WS_WD);
      if (r < 2 * I_G) { const int which = r / I_G; r -= which * I_G; const int e = r / 256, q = r % 256, kb = q / 16, nb = q % 16;
        const float* W = (which ? a.in[14] : a.in[13]) + (size_t)e * DM * FE; const int f0 = 32 * nb;
        transpose_item(W, FE, 64 * kb, f0, WguT + (size_t)e * 1024 * DM, DM, (f0 >> 7) * 256 + which * 128 + (f0 & 127), scr, F.lane); continue; } r -= 2 * I_G;
      { const int e = r / 256, q = r % 256, kb = q / 32, nb = q % 32;
        transpose_item(a.in[15] + (size_t)e * FE * DM, DM, 64 * kb, 32 * nb, WdT + (size_t)e * DM * FE, FE, 32 * nb, scr, F.lane); }
    }
  }
  { const float* x = a.in[0]; bf16_t* XN = (bf16_t*)(a.ws + WS_XN);
    for (int m = gw; m < T; m += NGW) rms_row_to_bf16(x + (size_t)m * DM, a.in[3], XN + (size_t)m * DM, F.lane); }
  { float* cs = (float*)(a.ws + WS_ROPE); float* sn = cs + (size_t)T * 32;
    const int gt = F.vcu * NTHR + F.tid, NGT = F.G * NTHR;
    for (int idx = gt; idx < T * 32; idx += NGT) { const int j = idx & 31, t = idx >> 5;
      const float inv = powf(10000.0f, -(float)(2 * j) / 64.0f); const float ang = (float)t * inv;
      const double ad = (double)ang; const double kq = rint(ad * 0.15915494309189535); const float rr = (float)(ad - kq * 6.283185307179586);
      cs[idx] = cosf(rr); sn[idx] = sinf(rr); } }
  if (F.vcu == 0 && F.wave == 0) {
    float* sm = (float*)(a.ws + WS_SMALL); const float* lp = a.in[4];
    float d1 = lp[F.lane] * lp[64 + F.lane], d2 = lp[128 + F.lane] * lp[192 + F.lane];
    d1 = wave_sum(d1); d2 = wave_sum(d2);
    if (F.lane == 0) sm[0] = expf(d1) - expf(d2) + 0.2f;
    const float* lbl = a.in[7];
    for (int i = F.lane; i < 1024; i += 64) { const int dir = i >> 9, c = i & 511; const float a0 = lbl[(dir * 2 + 0) * 512 + c], a1 = lbl[(dir * 2 + 1) * 512 + c];
      const float mx = fmaxf(a0, a1); const float e0 = expf(a0 - mx), e1 = expf(a1 - mx); sm[64 + i] = e0 / (e0 + e1); }
  }
}

struct ProbPlain {
  int K; const char* Abase; const char* Bt; int nM, nN, nwg, G, c;
  __device__ __forceinline__ void init(const void* A, const void* B, int M, int N, int K_, int G_, int c_) { Abase = (const char*)A; Bt = (const char*)B; K = K_; nM = M / BM; nN = N / BM; nwg = nM * nN; G = G_; c = c_; }
  __device__ __forceinline__ bool next(int i, Unit& u) const {
    const long L = (long)i * G + c; if (L >= nwg) return false;
    int wgid = (int)L; { const int q = nwg / NXCD, r = nwg % NXCD, xcd = wgid % NXCD, off = wgid / NXCD; wgid = (xcd < r ? xcd * (q + 1) : r * (q + 1) + (xcd - r) * q) + off; }
    const int nig = WGM * nN, gid = wgid / nig, fm = gid * WGM, gsz = (nM - fm) < WGM ? (nM - fm) : WGM;
    u.pm = fm + ((wgid % nig) % gsz); u.pn = (wgid % nig) / gsz; u.e = 0; u.nrows = 256; u.row0 = u.pm * 256; return true;
  }
  __device__ __forceinline__ unsigned a_row_off(const Unit& u, int r) const { return (unsigned)(u.pm * BM + r) * (unsigned)K * 2u; }
  __device__ __forceinline__ const char* b_rows(const Unit& u) const { return Bt + (size_t)u.pn * BM * K * 2; }
};

struct EpiInProj {
  unsigned char* ws; const float* cs; const float* sn;
  __device__ __forceinline__ void operator()(const f32x4 (&acc)[2][2][4][2], const Unit& u, int wr, int wc, int fr, int fq) const {
    const int row0 = u.pm * BM + wr * 64 + fr, pn = u.pn;
    if (pn < 4) {
      bf16_t* base = (bf16_t*)(ws + (pn < 2 ? WS_Q : WS_K)) + (size_t)(4 * (pn & 1) + wc) * T * 64;
#pragma unroll
      for (int ai = 0; ai < 2; ++ai)
#pragma unroll
        for (int m = 0; m < 4; ++m) { const int t = row0 + ai * HALF + m * 16;
          const f32x4 c0 = *(const f32x4*)(cs + (size_t)t * 32 + 8 * fq), c1 = *(const f32x4*)(cs + (size_t)t * 32 + 8 * fq + 4);
          const f32x4 s0 = *(const f32x4*)(sn + (size_t)t * 32 + 8 * fq), s1 = *(const f32x4*)(sn + (size_t)t * 32 + 8 * fq + 4);
          const f32x4 x1a = acc[ai][0][m][0], x1b = acc[ai][0][m][1], x2a = acc[ai][1][m][0], x2b = acc[ai][1][m][1];
          const f32x4 o1a = x1a * c0 - x2a * s0, o1b = x1b * c1 - x2b * s1, o2a = x1a * s0 + x2a * c0, o2b = x1b * s1 + x2b * c1;
          u32x4 w1, w2; w1.x = cvt_pk_bf16(o1a[0], o1a[1]); w1.y = cvt_pk_bf16(o1a[2], o1a[3]); w1.z = cvt_pk_bf16(o1b[0], o1b[1]); w1.w = cvt_pk_bf16(o1b[2], o1b[3]);
          w2.x = cvt_pk_bf16(o2a[0], o2a[1]); w2.y = cvt_pk_bf16(o2a[2], o2a[3]); w2.z = cvt_pk_bf16(o2b[0], o2b[1]); w2.w = cvt_pk_bf16(o2b[2], o2b[3]);
          bf16_t* rp = base + (size_t)t * 64 + 8 * fq;
          *(u32x4*)rp = w1; *(u32x4*)(rp + 32) = w2; }
    } else if (pn < 6) {
#pragma unroll
      for (int bj = 0; bj < 2; ++bj) { bf16_t* base = (bf16_t*)(ws + WS_V) + (size_t)(2 * (pn - 4) + bj) * T * 128 + wc * 32 + 8 * fq;
#pragma unroll
        for (int ai = 0; ai < 2; ++ai)
#pragma unroll
          for (int m = 0; m < 4; ++m) { const int t = row0 + ai * HALF + m * 16; const f32x4 v0 = acc[ai][bj][m][0], v1 = acc[ai][bj][m][1];
            u32x4 w; w.x = cvt_pk_bf16(v0[0], v0[1]); w.y = cvt_pk_bf16(v0[2], v0[3]); w.z = cvt_pk_bf16(v1[0], v1[1]); w.w = cvt_pk_bf16(v1[2], v1[3]);
            *(u32x4*)(base + (size_t)t * 128) = w; } }
    } else {
      const int reg = (pn - 6) >> 1; const bool act = (reg == 0) || (reg == 4);
      bf16_t* base = (bf16_t*)(ws + WS_HQ + (size_t)reg * 16 * MiB) + ((pn - 6) & 1) * 256 + wc * 32 + 8 * fq;
#pragma unroll
      for (int bj = 0; bj < 2; ++bj)
#pragma unroll
        for (int ai = 0; ai < 2; ++ai)
#pragma unroll
          for (int m = 0; m < 4; ++m) { const int t = row0 + ai * HALF + m * 16; f32x4 v0 = acc[ai][bj][m][0], v1 = acc[ai][bj][m][1];
            if (act) {
#pragma unroll
              for (int i = 0; i < 4; ++i) { v0[i] = fsilu(v0[i]); v1[i] = fsilu(v1[i]); } }
            u32x4 w; w.x = cvt_pk_bf16(v0[0], v0[1]); w.y = cvt_pk_bf16(v0[2], v0[3]); w.z = cvt_pk_bf16(v1[0], v1[1]); w.w = cvt_pk_bf16(v1[2], v1[3]);
            *(u32x4*)(base + (size_t)t * 512 + bj * 128) = w; }
    }
  }
};
}
namespace mk {
namespace att {
constexpr int NW = 8, QBLK = 32, KVBLK = 64, DV = 128, DQK = 64;
constexpr float SCALE = 0.125f;
constexpr float THR = 8.f;
constexpr int SHM_V = KVBLK * DV * 2, SHM_K = KVBLK * DQK * 2;
constexpr int SHM_ATTN = 2 * SHM_V + 2 * SHM_K + NW * 64 * 4;
#define KSWZ(row, colB) ((row) * 128 + ((colB) ^ ((((row) >> 1) & 7) << 4)))
#define SBAR() __builtin_amdgcn_sched_barrier(0)
__device__ __forceinline__ int crow(int r, int hi) { return (r & 3) + 8 * (r >> 2) + 4 * hi; }

__device__ __forceinline__ void partialSM(f32x16& p0, f32x16& p1, float& m_reg, float& mn, float& alpha) {
  constexpr float C = SCALE * LOG2E;
  float pmax = p0[0];
#pragma unroll
  for (int r = 1; r < 16; ++r) pmax = fmaxf(pmax, p0[r]);
#pragma unroll
  for (int r = 0; r < 16; ++r) pmax = fmaxf(pmax, p1[r]);
  { auto rr = __builtin_amdgcn_permlane32_swap(__float_as_uint(pmax), __float_as_uint(pmax), false, false);
    pmax = fmaxf(__uint_as_float(rr[0]), __uint_as_float(rr[1])); }
  if (__builtin_expect(__all(pmax - m_reg <= THR / SCALE), 1)) { mn = m_reg; alpha = 1.f; }
  else { mn = fmaxf(m_reg, pmax); alpha = __builtin_amdgcn_exp2f((m_reg - mn) * C); m_reg = mn; }
  const float mnC = -mn * C;
#pragma unroll
  for (int r = 0; r < 16; ++r) p0[r] = fmaf(p0[r], C, mnC);
#pragma unroll
  for (int r = 0; r < 16; ++r) p1[r] = fmaf(p1[r], C, mnC);
#pragma unroll
  for (int r = 0; r < 16; ++r) p0[r] = __builtin_amdgcn_exp2f(p0[r]);
}
__device__ __forceinline__ void finishSM(f32x16& p0, f32x16& p1, float alpha, float& l_reg, bf16x8& pa0, bf16x8& pa1, bf16x8& pa2, bf16x8& pa3) {
#pragma unroll
  for (int r = 0; r < 16; ++r) p1[r] = __builtin_amdgcn_exp2f(p1[r]);
  float ps = 0;
#pragma unroll
  for (int r = 0; r < 16; ++r) ps += p0[r];
#pragma unroll
  for (int r = 0; r < 16; ++r) ps += p1[r];
  { auto rr = __builtin_amdgcn_permlane32_swap(__float_as_uint(ps), __float_as_uint(ps), false, false);
    ps = __uint_as_float(rr[0]) + __uint_as_float(rr[1]); }
  l_reg = l_reg * alpha + ps;
#define PK4(P, BASE, OUT) do { unsigned a0 = cvt_pk_bf16(P[BASE + 0], P[BASE + 1]), a1 = cvt_pk_bf16(P[BASE + 2], P[BASE + 3]);   \
    unsigned b0 = cvt_pk_bf16(P[BASE + 4], P[BASE + 5]), b1 = cvt_pk_bf16(P[BASE + 6], P[BASE + 7]);                              \
    auto r0 = __builtin_amdgcn_permlane32_swap(a0, b0, false, false); auto r1 = __builtin_amdgcn_permlane32_swap(a1, b1, false, false); \
    u32x4 w = {r0[0], r1[0], r0[1], r1[1]}; OUT = __builtin_bit_cast(bf16x8, w); } while (0)
  PK4(p0, 0, pa0); PK4(p0, 8, pa1); PK4(p1, 0, pa2); PK4(p1, 8, pa3);
#undef PK4
}
__device__ __forceinline__ void qkt(f32x16& p0, f32x16& p1, const LAS char* Ks, const bf16x8* qr, int r32, int hi) {
  p0 = f32x16{}; p1 = f32x16{};
#pragma unroll
  for (int d0 = 0; d0 < 4; ++d0) { const int cb = (d0 * 16 + hi * 8) * 2;
    const bf16x8 b0 = *(const LAS bf16x8*)(Ks + KSWZ(r32, cb));
    const bf16x8 b1 = *(const LAS bf16x8*)(Ks + KSWZ(32 + r32, cb));
    p0 = __builtin_amdgcn_mfma_f32_32x32x16_bf16(b0, qr[d0], p0, 0, 0, 0);
    p1 = __builtin_amdgcn_mfma_f32_32x32x16_bf16(b1, qr[d0], p1, 0, 0, 0); }
}
__device__ __forceinline__ int v_st(int k, int c) { const int kk = (k & ~0xC) | ((k & 4) << 1) | ((k & 8) >> 1); return ((kk >> 3) * 4 + (c >> 5)) * 512 + ((kk & 7) * 32 + (c & 31)) * 2; }
__device__ __forceinline__ int v_rd_base(int lane) { return ((lane & 3) << 3) | (((lane >> 2) & 3) << 6) | (((lane >> 4) & 1) << 5) | (((lane >> 5) & 1) << 8); }
constexpr int v_rd_off(int d0, int ks, int half) { return d0 * 512 + ks * 4096 + half * 2048; }
template <int OFF> __device__ __forceinline__ s16x4 tr_read(int vb) {
  s16x4 r; asm volatile("ds_read_b64_tr_b16 %0, %1 offset:%2" : "=&v"(r) : "v"(vb), "i"(OFF) : "memory"); return r;
}
template <int D0> __device__ __forceinline__ void pv_one(f32x16& od, int vb, bf16x8 pa0, bf16x8 pa1, bf16x8 pa2, bf16x8 pa3) {
  const s16x4 l0 = tr_read<v_rd_off(D0, 0, 0)>(vb), h0 = tr_read<v_rd_off(D0, 0, 1)>(vb), l1 = tr_read<v_rd_off(D0, 1, 0)>(vb), h1 = tr_read<v_rd_off(D0, 1, 1)>(vb);
  const s16x4 l2 = tr_read<v_rd_off(D0, 2, 0)>(vb), h2 = tr_read<v_rd_off(D0, 2, 1)>(vb), l3 = tr_read<v_rd_off(D0, 3, 0)>(vb), h3 = tr_read<v_rd_off(D0, 3, 1)>(vb);
  asm volatile("s_waitcnt lgkmcnt(0)" ::: "memory"); SBAR();
#define PK(L, H) (bf16x8){L[0], L[1], L[2], L[3], H[0], H[1], H[2], H[3]}
  od = __builtin_amdgcn_mfma_f32_32x32x16_bf16(pa0, PK(l0, h0), od, 0, 0, 0);
  od = __builtin_amdgcn_mfma_f32_32x32x16_bf16(pa1, PK(l1, h1), od, 0, 0, 0);
  od = __builtin_amdgcn_mfma_f32_32x32x16_bf16(pa2, PK(l2, h2), od, 0, 0, 0);
  od = __builtin_amdgcn_mfma_f32_32x32x16_bf16(pa3, PK(l3, h3), od, 0, 0, 0);
#undef PK
}
__device__ __forceinline__ void pv_d0(f32x16* o, int vb, bf16x8 pa0, bf16x8 pa1, bf16x8 pa2, bf16x8 pa3) {
  pv_one<0>(o[0], vb, pa0, pa1, pa2, pa3); pv_one<1>(o[1], vb, pa0, pa1, pa2, pa3); pv_one<2>(o[2], vb, pa0, pa1, pa2, pa3); pv_one<3>(o[3], vb, pa0, pa1, pa2, pa3);
}

__device__ __forceinline__ void attn_pass(int tid, const bf16_t* __restrict__ Qb, const bf16_t* __restrict__ Kh, const bf16_t* __restrict__ Vh, int seq, LAS char* lds, f32x16 (&o)[4], float (&rli)[16]) {
  const int wid = tid >> 6, lane = tid & 63, r32 = lane & 31, hi = lane >> 5;
  LAS char* V_lds = lds; LAS char* K_lds = lds + 2 * SHM_V;
  LAS float* ws = (LAS float*)(lds + 2 * SHM_V + 2 * SHM_K) + wid * 64; LAS float* li_l = ws; LAS float* al_l = ws + 32;
  float m_reg = -1e30f, l_reg = 0;
#pragma unroll
  for (int d = 0; d < 4; ++d) o[d] = f32x16{};
  bf16x8 qr[4];
  const bf16_t* Qw = Qb + (long)(wid * QBLK + r32) * DQK + hi * 8;
#pragma unroll
  for (int d0 = 0; d0 < 4; ++d0) qr[d0] = *(const bf16x8*)(Qw + d0 * 16);
  const int sr = tid >> 4, sc = (tid & 15) * 8, vst0 = v_st(sr, sc), vst1 = v_st(32 + sr, sc);
  const int kr = tid >> 3, kc = (tid & 7) * 8, kst = KSWZ(kr, kc * 2);
  const int vb0 = (int)(uintptr_t)V_lds + v_rd_base(lane);
  struct { bf16x8 vs0, vs1, ks0; } sr_[2];
#define SLOAD(i, k0) do { sr_[i].vs0 = *(const bf16x8*)(&Vh[(long)((k0) + sr) * DV + sc]); sr_[i].vs1 = *(const bf16x8*)(&Vh[(long)((k0) + 32 + sr) * DV + sc]); \
    sr_[i].ks0 = *(const bf16x8*)(&Kh[(long)((k0) + kr) * DQK + kc]); } while (0)
#define SWRITE(b, i) do { *(LAS bf16x8*)(V_lds + (b) * SHM_V + vst0) = sr_[i].vs0; *(LAS bf16x8*)(V_lds + (b) * SHM_V + vst1) = sr_[i].vs1; \
    *(LAS bf16x8*)(K_lds + (b) * SHM_K + kst) = sr_[i].ks0; } while (0)
#define SWAIT() asm volatile("s_waitcnt vmcnt(3)" ::: "memory")
#define RESC(a) do { if (__any((a) < 1.f)) { if (hi == 0) al_l[r32] = (a); asm volatile("s_waitcnt lgkmcnt(0)" ::: "memory"); \
    _Pragma("unroll") for (int d = 0; d < 4; ++d) _Pragma("unroll") for (int r = 0; r < 16; ++r) o[d][r] *= al_l[crow(r, hi)]; } } while (0)
  f32x16 pA0, pA1, pB0, pB1; float mnA, mnB, alA, alB; bf16x8 pa0, pa1, pa2, pa3; const int NT = seq / KVBLK;
  constexpr int SE = 0, SO = 1;
  SLOAD(SE, 0); asm volatile("s_waitcnt vmcnt(0)" ::: "memory"); SWRITE(0, SE); __syncthreads();
  qkt(pA0, pA1, K_lds, qr, r32, hi); partialSM(pA0, pA1, m_reg, mnA, alA);
  SLOAD(SO, KVBLK); if (2 < NT) SLOAD(SE, 2 * KVBLK);
  SWAIT(); SWRITE(1, SO); __syncthreads();
  for (int j = 1; j + 1 < NT; j += 2) {
    SBAR(); qkt(pB0, pB1, K_lds + SHM_K, qr, r32, hi);
    finishSM(pA0, pA1, alA, l_reg, pa0, pa1, pa2, pa3); SBAR();
    SLOAD(SO, (j + 2) * KVBLK); SBAR();
    pv_d0(o, vb0, pa0, pa1, pa2, pa3); partialSM(pB0, pB1, m_reg, mnB, alB);
    __syncthreads(); SWAIT(); SWRITE(0, SE);
    RESC(alB); __syncthreads();
    SBAR(); qkt(pA0, pA1, K_lds, qr, r32, hi);
    finishSM(pB0, pB1, alB, l_reg, pa0, pa1, pa2, pa3); SBAR();
    if (j + 3 < NT) SLOAD(SE, (j + 3) * KVBLK); SBAR();
    pv_d0(o, vb0 + SHM_V, pa0, pa1, pa2, pa3); partialSM(pA0, pA1, m_reg, mnA, alA);
    __syncthreads(); SWAIT(); SWRITE(1, SO);
    RESC(alA); __syncthreads();
  }
  SBAR(); qkt(pB0, pB1, K_lds + SHM_K, qr, r32, hi);
  finishSM(pA0, pA1, alA, l_reg, pa0, pa1, pa2, pa3); SBAR();
  pv_d0(o, vb0, pa0, pa1, pa2, pa3); partialSM(pB0, pB1, m_reg, mnB, alB);
  __syncthreads(); RESC(alB);
  finishSM(pB0, pB1, alB, l_reg, pa0, pa1, pa2, pa3); SBAR();
  pv_d0(o, vb0 + SHM_V, pa0, pa1, pa2, pa3);
  if (hi == 0) li_l[r32] = l_reg; asm volatile("s_waitcnt lgkmcnt(0)" ::: "memory");
#pragma unroll
  for (int r = 0; r < 16; ++r) rli[r] = __builtin_amdgcn_rcpf(li_l[crow(r, hi)]);
  __syncthreads();
#undef SLOAD
#undef SWRITE
#undef SWAIT
#undef RESC
}

__device__ __forceinline__ void attn_unit(int tid, int h, int qb, const unsigned char* ws, float lam, const float* __restrict__ subg, float* stash, LAS char* lds) {
  const int wid = tid >> 6, lane = tid & 63, r32 = lane & 31, hi = lane >> 5;
  const bf16_t* Q = (const bf16_t*)(ws + WS_Q); const bf16_t* K = (const bf16_t*)(ws + WS_K); const bf16_t* V = (const bf16_t*)(ws + WS_V);
  f32x16 o[4]; float rli[16];
  attn_pass(tid, Q + ((size_t)(2 * h) * T + (size_t)qb * 256) * 64, K + (size_t)(2 * h) * T * 64, V + (size_t)h * T * 128, T, lds, o, rli);
  float* st = stash + (size_t)wid * 4096 + lane;
  asm volatile("" : "+v"(st) :: "memory");
#pragma unroll
  for (int d = 0; d < 4; ++d)
#pragma unroll
    for (int r = 0; r < 16; ++r) st[(d * 16 + r) * 64] = o[d][r] * rli[r];
  asm volatile("s_waitcnt vmcnt(0)" ::: "memory"); __builtin_amdgcn_sched_barrier(0);
  attn_pass(tid, Q + ((size_t)(2 * h + 1) * T + (size_t)qb * 256) * 64, K + (size_t)(2 * h + 1) * T * 64, V + (size_t)h * T * 128, T, lds, o, rli);
  float ss[16];
#pragma unroll
  for (int r = 0; r < 16; ++r) ss[r] = 0.f;
  asm volatile("" : "+v"(st) :: "memory");
#pragma unroll
  for (int d = 0; d < 4; ++d)
#pragma unroll
    for (int r = 0; r < 16; ++r) { const float a = st[(d * 16 + r) * 64] - lam * (o[d][r] * rli[r]); o[d][r] = a; ss[r] += a * a; }
#pragma unroll
  for (int r = 0; r < 16; ++r) { float s = ss[r]; s += __shfl_xor(s, 1); s += __shfl_xor(s, 2); s += __shfl_xor(s, 4); s += __shfl_xor(s, 8); s += __shfl_xor(s, 16);
    ss[r] = 0.8f / sqrtf(s * (1.f / 128.f) + 1e-5f); }
  bf16_t* mix = (bf16_t*)(ws + WS_XN);
#pragma unroll
  for (int d = 0; d < 4; ++d) { const float g = subg[d * 32 + r32];
#pragma unroll
    for (int r = 0; r < 16; ++r) { const int t = qb * 256 + wid * 32 + crow(r, hi);
      mix[(size_t)t * DM + h * 128 + d * 32 + r32] = (bf16_t)(cvt_pk_bf16(o[d][r] * ss[r] * g, 0.f) & 0xffffu); } }
}
#undef KSWZ
#undef SBAR
}
}
namespace mk {
namespace hg {
constexpr int C = 64, LSC = 512, NCH = LSC / C, NSC = T / LSC;
constexpr int L_QT = 0, L_KT = 16384, L_KH = 32768, L_VT = 49152, L_GB = 65536  , L_AT = 98304  ,
              L_SEG = 106496  , L_DL = 108544  , L_END = 109056;
__device__ __forceinline__ int crow(int r, int hi) { return (r & 3) + 8 * (r >> 2) + 4 * hi; }
__device__ __forceinline__ unsigned off_b(unsigned row, unsigned ch) { return 256u * row + 16u * (ch ^ (((row & 3) << 2) | ((row >> 2) & 3))); }
__device__ __forceinline__ unsigned row_read_addr(unsigned lane, unsigned s) { return off_b(lane & 31, 2 * s + (lane >> 5)); }
__device__ __forceinline__ unsigned tr_read_addr(unsigned lane, unsigned c, unsigned ks, unsigned t) {
  const unsigned h = lane >> 5, blk = (lane >> 4) & 1, q = (lane & 15) >> 2, p = lane & 3;
  return off_b(16 * ks + 8 * h + 4 * t + q, 4 * c + 2 * blk + (p >> 1)) + 8 * (p & 1);
}
__device__ __forceinline__ s16x4 trd(const LAS unsigned char* p) { typedef short v4i16_t __attribute__((ext_vector_type(4))); return __builtin_bit_cast(s16x4, __builtin_amdgcn_ds_read_tr16_b64_v4i16((LAS v4i16_t*)p)); }
__device__ __forceinline__ bf16x8 tr_frag(const LAS unsigned char* img, unsigned lane, unsigned c, unsigned kk) {
  const LAS unsigned char* base = img + 8192u * (kk >> 1);
  const s16x4 lo = trd(base + tr_read_addr(lane, c, kk & 1, 0)), hi = trd(base + tr_read_addr(lane, c, kk & 1, 1));
  return (bf16x8){lo[0], lo[1], lo[2], lo[3], hi[0], hi[1], hi[2], hi[3]};
}
__device__ __forceinline__ bf16x8 row_frag(const LAS unsigned char* img, unsigned lane, unsigned rt, unsigned s) {
  return *(const LAS bf16x8*)(img + 8192u * rt + row_read_addr(lane, s));
}
__device__ __forceinline__ unsigned at_off(unsigned row, unsigned chunk) { return row * 128u + ((chunk ^ ((row >> 1) & 7u)) << 4); }

template <bool OUT>
__device__ __forceinline__ void hgrn_item(int tid, int h, int dir, int p, const unsigned char* ws, float* Sbuf, float* Dbuf, LAS unsigned char* lds) {
  const int wid = __builtin_amdgcn_readfirstlane(tid >> 6), lane = tid & 63, r32 = lane & 31, hi = lane >> 5;
  const bf16_t* HQ = (const bf16_t*)(ws + WS_HQ); const bf16_t* Z = (const bf16_t*)(ws + (dir ? WS_ZB : WS_ZF)); const bf16_t* HI = (const bf16_t*)(ws + WS_HI);
  const float* lbp = (const float*)(ws + WS_SMALL) + 64 + dir * 512 + h * 128;
  bf16_t* Od = (bf16_t*)(ws + WS_Q) + ((size_t)(dir * 4 + h) * T) * 128;
  const int sc = dir ? (NSC - 1 - p) : p, tok0 = sc * LSC;
  float* Sg = Sbuf + ((size_t)((h * 2 + dir) * NSC + p)) * 16384;
  float* Dg = Dbuf + ((size_t)((h * 2 + dir) * NSC + p)) * 128;
  const int sr = tid >> 4, c8 = (tid & 15) * 8;
  float lb8[8];
#pragma unroll
  for (int i = 0; i < 8; ++i) lb8[i] = lbp[c8 + i];
  const int vj = wid & 3, kt0 = 2 * (wid >> 2);
  f32x16 S0, S1;
  if (OUT) {
#pragma unroll
    for (int r = 0; r < 16; ++r) { S0[r] = Sg[(size_t)(32 * kt0 + crow(r, hi)) * 128 + 32 * vj + r32]; S1[r] = Sg[(size_t)(32 * (kt0 + 1) + crow(r, hi)) * 128 + 32 * vj + r32]; }
  } else { S0 = f32x16{}; S1 = f32x16{}; }
  float bsum[8];
#pragma unroll
  for (int i = 0; i < 8; ++i) bsum[i] = 0.f;
  LAS float* Gb = (LAS float*)(lds + L_GB); LAS float* Seg = (LAS float*)(lds + L_SEG); LAS float* Dl = (LAS float*)(lds + L_DL);
  for (int step = 0; step < NCH; ++step) {
    const int ci = dir ? (NCH - 1 - step) : step, ctok = tok0 + ci * C;
    const int t0 = ctok + (dir ? (63 - sr) : sr), t1 = ctok + (dir ? (31 - sr) : (sr + 32));
    const size_t g0 = (size_t)t0 * 512 + h * 128 + c8, g1 = (size_t)t1 * 512 + h * 128 + c8;
    const u32x4 z0 = *(const u32x4*)(Z + g0), z1 = *(const u32x4*)(Z + g1);
    const u32x4 v0 = *(const u32x4*)(HI + g0), v1 = *(const u32x4*)(HI + g1);
    u32x4 q0 = {0, 0, 0, 0}, q1 = {0, 0, 0, 0};
    if (OUT) { q0 = *(const u32x4*)(HQ + g0); q1 = *(const u32x4*)(HQ + g1); }
    float k0[8], k1[8];
#pragma unroll
    for (int i = 0; i < 4; ++i) {
      { const float za = bflo(z0[i]), zb = bfhi(z0[i]); const float sa = fsigm(za), sb = fsigm(zb); const float fa = lb8[2 * i] + (1.f - lb8[2 * i]) * sa, fb = lb8[2 * i + 1] + (1.f - lb8[2 * i + 1]) * sb;
        k0[2 * i] = 1.f - fa; k0[2 * i + 1] = 1.f - fb; Gb[sr * 128 + c8 + 2 * i] = __logf(fa); Gb[sr * 128 + c8 + 2 * i + 1] = __logf(fb); }
      { const float za = bflo(z1[i]), zb = bfhi(z1[i]); const float sa = fsigm(za), sb = fsigm(zb); const float fa = lb8[2 * i] + (1.f - lb8[2 * i]) * sa, fb = lb8[2 * i + 1] + (1.f - lb8[2 * i + 1]) * sb;
        k1[2 * i] = 1.f - fa; k1[2 * i + 1] = 1.f - fb; Gb[(sr + 32) * 128 + c8 + 2 * i] = __logf(fa); Gb[(sr + 32) * 128 + c8 + 2 * i + 1] = __logf(fb); }
    }
    __syncthreads();
    { const int ch = tid & 127, seg = tid >> 7; float run = 0.f;
#pragma unroll
      for (int r = 0; r < 16; ++r) { run += Gb[(16 * seg + r) * 128 + ch]; Gb[(16 * seg + r) * 128 + ch] = run; }
      Seg[seg * 128 + ch] = run; }
    __syncthreads();
    float bl[8], o0[8], o1[8];
    { const int sg0 = sr >> 4, sg1 = (sr + 32) >> 4;
#pragma unroll
      for (int i = 0; i < 8; ++i) { const float s0 = Seg[c8 + i], s1 = Seg[128 + c8 + i], s2 = Seg[256 + c8 + i], s3 = Seg[384 + c8 + i];
        bl[i] = (s0 + s1) + (s2 + s3); o0[i] = sg0 == 0 ? 0.f : s0; o1[i] = sg1 == 2 ? (s0 + s1) : ((s0 + s1) + s2); } }
    float b0[8], b1[8];
#pragma unroll
    for (int i = 0; i < 8; ++i) { b0[i] = Gb[sr * 128 + c8 + i] + o0[i]; b1[i] = Gb[(sr + 32) * 128 + c8 + i] + o1[i]; }
    if (sr == 0) {
#pragma unroll
      for (int i = 0; i < 8; ++i) { Dl[c8 + i] = __expf(bl[i]); bsum[i] += bl[i]; } }
    { u32x4 kh0, kh1;
#pragma unroll
      for (int i = 0; i < 4; ++i) { kh0[i] = cvt_pk_bf16(k0[2 * i] * __expf(bl[2 * i] - b0[2 * i]), k0[2 * i + 1] * __expf(bl[2 * i + 1] - b0[2 * i + 1]));
        kh1[i] = cvt_pk_bf16(k1[2 * i] * __expf(bl[2 * i] - b1[2 * i]), k1[2 * i + 1] * __expf(bl[2 * i + 1] - b1[2 * i + 1])); }
      const unsigned a0 = off_b(sr, tid & 15), a1 = 8192u + off_b(sr, tid & 15);
      *(LAS u32x4*)(lds + L_KH + a0) = kh0; *(LAS u32x4*)(lds + L_KH + a1) = kh1;
      *(LAS u32x4*)(lds + L_VT + a0) = v0; *(LAS u32x4*)(lds + L_VT + a1) = v1;
      if (OUT) { u32x4 qt0, qt1, kt0_, kt1_;
#pragma unroll
        for (int i = 0; i < 4; ++i) { qt0[i] = cvt_pk_bf16(bflo(q0[i]) * __expf(b0[2 * i]), bfhi(q0[i]) * __expf(b0[2 * i + 1])); qt1[i] = cvt_pk_bf16(bflo(q1[i]) * __expf(b1[2 * i]), bfhi(q1[i]) * __expf(b1[2 * i + 1]));
          kt0_[i] = cvt_pk_bf16(k0[2 * i] * __expf(-b0[2 * i]), k0[2 * i + 1] * __expf(-b0[2 * i + 1])); kt1_[i] = cvt_pk_bf16(k1[2 * i] * __expf(-b1[2 * i]), k1[2 * i + 1] * __expf(-b1[2 * i + 1])); }
        *(LAS u32x4*)(lds + L_QT + a0) = qt0; *(LAS u32x4*)(lds + L_QT + a1) = qt1; *(LAS u32x4*)(lds + L_KT + a0) = kt0_; *(LAS u32x4*)(lds + L_KT + a1) = kt1_; } }
    __syncthreads();
    if (OUT) {
      { LAS unsigned char* sb = lds + L_GB;
#pragma unroll
        for (int r = 0; r < 16; ++r) { const unsigned kl = crow(r, hi), v = 32 * vj + r32;
          *(LAS bf16_t*)(sb + 8192u * kt0 + off_b(kl, v >> 3) + (v & 7) * 2) = (bf16_t)(cvt_pk_bf16(S0[r], 0.f) & 0xffffu);
          *(LAS bf16_t*)(sb + 8192u * (kt0 + 1) + off_b(kl, v >> 3) + (v & 7) * 2) = (bf16_t)(cvt_pk_bf16(S1[r], 0.f) & 0xffffu); } }
      if (wid < 4 && !(wid == 1)) { const int ti = wid >> 1, si = wid & 1; f32x16 a = f32x16{};
#pragma unroll
        for (int s = 0; s < 8; ++s) a = __builtin_amdgcn_mfma_f32_32x32x16_bf16(row_frag(lds + L_KT, lane, si, s), row_frag(lds + L_QT, lane, ti, s), a, 0, 0, 0);
        const int tcol = 32 * ti + r32;
#pragma unroll
        for (int g = 0; g < 4; ++g) { const int s0 = 32 * si + 8 * g + 4 * hi; float x[4];
#pragma unroll
          for (int e = 0; e < 4; ++e) x[e] = (s0 + e <= tcol) ? a[4 * g + e] : 0.f;
          u32x2 w; w.x = cvt_pk_bf16(x[0], x[1]); w.y = cvt_pk_bf16(x[2], x[3]);
          *(LAS u32x2*)(lds + L_AT + at_off(tcol, 4 * si + g) + 8 * hi) = w; } }
      __syncthreads();
      { const int ti = wid >> 2; f32x16 o = f32x16{};
#pragma unroll
        for (int kk = 0; kk < 8; ++kk) o = __builtin_amdgcn_mfma_f32_32x32x16_bf16(row_frag(lds + L_QT, lane, ti, kk), tr_frag(lds + L_GB, lane, vj, kk), o, 0, 0, 0);
        const int nks = ti == 0 ? 2 : 4;
        for (int kk = 0; kk < nks; ++kk) { const bf16x8 af = *(const LAS bf16x8*)(lds + L_AT + at_off(32 * ti + r32, 2 * kk + hi));
          o = __builtin_amdgcn_mfma_f32_32x32x16_bf16(af, tr_frag(lds + L_VT, lane, vj, kk), o, 0, 0, 0); }
#pragma unroll
        for (int r = 0; r < 16; ++r) { const int rr = 32 * ti + crow(r, hi); const int t = ctok + (dir ? (63 - rr) : rr);
          Od[(size_t)t * 128 + 32 * vj + r32] = (bf16_t)(cvt_pk_bf16(o[r], 0.f) & 0xffffu); } }
    }
    { float d0[16], d1[16];
#pragma unroll
      for (int r = 0; r < 16; ++r) { d0[r] = Dl[32 * kt0 + crow(r, hi)]; d1[r] = Dl[32 * (kt0 + 1) + crow(r, hi)]; }
#pragma unroll
      for (int r = 0; r < 16; ++r) { S0[r] *= d0[r]; S1[r] *= d1[r]; }
#pragma unroll
      for (int kk = 0; kk < 4; ++kk) { const bf16x8 vf = tr_frag(lds + L_VT, lane, vj, kk);
        S0 = __builtin_amdgcn_mfma_f32_32x32x16_bf16(tr_frag(lds + L_KH, lane, kt0, kk), vf, S0, 0, 0, 0);
        S1 = __builtin_amdgcn_mfma_f32_32x32x16_bf16(tr_frag(lds + L_KH, lane, kt0 + 1, kk), vf, S1, 0, 0, 0); } }
    __syncthreads();
  }
  if (!OUT) {
#pragma unroll
    for (int r = 0; r < 16; ++r) { Sg[(size_t)(32 * kt0 + crow(r, hi)) * 128 + 32 * vj + r32] = S0[r]; Sg[(size_t)(32 * (kt0 + 1) + crow(r, hi)) * 128 + 32 * vj + r32] = S1[r]; }
    if (sr == 0) {
#pragma unroll
      for (int i = 0; i < 8; ++i) Dg[c8 + i] = __expf(bsum[i]); }
  }
}

__device__ __forceinline__ void hgrn_scan(int gthread, int nthreads, float* Sbuf, const float* Dbuf) {
  for (int e = gthread; e < 8 * 16384; e += nthreads) { const int hd = e >> 14, kv = e & 16383, k = kv >> 7;
    float* Sp = Sbuf + (size_t)hd * NSC * 16384 + kv; const float* Dp = Dbuf + (size_t)hd * NSC * 128 + k;
    float run = 0.f;
#pragma unroll 8
    for (int p = 0; p < NSC; ++p) { const float s = Sp[(size_t)p * 16384], d = Dp[p * 128]; Sp[(size_t)p * 16384] = run; run = d * run + s; } }
}
__device__ __forceinline__ void hgrn_combine(int gwave, int nwaves, int lane, const unsigned char* ws, const float* __restrict__ gg) {
  const bf16_t* Of = (const bf16_t*)(ws + WS_Q); const bf16_t* Ob = Of + (size_t)4 * T * 128; const bf16_t* HG = (const bf16_t*)(ws + WS_HG); bf16_t* mix = (bf16_t*)(ws + WS_XN);
  const float g0 = gg[2 * lane], g1 = gg[2 * lane + 1];
  for (int w = gwave; w < T * 4; w += nwaves) { const int t = w >> 2, h = w & 3;
    const unsigned f = *(const unsigned*)(Of + ((size_t)h * T + t) * 128 + 2 * lane), b = *(const unsigned*)(Ob + ((size_t)h * T + t) * 128 + 2 * lane);
    const unsigned gt = *(const unsigned*)(HG + (size_t)t * 512 + h * 128 + 2 * lane);
    const float a0 = bflo(f) + bflo(b), a1 = bfhi(f) + bfhi(b);
    const float ss = wave_sum(a0 * a0 + a1 * a1);
    const float r = 1.f / sqrtf(ss * (1.f / 128.f) + 1e-6f);
    *(unsigned*)(mix + (size_t)t * DM + 512 + h * 128 + 2 * lane) = cvt_pk_bf16(a0 * r * g0 * bflo(gt), a1 * r * g1 * bfhi(gt)); }
}
}
}
namespace mk {
struct EpiOutProj {
  const float* x; float* out;
  __device__ __forceinline__ void operator()(const f32x4 (&acc)[2][2][4][2], const Unit& u, int wr, int wc, int fr, int fq) const {
    const int row0 = u.pm * BM + wr * 64 + fr, col0 = u.pn * BM + wc * 32 + 8 * fq;
#pragma unroll
    for (int ai = 0; ai < 2; ++ai)
#pragma unroll
      for (int m = 0; m < 4; ++m) { const size_t ro = (size_t)(row0 + ai * HALF + m * 16) * DM + col0;
#pragma unroll
        for (int bj = 0; bj < 2; ++bj) { const GAS f32x4* xp = (const GAS f32x4*)(x + ro + bj * HALF); GAS f32x4* op = (GAS f32x4*)(out + ro + bj * HALF);
          const f32x4 x0 = xp[0], x1 = xp[1]; op[0] = x0 + acc[ai][bj][m][0]; op[1] = x1 + acc[ai][bj][m][1]; } }
  }
};

namespace rt {
constexpr size_t WS_WR = WS_SMALL + 64 * 1024;
constexpr size_t R_LIST = WS_ROUTE, R_CWL = WS_ROUTE + 2 * MiB, R_TINFO = WS_ROUTE + 4 * MiB;
__device__ __forceinline__ void build_wr(int gthread, int nthreads, const Args& a) {
  float* WR = (float*)(a.ws + WS_WR); const float* g = a.in[8]; const float* wgr = a.in[9]; const float* wer = a.in[11];
  for (int idx = gthread; idx < 1024 * 48; idx += nthreads) { const int k = idx / 48, j = idx % 48; float w = 0.f;
    if (j < 4) w = wgr[k * 4 + j]; else if (j < 36) { const int gi = (j - 4) >> 3, e = (j - 4) & 7; w = wer[((size_t)gi * 1024 + k) * 8 + e]; }
    WR[idx] = w * g[k]; }
}
__device__ __forceinline__ void router_phase(Frame& F, const Args& a, gu32* gcnt) {
  const float* hres = a.out; const float* g = a.in[8]; const float* WR = (const float*)(a.ws + WS_WR);
  const float* bgr = a.in[10]; const float* ber = a.in[12];
  bf16_t* XT = (bf16_t*)(a.ws + WS_XN); int* list = (int*)(a.ws + R_LIST); float* cwl = (float*)(a.ws + R_CWL); int* tinfo = (int*)(a.ws + R_TINFO);
  LAS float* lg = (LAS float*)(F.lds + F.wave * 4096); LAS int* lcnt = (LAS int*)(F.lds + 32768); LAS int* lbase = lcnt + 32;
  const int lane = F.lane, j = lane & 15, q = lane >> 4;
  const int ntile = T / 16, tpb = (ntile + F.G - 1) / F.G;
  if (F.tid < 64) lcnt[F.tid] = 0;
  __syncthreads();
  const int tile = F.vcu * tpb + F.wave; const bool active = (F.wave < tpb) && (tile < ntile);
  int e1 = 0, e2 = 0, lr1 = 0, lr2 = 0; float c1 = 0.f, c2 = 0.f; int tok = 0;
  if (active) {
    const int t0 = tile * 16;
    const float* xr = hres + (size_t)(t0 + j) * DM + 4 * q;
    f32x4 acc0 = {0.f, 0.f, 0.f, 0.f}, acc1 = acc0, acc2 = acc0; float ssq = 0.f;
#pragma unroll 4
    for (int u = 0; u < 64; ++u) { const f32x4 xv = *(const GAS f32x4*)(xr + 16 * u); ssq += (xv.x * xv.x + xv.y * xv.y) + (xv.z * xv.z + xv.w * xv.w);
      const float* wp = WR + (size_t)(16 * u + 4 * q) * 48 + j;
#pragma unroll
      for (int e = 0; e < 4; ++e) { const float av = xv[e];
        acc0 = __builtin_amdgcn_mfma_f32_16x16x4f32(av, wp[e * 48], acc0, 0, 0, 0);
        acc1 = __builtin_amdgcn_mfma_f32_16x16x4f32(av, wp[e * 48 + 16], acc1, 0, 0, 0);
        acc2 = __builtin_amdgcn_mfma_f32_16x16x4f32(av, wp[e * 48 + 32], acc2, 0, 0, 0); } }
    ssq += __shfl_xor(ssq, 16); ssq += __shfl_xor(ssq, 32);
    const float rstd = 1.f / sqrtf(ssq * (1.f / DM) + 1e-6f);
#pragma unroll
    for (int r = 0; r < 4; ++r) { lg[(4 * q + r) * 48 + j] = acc0[r]; lg[(4 * q + r) * 48 + 16 + j] = acc1[r]; lg[(4 * q + r) * 48 + 32 + j] = acc2[r]; }
    LDS_WAIT();
#pragma unroll 4
    for (int u = 0; u < 64; ++u) { const f32x4 xv = *(const GAS f32x4*)(xr + 16 * u); const f32x4 gv = *(const GAS f32x4*)(g + 16 * u + 4 * q);
      u32x2 w; w.x = cvt_pk_bf16(xv.x * rstd * gv.x, xv.y * rstd * gv.y); w.y = cvt_pk_bf16(xv.z * rstd * gv.z, xv.w * rstd * gv.w);
      *(GAS u32x2*)(XT + (size_t)(t0 + j) * DM + 16 * u + 4 * q) = w; }
    if (lane < 16) {
      tok = t0 + lane;
      float gl[4];
#pragma unroll
      for (int i = 0; i < 4; ++i) gl[i] = lg[lane * 48 + i] * rstd + bgr[i];
      int gi = 0; float gm = gl[0];
#pragma unroll
      for (int i = 1; i < 4; ++i) if (gl[i] > gm) { gm = gl[i]; gi = i; }
      float den = 0.f;
#pragma unroll
      for (int i = 0; i < 4; ++i) den += __expf(gl[i] - gm);
      const float pg = 1.f / den;
      float el[8];
#pragma unroll
      for (int i = 0; i < 8; ++i) el[i] = lg[lane * 48 + 4 + 8 * gi + i] * rstd + ber[gi * 8 + i];
      int i1 = 0; float m1 = el[0];
#pragma unroll
      for (int i = 1; i < 8; ++i) if (el[i] > m1) { m1 = el[i]; i1 = i; }
      int i2 = 0; float m2 = -3.0e38f;
#pragma unroll
      for (int i = 0; i < 8; ++i) if (i != i1 && el[i] > m2) { m2 = el[i]; i2 = i; }
      const float ex = __expf(m2 - m1); const float w1 = 1.f / (1.f + ex), w2 = ex / (1.f + ex);
      e1 = gi * 8 + i1; e2 = gi * 8 + i2; c1 = w1 * pg; c2 = w2 * pg;
      lr1 = __hip_atomic_fetch_add(lcnt + e1, 1, __ATOMIC_RELAXED, __HIP_MEMORY_SCOPE_WORKGROUP); lr2 = __hip_atomic_fetch_add(lcnt + e2, 1, __ATOMIC_RELAXED, __HIP_MEMORY_SCOPE_WORKGROUP);
    }
  }
  __syncthreads();
  if (F.tid < 32) { const int n = lcnt[F.tid]; lbase[F.tid] = n ? (int)__hip_atomic_fetch_add(gcnt + F.tid, (unsigned)n, __ATOMIC_RELAXED, __HIP_MEMORY_SCOPE_AGENT) : 0; }
  __syncthreads();
  if (active && lane < 16) { const int p1 = lbase[e1] + lr1, p2 = lbase[e2] + lr2;
    list[(size_t)e1 * T + p1] = tok; list[(size_t)e2 * T + p2] = tok; cwl[(size_t)e1 * T + p1] = c1; cwl[(size_t)e2 * T + p2] = c2;
    typedef int i32x4 __attribute__((ext_vector_type(4))); *(GAS i32x4*)(tinfo + (size_t)tok * 4) = (i32x4){e1, p1, e2, p2}; }
}
}

constexpr int MOE_TAB = RING_BYTES + 512;
__device__ __forceinline__ void moe_tables(Frame& F, gu32* gcnt) {
  LAS int* tab = (LAS int*)(F.lds + MOE_TAB);
  if (F.tid == 0) { int o = 0, c = 0; for (int e = 0; e < NEXP; ++e) { const int n = (int)__hip_atomic_load(gcnt + e, __ATOMIC_RELAXED, __HIP_MEMORY_SCOPE_AGENT); tab[e] = n; tab[32 + e] = o; tab[66 + e] = c; o += n; c += (n + 255) >> 8; } tab[64] = o; tab[98] = c; }
  __syncthreads();
}
template <bool DOWN>
struct ProbMoE {
  int K; const char* Abase; const char* Wt; const int* list; const LAS int* tab; int G, c;
  __device__ __forceinline__ bool next(int i, Unit& u) const {
    const int L = i * G + c, ntile = tab[98]; if (L >= ntile * 4) return false;
    const int tile = L >> 2; u.pn = L & 3;
    int e = 0;
#pragma unroll 1
    for (int s = 16; s >= 1; s >>= 1) if (e + s < NEXP && tab[66 + e + s] <= tile) e += s;
    u.e = e; u.pm = tile - tab[66 + e]; u.nrows = tab[e] - u.pm * 256; if (u.nrows > 256) u.nrows = 256; u.row0 = tab[32 + e] + u.pm * 256; return true;
  }
  __device__ __forceinline__ unsigned a_row_off(const Unit& u, int r) const {
    const int rr = r < u.nrows ? r : (u.nrows - 1);
    if (DOWN) return (unsigned)(u.row0 + rr) * (unsigned)K * 2u;
    const int tok = list[(size_t)u.e * T + u.pm * 256 + rr]; return (unsigned)tok * (unsigned)K * 2u;
  }
  __device__ __forceinline__ const char* b_rows(const Unit& u) const { return Wt + ((size_t)u.e * 1024 + (size_t)u.pn * 256) * K * 2; }
};
struct EpiGateUp {
  bf16_t* hid; const float* cwl;
  __device__ __forceinline__ void operator()(const f32x4 (&acc)[2][2][4][2], const Unit& u, int wr, int wc, int fr, int fq) const {
    const int f0 = u.pn * 128 + wc * 32 + 8 * fq;
#pragma unroll
    for (int ai = 0; ai < 2; ++ai)
#pragma unroll
      for (int m = 0; m < 4; ++m) { const int r = ai * HALF + wr * 64 + m * 16 + fr;
        if (r < u.nrows) { const float cw = cwl[(size_t)u.e * T + u.pm * 256 + r];
          const f32x4 a0 = acc[ai][0][m][0], a1 = acc[ai][0][m][1], u0 = acc[ai][1][m][0], u1 = acc[ai][1][m][1]; float hv[8];
#pragma unroll
          for (int i = 0; i < 4; ++i) { hv[i] = fsilu(a0[i]) * u0[i] * cw; hv[4 + i] = fsilu(a1[i]) * u1[i] * cw; }
          u32x4 w; w.x = cvt_pk_bf16(hv[0], hv[1]); w.y = cvt_pk_bf16(hv[2], hv[3]); w.z = cvt_pk_bf16(hv[4], hv[5]); w.w = cvt_pk_bf16(hv[6], hv[7]);
          *(GAS u32x4*)(hid + (size_t)(u.row0 + r) * FE + f0) = w; } }
  }
};
struct EpiDown {
  bf16_t* y;
  __device__ __forceinline__ void operator()(const f32x4 (&acc)[2][2][4][2], const Unit& u, int wr, int wc, int fr, int fq) const {
    const int col0 = u.pn * BM + wc * 32 + 8 * fq;
#pragma unroll
    for (int ai = 0; ai < 2; ++ai)
#pragma unroll
      for (int m = 0; m < 4; ++m) { const int r = ai * HALF + wr * 64 + m * 16 + fr;
        if (r < u.nrows) {
#pragma unroll
          for (int bj = 0; bj < 2; ++bj) { const f32x4 v0 = acc[ai][bj][m][0], v1 = acc[ai][bj][m][1];
            u32x4 w; w.x = cvt_pk_bf16(v0[0], v0[1]); w.y = cvt_pk_bf16(v0[2], v0[3]); w.z = cvt_pk_bf16(v1[0], v1[1]); w.w = cvt_pk_bf16(v1[2], v1[3]);
            *(GAS u32x4*)(y + (size_t)(u.row0 + r) * DM + col0 + bj * HALF) = w; } } }
  }
};
__device__ __forceinline__ void final_phase(Frame& F, const Args& a, const bf16_t* y) {
  const LAS int* tab = (const LAS int*)(F.lds + MOE_TAB); const int* tinfo = (const int*)(a.ws + rt::R_TINFO); const float* gf = a.in[16];
  const int gw = F.vcu * NWAVES + F.wave, NGW = F.G * NWAVES, lane = F.lane;
  for (int t = gw; t < T; t += NGW) { typedef int i32x4 __attribute__((ext_vector_type(4))); const i32x4 ti = *(const GAS i32x4*)(tinfo + (size_t)t * 4);
    const int s1 = tab[32 + ti[0]] + ti[1], s2 = tab[32 + ti[2]] + ti[3];
    GAS f32x4* op = (GAS f32x4*)(a.out + (size_t)t * DM) + lane; const GAS u32x2* y1 = (const GAS u32x2*)(y + (size_t)s1 * DM) + lane; const GAS u32x2* y2 = (const GAS u32x2*)(y + (size_t)s2 * DM) + lane;
    f32x4 v[4]; float s = 0.f;
#pragma unroll
    for (int jj = 0; jj < 4; ++jj) { const f32x4 hv = op[64 * jj]; const u32x2 p = y1[64 * jj], q2 = y2[64 * jj];
      v[jj].x = hv.x + bflo(p.x) + bflo(q2.x); v[jj].y = hv.y + bfhi(p.x) + bfhi(q2.x); v[jj].z = hv.z + bflo(p.y) + bflo(q2.y); v[jj].w = hv.w + bfhi(p.y) + bfhi(q2.y);
      s += (v[jj].x * v[jj].x + v[jj].y * v[jj].y) + (v[jj].z * v[jj].z + v[jj].w * v[jj].w); }
    const float rstd = 1.f / sqrtf(wave_sum(s) * (1.f / DM) + 1e-6f);
#pragma unroll
    for (int jj = 0; jj < 4; ++jj) { const f32x4 gg = ((const GAS f32x4*)gf)[lane + 64 * jj]; op[64 * jj] = v[jj] * rstd * gg; } }
}
}
namespace mk {
#ifndef MK_STAGE
#define MK_STAGE 1
#endif
constexpr int N_PHASES = 11;

__global__ void __launch_bounds__(NTHR, 2) mk_fwd(Args args) {
  extern __shared__ __attribute__((aligned(16))) unsigned char lds_raw[];
  Frame F;
  F.lds = (LAS unsigned char*)lds_raw;
  F.MISC = (volatile LAS unsigned*)(F.lds + MISC_OFF);
  F.tid = threadIdx.x; F.lane = F.tid & 63; F.wave = __builtin_amdgcn_readfirstlane(F.tid >> 6);
  F.G = gridDim.x; { const int bx = blockIdx.x; F.vcu = (F.G % 8 == 0) ? (bx % 8) * (F.G / 8) + bx / 8 : bx; }
  unsigned char* ws = args.ws;
  gu32* ctl = (gu32*)(ws + WS_CTL);
  for (int u = F.tid; u < (LDS_BYTES - RING_BYTES) / 4; u += NTHR) ((LAS unsigned*)(F.lds + RING_BYTES))[u] = 0u;
  __syncthreads();
  XcdBarrier bar = xcd_barrier_post((unsigned*)(ctl + CW_BAR), F.MISC + 8);
  const int lo = args.ph_lo, hi = args.ph_hi;
#define IN(k) (lo <= (k) && (k) < hi)
#define BOTH(k) (IN(k) && IN((k) + 1))
#define GRID_BAR() xcd_barrier(bar)

  if (IN(0)) { p0_prologue<(MK_STAGE >= 5)>(F, args); if (MK_STAGE >= 5) rt::build_wr(F.vcu * NTHR + F.tid, F.G * NTHR, args); if (BOTH(0)) GRID_BAR(); }

  if (IN(1)) {
    ProbPlain P; P.init(ws + WS_XN, ws + WS_WIN, T, NCOL, DM, F.G, (int)blockIdx.x);
    EpiInProj E{ws, (const float*)(ws + WS_ROPE), (const float*)(ws + WS_ROPE) + (size_t)T * 32};
    gemm_phase<ProbPlain, EpiInProj, true>(F.lds, P, E);
    if (BOTH(1)) GRID_BAR();
  }
  if (IN(2)) {
    if (MK_STAGE >= 3) {
      for (int it = F.vcu; it < 256; it += F.G) { int tid_ = threadIdx.x; asm volatile("" : "+v"(tid_));
        hg::hgrn_item<false>(tid_, it >> 6, (it >> 5) & 1, it & 31, ws, args.out + 8 * 1048576, args.out + 12 * 1048576, F.lds); }
    }
    const float lam = *(const float*)(ws + WS_SMALL);
    for (int u = F.vcu; u < 256; u += F.G) { int tid_ = threadIdx.x; asm volatile("" : "+v"(tid_));
      att::attn_unit(tid_, u >> 6, u & 63, ws, lam, args.in[5], args.out + (size_t)blockIdx.x * 32768, (LAS char*)F.lds); }
    if (BOTH(2)) GRID_BAR();
  }
  if (IN(3)) { hg::hgrn_scan(F.vcu * NTHR + F.tid, F.G * NTHR, args.out + 8 * 1048576, args.out + 12 * 1048576); if (BOTH(3)) GRID_BAR(); }
  if (IN(4)) {
    for (int it = F.vcu; it < 256; it += F.G) { int tid_ = threadIdx.x; asm volatile("" : "+v"(tid_));
      hg::hgrn_item<true>(tid_, it >> 6, (it >> 5) & 1, it & 31, ws, args.out + 8 * 1048576, args.out + 12 * 1048576, F.lds); }
    if (BOTH(4)) GRID_BAR();
  }
  if (IN(5)) { hg::hgrn_combine(F.vcu * NWAVES + F.wave, F.G * NWAVES, F.lane, ws, args.in[6]); if (BOTH(5)) GRID_BAR(); }
  if (IN(6)) {
    ProbPlain P; P.init(ws + WS_XN, ws + WS_WOUT, T, DM, DM, F.G, (int)blockIdx.x);
    EpiOutProj E{args.in[0], args.out};
    gemm_phase<ProbPlain, EpiOutProj, true>(F.lds, P, E);
    if (BOTH(6)) GRID_BAR();
  }
  if (IN(7)) { rt::router_phase(F, args, ctl + CW_CNT); if (BOTH(7)) GRID_BAR(); }
  if (IN(8)) {
    moe_tables(F, ctl + CW_CNT);
    ProbMoE<false> P{DM, (const char*)(ws + WS_XN), (const char*)(ws + WS_WGU), (const int*)(ws + rt::R_LIST), (const LAS int*)(F.lds + MOE_TAB), F.G, (int)blockIdx.x};
    EpiGateUp E{(bf16_t*)(ws + WS_Q), (const float*)(ws + rt::R_CWL)};
    gemm_phase<ProbMoE<false>, EpiGateUp, true>(F.lds, P, E);
    if (BOTH(8)) GRID_BAR();
  }
  if (IN(9)) {
    if (!IN(8)) moe_tables(F, ctl + CW_CNT);
    ProbMoE<true> P{FE, (const char*)(ws + WS_Q), (const char*)(ws + WS_WD), (const int*)(ws + rt::R_LIST), (const LAS int*)(F.lds + MOE_TAB), F.G, (int)blockIdx.x};
    EpiDown E{(bf16_t*)(ws + WS_V)};
    gemm_phase<ProbMoE<true>, EpiDown, true>(F.lds, P, E);
    if (BOTH(9)) GRID_BAR();
  }
  if (IN(10)) { if (!IN(8) && !IN(9)) moe_tables(F, ctl + CW_CNT); final_phase(F, args, (const bf16_t*)(ws + WS_V)); }
#undef IN
#undef BOTH
#undef GRID_BAR
}
}

extern "C" void kernel_launch(void* const* d_in, const int* in_sizes, int n_in, void* d_out, int out_size, void* d_ws, size_t ws_size, hipStream_t stream) {
  using namespace mk;
  static int grid = 0;
  if (grid == 0) {
    if (n_in != 17 || in_sizes[0] != T * DM || out_size != T * DM || ws_size < WS_END) { fprintf(stderr, "kernel_launch: unexpected shapes n_in %d out %d ws %zu (need %zu)\n", n_in, out_size, ws_size, (size_t)WS_END); grid = -1; return; }
    int dev = 0, cus = 0, per_cu = 0;
    if (hipGetDevice(&dev) != hipSuccess || hipDeviceGetAttribute(&cus, hipDeviceAttributeMultiprocessorCount, dev) != hipSuccess) { grid = -1; return; }
    if (hipFuncSetAttribute((const void*)mk_fwd, hipFuncAttributeMaxDynamicSharedMemorySize, LDS_BYTES) != hipSuccess) { fprintf(stderr, "kernel_launch: hipFuncSetAttribute failed\n"); grid = -1; return; }
    if (hipOccupancyMaxActiveBlocksPerMultiprocessor(&per_cu, (const void*)mk_fwd, NTHR, LDS_BYTES) != hipSuccess || per_cu < 1) { fprintf(stderr, "kernel_launch: occupancy query says %d blocks/CU\n", per_cu); per_cu = 1; }
    (void)hipGetLastError();
    grid = cus;
  }
  if (grid < 0) return;
  (void)hipMemsetAsync((char*)d_ws + WS_CTL, 0, CTL_ZERO_BYTES, stream);
  Args a{};
  for (int i = 0; i < 17; ++i) a.in[i] = (const float*)d_in[i];
  a.out = (float*)d_out; a.ws = (unsigned char*)d_ws;
  const int stage_hi[6] = {0, 2, 3, 6, 7, N_PHASES};
  a.ph_lo = 0; a.ph_hi = stage_hi[MK_STAGE];
  hipLaunchKernelGGL(mk_fwd, dim3(grid), dim3(NTHR), LDS_BYTES, stream, a);
#if MK_STAGE < 5
  { unsigned char* ws = (unsigned char*)d_ws; nv::Bufs b{};
    int* rt = (int*)(ws + WS_ROUTE);
    b.cnt = rt; b.off = rt + 64; b.tpos = rt + 1024; b.tcw = (float*)(rt + 1024 + 4 * T); b.cw = (float*)(rt + 1024 + 6 * T); b.list = rt + 1024 + 8 * T;
    b.scratch = (float*)d_out;
    b.Qb = (const unsigned short*)(ws + WS_Q); b.Kb = (const unsigned short*)(ws + WS_K); b.Vb = (const unsigned short*)(ws + WS_V);
    b.HQ = (const unsigned short*)(ws + WS_HQ); b.ZF = (const unsigned short*)(ws + WS_ZF); b.ZB = (const unsigned short*)(ws + WS_ZB); b.HI = (const unsigned short*)(ws + WS_HI); b.HG = (const unsigned short*)(ws + WS_HG);
    b.mixb = (unsigned short*)(ws + WS_XN);
    b.xt = (float*)(ws + WS_Q); b.hid = (float*)(ws + WS_Q + 64 * MiB);
    nv::run(d_in, (float*)d_out, b, MK_STAGE, stream); }
#endif
}
```

```cpp
#define MK_STAGE 5
#define MK_REPEAT_MASK 0
#include <hip/hip_runtime.h>
#include <cstdio>
#include <cstdint>
#include <cmath>
namespace mk {
#define LAS __attribute__((address_space(3)))
#define GAS __attribute__((address_space(1)))
typedef unsigned short bf16_t;
typedef short bf16x8 __attribute__((ext_vector_type(8)));
typedef short s16x4 __attribute__((ext_vector_type(4)));
typedef float f32x4 __attribute__((ext_vector_type(4)));
typedef float f32x2 __attribute__((ext_vector_type(2)));
typedef float f32x16 __attribute__((ext_vector_type(16)));
typedef unsigned u32x4 __attribute__((ext_vector_type(4)));
typedef unsigned u32x2 __attribute__((ext_vector_type(2)));
typedef GAS unsigned gu32;

constexpr int T = 16384, DM = 1024, NCOL = 4096, NEXP = 32, FE = 512;
constexpr int NWAVES = 8, NTHR = 512;
constexpr float LOG2E = 1.4426950408889634f;

__device__ __forceinline__ unsigned cvt_pk_bf16(float lo, float hi) { unsigned r; asm volatile("v_cvt_pk_bf16_f32 %0, %1, %2" : "=v"(r) : "v"(lo), "v"(hi)); return r; }
__device__ __forceinline__ float bf2f(unsigned short h) { return __uint_as_float((unsigned)h << 16); }
__device__ __forceinline__ float bflo(unsigned w) { return __uint_as_float(w << 16); }
__device__ __forceinline__ float bfhi(unsigned w) { return __uint_as_float(w & 0xffff0000u); }
__device__ __forceinline__ float wave_sum(float v) {
#pragma unroll
  for (int o = 1; o < 64; o <<= 1) v += __shfl_xor(v, o);
  return v;
}
__device__ __forceinline__ float fsigm(float z) { return 1.f / (1.f + __expf(-z)); }
__device__ __forceinline__ float fsilu(float z) { return z / (1.f + __expf(-z)); }
#define LDS_WAIT() asm volatile("s_waitcnt lgkmcnt(0)" ::: "memory")
#define VM_WAIT() asm volatile("s_waitcnt vmcnt(0)" ::: "memory")

#define XB_TMO      128
#define XB_XCNT(j)  (256  + 64 * (j))
#define XB_XSUB(j)  (1280 + 64 * (j))
#define XB_XGEN(j)  (2304 + 64 * (j))
#define XB_TOP      3328
#define XB_TOPGEN   3392
#define XCD_BAR_WORDS 3456
#define XB_SPIN_CAP (1u << 22)
__device__ __forceinline__ unsigned xb_ld(unsigned* p)              { return __hip_atomic_load(p, __ATOMIC_RELAXED, __HIP_MEMORY_SCOPE_AGENT); }
__device__ __forceinline__ unsigned xb_add(unsigned* p, unsigned v) { return __hip_atomic_fetch_add(p, v, __ATOMIC_RELAXED, __HIP_MEMORY_SCOPE_AGENT); }
__device__ __forceinline__ unsigned xb_xcc_id() { return (unsigned)__builtin_amdgcn_s_getreg((3 << 11) | 20) & 0xFu; }
#define XB_SPIN(cond, bar) do { unsigned _sp = 0; while (cond) { __builtin_amdgcn_s_sleep(1); \
    if ((++_sp & 255u) == 0u) { if (xb_ld(&(bar)[XB_TMO])) break; if (_sp > XB_SPIN_CAP) { atomicAdd(&(bar)[XB_TMO], 1u); break; } } } } while (0)
struct XcdBarrier { unsigned* bar; unsigned x; volatile LAS unsigned* st; };
__device__ __forceinline__ XcdBarrier xcd_barrier_post(unsigned* bar, volatile LAS unsigned* st) {
  XcdBarrier b; b.bar = bar; b.x = xb_xcc_id(); b.st = st;
  if (threadIdx.x == 0) (void)xb_add(&bar[XB_XCNT(b.x)], 1u);
  return b;
}
__device__ __forceinline__ void xcd_barrier_complete(unsigned* bar, unsigned x, unsigned& nloc, unsigned& nx) {
  const unsigned G = gridDim.x * gridDim.y * gridDim.z;
  unsigned sum, cnt, mine, sp = 0u;
  for (;;) {
    sum = 0u; cnt = 0u; mine = 0u;
#pragma unroll
    for (unsigned j = 0; j < 16; ++j) { const unsigned c = xb_ld(&bar[XB_XCNT(j)]); sum += c; cnt += (c > 0u) ? 1u : 0u; mine = (j == x) ? c : mine; }
    if (sum == G) break;
    __builtin_amdgcn_s_sleep(1);
    if ((++sp & 255u) == 0u) { if (xb_ld(&bar[XB_TMO])) break; if (sp > XB_SPIN_CAP) { atomicAdd(&bar[XB_TMO], 1u); break; } }
  }
  nloc = mine > 0u ? mine : 1u; nx = cnt > 0u ? cnt : 1u;
}
__device__ __forceinline__ void xcd_barrier(const XcdBarrier& b) {
  asm volatile("s_waitcnt vmcnt(0)" ::: "memory");
  __syncthreads();
  if (threadIdx.x == 0) {
    unsigned* bar = b.bar;
    __builtin_amdgcn_s_waitcnt(0);
    unsigned nloc = b.st[0], nx = b.st[1];
    if (nloc == 0u) { xcd_barrier_complete(bar, b.x, nloc, nx); b.st[0] = nloc; b.st[1] = nx; }
    const unsigned old = xb_add(&bar[XB_XSUB(b.x)], 1u);
    const unsigned gen = old / nloc;
    if (old + 1u == (gen + 1u) * nloc) {
      __builtin_amdgcn_fence(__ATOMIC_RELEASE, "agent");
      asm volatile("s_waitcnt vmcnt(0)" ::: "memory");
      const unsigned og = xb_add(&bar[XB_TOP], 1u);
      const unsigned tg = og / nx;
      if (og + 1u == (tg + 1u) * nx) xb_add(&bar[XB_TOPGEN], 1u);
      else XB_SPIN(xb_ld(&bar[XB_TOPGEN]) == tg, bar);
      __builtin_amdgcn_fence(__ATOMIC_ACQUIRE, "agent");
      xb_add(&bar[XB_XGEN(b.x)], 1u);
      asm volatile("s_waitcnt vmcnt(0)" ::: "memory");
    } else {
      XB_SPIN(xb_ld(&bar[XB_XGEN(b.x)]) == gen, bar);
      __builtin_amdgcn_fence(__ATOMIC_ACQUIRE, "agent");
      asm volatile("s_waitcnt vmcnt(0)" ::: "memory");
    }
  }
  __syncthreads();
}

constexpr int BM = 256, BK = 64, HALF = 128, HTB = HALF * BK * 2, STAGE_BYTES = 8 * HTB, NXCD = 8, WGM = 8;
__device__ __forceinline__ int lds_byte(int r, int c) { const int st = (r >> 4) * 2 + (c >> 5), rr = r & 15, cc = c & 31, ob = rr * 64 + cc * 2; return st * 1024 + (ob ^ (((ob >> 9) & 1) << 5)); }
__device__ __forceinline__ void stage_rc(int b, int& R, int& C) { const int st = b / 1024, sb = b % 1024, swz = sb ^ (((sb >> 9) & 1) << 5); R = (st >> 1) * 16 + swz / 64; C = (st & 1) * 32 + (swz % 64) / 2; }
__device__ __forceinline__ int perm32(int rho) { const int n = rho >> 4, i = rho & 15; return 8 * (i >> 2) + 4 * n + (i & 3); }

struct Unit { int pm, pn, e, nrows, row0; };

template <class Prob, class Epi, bool ALIGN_EPI>
__device__ __forceinline__ void gemm_phase(LAS unsigned char* lds, const Prob& P, const Epi& E) {
  const int tid = threadIdx.x, wid = __builtin_amdgcn_readfirstlane(tid >> 6), lane = tid & 63, wr = wid >> 2, wc = wid & 3, fr = lane & 15, fq = lane >> 4;
  const int K = P.K, nt = K / BK;
  int Rr[2], Cc[2]; unsigned voffB[2];
#pragma unroll
  for (int i = 0; i < 2; ++i) { int R, C; stage_rc(tid * 16 + i * 8192, R, C); Rr[i] = R; Cc[i] = C; const int Rb = (R & ~31) + perm32(R & 31); voffB[i] = (unsigned)(Rb * K + C) * 2u; }
  const size_t kstep = (size_t)(BK * 2);
  const size_t hstep = (size_t)HALF * K * 2;
  const unsigned ldsw = (unsigned)wid * 1024u;
  const int aoff = lds_byte(wr * 64 + fr, fq * 8), boff = lds_byte(wc * 32 + fr, fq * 8);
#define PG8_SA(b, h) (((b) * 2 + (h)) * HTB)
#define PG8_SB(b, h) ((4 + (b) * 2 + (h)) * HTB)
#define PG8_STAGE(bufoff, gbase, voff) do { _Pragma("unroll") for (int _i = 0; _i < 2; ++_i) \
        __builtin_amdgcn_global_load_lds((const unsigned*)((const char*)(gbase) + (voff)[_i]), (LAS unsigned*)(lds + (bufoff) + ldsw + _i * 8192), 16, 0, 0); } while (0)
#define PG8_LDA(dst, b, h) do { _Pragma("unroll") for (int m = 0; m < 4; ++m) _Pragma("unroll") for (int k = 0; k < 2; ++k) dst[m][k] = *(const LAS bf16x8*)(lds + PG8_SA(b, h) + aoff + m * 2048 + k * 1024); } while (0)
#define PG8_LDB(dst, b, h) do { _Pragma("unroll") for (int n = 0; n < 2; ++n) _Pragma("unroll") for (int k = 0; k < 2; ++k) dst[n][k] = *(const LAS bf16x8*)(lds + PG8_SB(b, h) + boff + n * 2048 + k * 1024); } while (0)
#define PG8_MMA(ai, bj, At, Bt) do { __builtin_amdgcn_s_setprio(1); _Pragma("unroll") for (int m = 0; m < 4; ++m) _Pragma("unroll") for (int n = 0; n < 2; ++n) _Pragma("unroll") for (int k = 0; k < 2; ++k) \
        acc[ai][bj][m][n] = __builtin_amdgcn_mfma_f32_16x16x32_bf16(Bt[n][k], At[m][k], acc[ai][bj][m][n], 0, 0, 0); __builtin_amdgcn_s_setprio(0); } while (0)
#define PG8_WAIT_V(n) asm volatile("s_waitcnt vmcnt(" #n ")" ::: "memory")
#define PG8_WAIT_L(n) asm volatile("s_waitcnt lgkmcnt(" #n ")" ::: "memory")
#define PG8_BAR __builtin_amdgcn_s_barrier()
#define PG8_SCHED __builtin_amdgcn_sched_barrier(0)
  Unit cur, nxt; int ui = 0;
  if (!P.next(0, cur)) return;
  f32x4 acc[2][2][4][2];
#pragma unroll
  for (int a = 0; a < 2; ++a)
#pragma unroll
    for (int b = 0; b < 2; ++b)
#pragma unroll
      for (int m = 0; m < 4; ++m)
#pragma unroll
        for (int n = 0; n < 2; ++n) acc[a][b][m][n] = (f32x4){0.f, 0.f, 0.f, 0.f};
  bf16x8 At[4][2], B0[2][2], B1[2][2];
  unsigned aC0[2], aC1[2], aN0[2], aN1[2];
#pragma unroll
  for (int i = 0; i < 2; ++i) { aC0[i] = P.a_row_off(cur, Rr[i]) + (unsigned)Cc[i] * 2u; aC1[i] = P.a_row_off(cur, HALF + Rr[i]) + (unsigned)Cc[i] * 2u; aN0[i] = aC0[i]; aN1[i] = aC1[i]; }
  const char* const cAb = P.Abase;
  const char* cB = P.b_rows(cur);
  PG8_STAGE(PG8_SB(0, 0), cB, voffB); PG8_STAGE(PG8_SB(0, 1), cB + hstep, voffB); PG8_STAGE(PG8_SA(0, 0), cAb, aC0); PG8_STAGE(PG8_SA(0, 1), cAb, aC1);
  if (wr == 1) PG8_BAR;
  PG8_WAIT_V(2); PG8_BAR;
  PG8_STAGE(PG8_SB(1, 0), cB + kstep, voffB); PG8_STAGE(PG8_SA(1, 0), cAb + kstep, aC0); PG8_STAGE(PG8_SB(1, 1), cB + hstep + kstep, voffB);
  PG8_WAIT_V(6); PG8_BAR;
  for (;;) {
    const bool has_next = P.next(ui + 1, nxt);
    const char* nB = cB;
    if (has_next) { nB = P.b_rows(nxt);
#pragma unroll
      for (int i = 0; i < 2; ++i) { aN0[i] = P.a_row_off(nxt, Rr[i]) + (unsigned)Cc[i] * 2u; aN1[i] = P.a_row_off(nxt, HALF + Rr[i]) + (unsigned)Cc[i] * 2u; }
    } else {
#pragma unroll
      for (int i = 0; i < 2; ++i) { aN0[i] = aC0[i]; aN1[i] = aC1[i]; }
    }
    for (int t = 0; t < nt; t += 2) {
      const bool last = (t == nt - 2);
      const char* a1 = cAb + (size_t)(t + 1) * kstep;
      const char* a2 = last ? cAb : cAb + (size_t)(t + 2) * kstep; const char* b2 = last ? nB : cB + (size_t)(t + 2) * kstep;
      const char* a3 = a2 + kstep; const char* b3 = b2 + kstep;
      unsigned s0[2], s1[2];
#pragma unroll
      for (int i = 0; i < 2; ++i) { s0[i] = last ? aN0[i] : aC0[i]; s1[i] = last ? aN1[i] : aC1[i]; }
      PG8_LDB(B0, 0, 0); PG8_LDB(B1, 0, 1); PG8_SCHED; PG8_LDA(At, 0, 0); PG8_STAGE(PG8_SA(1, 1), a1, aC1);
      PG8_WAIT_V(8); PG8_WAIT_L(0); PG8_BAR; PG8_MMA(0, 0, At, B0); PG8_MMA(0, 1, At, B1); PG8_BAR; PG8_SCHED;
      PG8_LDA(At, 0, 1); PG8_STAGE(PG8_SB(0, 0), b2, voffB); PG8_STAGE(PG8_SB(0, 1), b2 + hstep, voffB); PG8_STAGE(PG8_SA(0, 0), a2, s0);
      PG8_WAIT_V(8); PG8_WAIT_L(0); PG8_BAR; PG8_MMA(1, 0, At, B0); PG8_MMA(1, 1, At, B1); PG8_BAR; PG8_SCHED;
      PG8_LDB(B0, 1, 0); PG8_LDB(B1, 1, 1); PG8_SCHED; PG8_LDA(At, 1, 0); PG8_STAGE(PG8_SA(0, 1), a2, s1);
      PG8_WAIT_V(8); PG8_WAIT_L(0); PG8_BAR; PG8_MMA(0, 0, At, B0); PG8_MMA(0, 1, At, B1); PG8_BAR; PG8_SCHED;
      PG8_LDA(At, 1, 1); PG8_STAGE(PG8_SB(1, 0), b3, voffB); PG8_STAGE(PG8_SB(1, 1), b3 + hstep, voffB); PG8_STAGE(PG8_SA(1, 0), a3, s0);
      PG8_WAIT_V(8); PG8_WAIT_L(0); PG8_BAR; PG8_MMA(1, 0, At, B0); PG8_MMA(1, 1, At, B1); PG8_BAR; PG8_SCHED;
    }
    if constexpr (ALIGN_EPI) { if (wr == 0) PG8_BAR; }
    E(acc, cur, wr, wc, fr, fq);
    if (!has_next) break;
#pragma unroll
    for (int a = 0; a < 2; ++a)
#pragma unroll
      for (int b = 0; b < 2; ++b)
#pragma unroll
        for (int m = 0; m < 4; ++m)
#pragma unroll
          for (int n = 0; n < 2; ++n) acc[a][b][m][n] = (f32x4){0.f, 0.f, 0.f, 0.f};
    cur = nxt; cB = nB; ++ui;
#pragma unroll
    for (int i = 0; i < 2; ++i) { aC0[i] = aN0[i]; aC1[i] = aN1[i]; }
    if constexpr (ALIGN_EPI) { if (wr == 1) PG8_BAR; }
  }
  PG8_WAIT_V(0);
  if constexpr (!ALIGN_EPI) { if (wr == 0) PG8_BAR; }
  PG8_BAR;
#undef PG8_SA
#undef PG8_SB
#undef PG8_STAGE
#undef PG8_LDA
#undef PG8_LDB
#undef PG8_MMA
#undef PG8_WAIT_V
#undef PG8_WAIT_L
#undef PG8_BAR
#undef PG8_SCHED
}
}
namespace mk {
constexpr size_t MiB = 1u << 20;
constexpr size_t WS_CTL = 0, CTL_ZERO_BYTES = 256 * 1024;
constexpr size_t WS_SMALL = 512 * 1024;
constexpr size_t WS_WIN = 1 * MiB;
constexpr size_t WS_WOUT = 9 * MiB;
constexpr size_t WS_ROPE = 11 * MiB;
constexpr size_t WS_ROUTE = 15 * MiB;
constexpr size_t WS_WGU = 20 * MiB;
constexpr size_t WS_XN = 84 * MiB;
constexpr size_t WS_Q = 116 * MiB;
constexpr size_t WS_K = 132 * MiB;
constexpr size_t WS_V = 148 * MiB;
constexpr size_t WS_HQ = 164 * MiB;
constexpr size_t WS_ZF = 180 * MiB;
constexpr size_t WS_ZB = 196 * MiB;
constexpr size_t WS_HI = 212 * MiB;
constexpr size_t WS_HG = 228 * MiB;
constexpr size_t WS_WD = 244 * MiB;
constexpr size_t WS_END = 276 * MiB;
constexpr int CW_BAR = 1024;
constexpr int CW_CNT = 8192;

constexpr int RING_BYTES = 131072;
constexpr int MISC_OFF = RING_BYTES + 320;
constexpr int LDS_BYTES = 147456;

struct Args {
  const float* in[17]; float* out; unsigned char* ws; int ph_lo, ph_hi;
};

struct Frame {
  LAS unsigned char* lds;
  volatile LAS unsigned* MISC;
  int tid, lane, wave, vcu, G;
};

__device__ __forceinline__ void transpose_item(const float* W, int ldw, int k0, int n0, bf16_t* WT, int Kdst, int dst_row0, LAS float* scr, int lane) {
#pragma unroll 8
  for (int i = 0; i < 32; ++i) { const int kk = 2 * i + (lane >> 5); scr[kk * 33 + (lane & 31)] = W[(size_t)(k0 + kk) * ldw + n0 + (lane & 31)]; }
  LDS_WAIT(); asm volatile("" ::: "memory");
  const int c = lane & 7;
#pragma unroll
  for (int j = 0; j < 4; ++j) { const int n = (lane >> 3) + 8 * j; const LAS float* s = scr + (8 * c) * 33 + n;
    u32x4 o; o.x = cvt_pk_bf16(s[0 * 33], s[1 * 33]); o.y = cvt_pk_bf16(s[2 * 33], s[3 * 33]); o.z = cvt_pk_bf16(s[4 * 33], s[5 * 33]); o.w = cvt_pk_bf16(s[6 * 33], s[7 * 33]);
    *(GAS u32x4*)(WT + (size_t)(dst_row0 + n) * Kdst + k0 + 8 * c) = o; }
  LDS_WAIT(); asm volatile("" ::: "memory");
}
__device__ __forceinline__ int inproj_dst_col(int n0) {
  if (n0 >= 1024) return n0;
  const int R = n0 >> 9, rem = n0 & 511, hc = rem >> 6, bj = (rem >> 5) & 1;
  return R * 512 + (hc >> 2) * 256 + bj * 128 + (hc & 3) * 32;
}
__device__ __forceinline__ void rms_row_to_bf16(const float* xrow, const float* g, bf16_t* orow, int lane) {
  const GAS f32x4* xr = (const GAS f32x4*)xrow + lane;
  f32x4 v[4]; float s = 0.f;
#pragma unroll
  for (int j = 0; j < 4; ++j) { v[j] = xr[64 * j]; s += (v[j].x * v[j].x + v[j].y * v[j].y) + (v[j].z * v[j].z + v[j].w * v[j].w); }
  const float rstd = 1.f / sqrtf(wave_sum(s) * (1.f / DM) + 1e-6f);
  GAS u32x2* o8 = (GAS u32x2*)orow + lane;
#pragma unroll
  for (int j = 0; j < 4; ++j) { const f32x4 gg = ((const GAS f32x4*)g)[lane + 64 * j]; u32x2 w; w.x = cvt_pk_bf16(v[j].x * rstd * gg.x, v[j].y * rstd * gg.y); w.y = cvt_pk_bf16(v[j].z * rstd * gg.z, v[j].w * rstd * gg.w); o8[64 * j] = w; }
}

template <bool MOE_W>
__device__ __forceinline__ void p0_prologue(Frame& F, const Args& a) {
  LAS float* scr = (LAS float*)(F.lds + F.wave * 16384);
  const int gw = F.vcu * NWAVES + F.wave, NGW = F.G * NWAVES;
  const float* w_in = a.in[1]; const float* w_out = a.in[2];
  bf16_t* WinT = (bf16_t*)(a.ws + WS_WIN); bf16_t* WoutT = (bf16_t*)(a.ws + WS_WOUT);
  constexpr int I_IN = 16 * 128, I_OUT = 16 * 32, I_G = 32 * 16 * 16, I_D = 32 * 8 * 32;
  const int NITEMS = I_IN + I_OUT + (MOE_W ? (2 * I_G + I_D) : 0);
  for (int it = gw; it < NITEMS; it += NGW) {
    int r = it;
    if (r < I_IN) { const int kb = r / 128, nb = r % 128; transpose_item(w_in, NCOL, 64 * kb, 32 * nb, WinT, DM, inproj_dst_col(32 * nb), scr, F.lane); continue; } r -= I_IN;
    if (r < I_OUT) { const int kb = r / 32, nb = r % 32; transpose_item(w_out, DM, 64 * kb, 32 * nb, WoutT, DM, 32 * nb, scr, F.lane); continue; } r -= I_OUT;
    if (MOE_W) {
      bf16_t* WguT = (bf16_t*)(a.ws + WS_WGU); bf16_t* WdT = (bf16_t*)(a.ws + WS_WD);
      if (r < 2 * I_G) { const int which = r / I_G; r -= which * I_G; const int e = r / 256, q = r % 256, kb = q / 16, nb = q % 16;
        const float* W = (which ? a.in[14] : a.in[13]) + (size_t)e * DM * FE; const int f0 = 32 * nb;
        transpose_item(W, FE, 64 * kb, f0, WguT + (size_t)e * 1024 * DM, DM, (f0 >> 7) * 256 + which * 128 + (f0 & 127), scr, F.lane); continue; } r -= 2 * I_G;
      { const int e = r / 256, q = r % 256, kb = q / 32, nb = q % 32;
        transpose_item(a.in[15] + (size_t)e * FE * DM, DM, 64 * kb, 32 * nb, WdT + (size_t)e * DM * FE, FE, 32 * nb, scr, F.lane); }
    }
  }
  { const float* x = a.in[0]; bf16_t* XN = (bf16_t*)(a.ws + WS_XN);
    for (int m = gw; m < T; m += NGW) rms_row_to_bf16(x + (size_t)m * DM, a.in[3], XN + (size_t)m * DM, F.lane); }
  { float* cs = (float*)(a.ws + WS_ROPE); float* sn = cs + (size_t)T * 32;
    const int gt = F.vcu * NTHR + F.tid, NGT = F.G * NTHR;
    for (int idx = gt; idx < T * 32; idx += NGT) { const int j = idx & 31, t = idx >> 5;
      const float inv = powf(10000.0f, -(float)(2 * j) / 64.0f); const float ang = (float)t * inv;
      const double ad = (double)ang; const double kq = rint(ad * 0.15915494309189535); const float rr = (float)(ad - kq * 6.283185307179586);
      cs[idx] = cosf(rr); sn[idx] = sinf(rr); } }
  if (F.vcu == 0 && F.wave == 0) {
    float* sm = (float*)(a.ws + WS_SMALL); const float* lp = a.in[4];
    float d1 = lp[F.lane] * lp[64 + F.lane], d2 = lp[128 + F.lane] * lp[192 + F.lane];
    d1 = wave_sum(d1); d2 = wave_sum(d2);
    if (F.lane == 0) sm[0] = expf(d1) - expf(d2) + 0.2f;
    const float* lbl = a.in[7];
    for (int i = F.lane; i < 1024; i += 64) { const int dir = i >> 9, c = i & 511; const float a0 = lbl[(dir * 2 + 0) * 512 + c], a1 = lbl[(dir * 2 + 1) * 512 + c];
      const float mx = fmaxf(a0, a1); const float e0 = expf(a0 - mx), e1 = expf(a1 - mx); sm[64 + i] = e0 / (e0 + e1); }
  }
}

struct ProbPlain {
  int K; const char* Abase; const char* Bt; int nM, nN, nwg, G, c;
  __device__ __forceinline__ void init(const void* A, const void* B, int M, int N, int K_, int G_, int c_) { Abase = (const char*)A; Bt = (const char*)B; K = K_; nM = M / BM; nN = N / BM; nwg = nM * nN; G = G_; c = c_; }
  __device__ __forceinline__ bool next(int i, Unit& u) const {
    const long L = (long)i * G + c; if (L >= nwg) return false;
    int wgid = (int)L; { const int q = nwg / NXCD, r = nwg % NXCD, xcd = wgid % NXCD, off = wgid / NXCD; wgid = (xcd < r ? xcd * (q + 1) : r * (q + 1) + (xcd - r) * q) + off; }
    const int nig = WGM * nN, gid = wgid / nig, fm = gid * WGM, gsz = (nM - fm) < WGM ? (nM - fm) : WGM;
    u.pm = fm + ((wgid % nig) % gsz); u.pn = (wgid % nig) / gsz; u.e = 0; u.nrows = 256; u.row0 = u.pm * 256; return true;
  }
  __device__ __forceinline__ unsigned a_row_off(const Unit& u, int r) const { return (unsigned)(u.pm * BM + r) * (unsigned)K * 2u; }
  __device__ __forceinline__ const char* b_rows(const Unit& u) const { return Bt + (size_t)u.pn * BM * K * 2; }
};

struct EpiInProj {
  unsigned char* ws; const float* cs; const float* sn;
  __device__ __forceinline__ void operator()(const f32x4 (&acc)[2][2][4][2], const Unit& u, int wr, int wc, int fr, int fq) const {
    const int row0 = u.pm * BM + wr * 64 + fr, pn = u.pn;
    if (pn < 4) {
      bf16_t* base = (bf16_t*)(ws + (pn < 2 ? WS_Q : WS_K)) + (size_t)(4 * (pn & 1) + wc) * T * 64;
#pragma unroll
      for (int ai = 0; ai < 2; ++ai)
#pragma unroll
        for (int m = 0; m < 4; ++m) { const int t = row0 + ai * HALF + m * 16;
          const f32x4 c0 = *(const f32x4*)(cs + (size_t)t * 32 + 8 * fq), c1 = *(const f32x4*)(cs + (size_t)t * 32 + 8 * fq + 4);
          const f32x4 s0 = *(const f32x4*)(sn + (size_t)t * 32 + 8 * fq), s1 = *(const f32x4*)(sn + (size_t)t * 32 + 8 * fq + 4);
          const f32x4 x1a = acc[ai][0][m][0], x1b = acc[ai][0][m][1], x2a = acc[ai][1][m][0], x2b = acc[ai][1][m][1];
          const float qs = pn < 2 ? 0.125f * LOG2E : 1.f;
          const f32x4 o1a = (x1a * c0 - x2a * s0) * qs, o1b = (x1b * c1 - x2b * s1) * qs, o2a = (x1a * s0 + x2a * c0) * qs, o2b = (x1b * s1 + x2b * c1) * qs;
          u32x4 w1, w2; w1.x = cvt_pk_bf16(o1a[0], o1a[1]); w1.y = cvt_pk_bf16(o1a[2], o1a[3]); w1.z = cvt_pk_bf16(o1b[0], o1b[1]); w1.w = cvt_pk_bf16(o1b[2], o1b[3]);
          w2.x = cvt_pk_bf16(o2a[0], o2a[1]); w2.y = cvt_pk_bf16(o2a[2], o2a[3]); w2.z = cvt_pk_bf16(o2b[0], o2b[1]); w2.w = cvt_pk_bf16(o2b[2], o2b[3]);
          bf16_t* rp = base + (size_t)t * 64 + 8 * fq;
          *(u32x4*)rp = w1; *(u32x4*)(rp + 32) = w2; }
    } else if (pn < 6) {
#pragma unroll
      for (int bj = 0; bj < 2; ++bj) { bf16_t* base = (bf16_t*)(ws + WS_V) + (size_t)(2 * (pn - 4) + bj) * T * 128 + wc * 32 + 8 * fq;
#pragma unroll
        for (int ai = 0; ai < 2; ++ai)
#pragma unroll
          for (int m = 0; m < 4; ++m) { const int t = row0 + ai * HALF + m * 16; const f32x4 v0 = acc[ai][bj][m][0], v1 = acc[ai][bj][m][1];
            u32x4 w; w.x = cvt_pk_bf16(v0[0], v0[1]); w.y = cvt_pk_bf16(v0[2], v0[3]); w.z = cvt_pk_bf16(v1[0], v1[1]); w.w = cvt_pk_bf16(v1[2], v1[3]);
            *(u32x4*)(base + (size_t)t * 128) = w; } }
    } else {
      const int reg = (pn - 6) >> 1; const bool act = (reg == 0) || (reg == 4);
      bf16_t* base = (bf16_t*)(ws + WS_HQ + (size_t)reg * 16 * MiB) + ((pn - 6) & 1) * 256 + wc * 32 + 8 * fq;
#pragma unroll
      for (int bj = 0; bj < 2; ++bj)
#pragma unroll
        for (int ai = 0; ai < 2; ++ai)
#pragma unroll
          for (int m = 0; m < 4; ++m) { const int t = row0 + ai * HALF + m * 16; f32x4 v0 = acc[ai][bj][m][0], v1 = acc[ai][bj][m][1];
            if (act) {
#pragma unroll
              for (int i = 0; i < 4; ++i) { v0[i] = fsilu(v0[i]); v1[i] = fsilu(v1[i]); } }
            u32x4 w; w.x = cvt_pk_bf16(v0[0], v0[1]); w.y = cvt_pk_bf16(v0[2], v0[3]); w.z = cvt_pk_bf16(v1[0], v1[1]); w.w = cvt_pk_bf16(v1[2], v1[3]);
            *(u32x4*)(base + (size_t)t * 512 + bj * 128) = w; }
    }
  }
};
}
namespace mk {
namespace att {
constexpr int NW = 8, QBLK = 32, KVBLK = 64, DV = 128, DQK = 64;
constexpr float SCALE = 1.0f / LOG2E;
constexpr float THR = 8.f;
constexpr int SHM_V = KVBLK * DV * 2, SHM_K = KVBLK * DQK * 2;
constexpr int SHM_ATTN = 2 * SHM_V + 2 * SHM_K + NW * 64 * 4;
#define KSWZ(row, colB) ((row) * 128 + ((colB) ^ ((((row) >> 1) & 7) << 4)))
#define SBAR() __builtin_amdgcn_sched_barrier(0)
__device__ __forceinline__ int crow(int r, int hi) { return (r & 3) + 8 * (r >> 2) + 4 * hi; }

__device__ __forceinline__ void partialSM(f32x16& p0, f32x16& p1, float& m_reg, float& mn, float& alpha) {
  constexpr float C = SCALE * LOG2E;
  float pmax = p0[0];
#pragma unroll
  for (int r = 1; r < 16; ++r) pmax = fmaxf(pmax, p0[r]);
#pragma unroll
  for (int r = 0; r < 16; ++r) pmax = fmaxf(pmax, p1[r]);
  { auto rr = __builtin_amdgcn_permlane32_swap(__float_as_uint(pmax), __float_as_uint(pmax), false, false);
    pmax = fmaxf(__uint_as_float(rr[0]), __uint_as_float(rr[1])); }
  if (__builtin_expect(__all(pmax - m_reg <= THR / SCALE), 1)) { mn = m_reg; alpha = 1.f; }
  else { mn = fmaxf(m_reg, pmax); alpha = __builtin_amdgcn_exp2f((m_reg - mn) * C); m_reg = mn; }
  const float mnC = -mn * C;
#pragma unroll
  for (int r = 0; r < 16; ++r) p0[r] = fmaf(p0[r], C, mnC);
#pragma unroll
  for (int r = 0; r < 16; ++r) p1[r] = fmaf(p1[r], C, mnC);
#pragma unroll
  for (int r = 0; r < 16; ++r) p0[r] = __builtin_amdgcn_exp2f(p0[r]);
}
__device__ __forceinline__ void finishSM(f32x16& p0, f32x16& p1, float alpha, float& l_reg, bf16x8& pa0, bf16x8& pa1, bf16x8& pa2, bf16x8& pa3) {
#pragma unroll
  for (int r = 0; r < 16; ++r) p1[r] = __builtin_amdgcn_exp2f(p1[r]);
  float ps = 0;
#pragma unroll
  for (int r = 0; r < 16; ++r) ps += p0[r];
#pragma unroll
  for (int r = 0; r < 16; ++r) ps += p1[r];
  { auto rr = __builtin_amdgcn_permlane32_swap(__float_as_uint(ps), __float_as_uint(ps), false, false);
    ps = __uint_as_float(rr[0]) + __uint_as_float(rr[1]); }
  l_reg = l_reg * alpha + ps;
#define PK4(P, BASE, OUT) do { unsigned a0 = cvt_pk_bf16(P[BASE + 0], P[BASE + 1]), a1 = cvt_pk_bf16(P[BASE + 2], P[BASE + 3]);   \
    unsigned b0 = cvt_pk_bf16(P[BASE + 4], P[BASE + 5]), b1 = cvt_pk_bf16(P[BASE + 6], P[BASE + 7]);                              \
    auto r0 = __builtin_amdgcn_permlane32_swap(a0, b0, false, false); auto r1 = __builtin_amdgcn_permlane32_swap(a1, b1, false, false); \
    u32x4 w = {r0[0], r1[0], r0[1], r1[1]}; OUT = __builtin_bit_cast(bf16x8, w); } while (0)
  PK4(p0, 0, pa0); PK4(p0, 8, pa1); PK4(p1, 0, pa2); PK4(p1, 8, pa3);
#undef PK4
}
__device__ __forceinline__ void qkt(f32x16& p0, f32x16& p1, const LAS char* Ks, const bf16x8* qr, int r32, int hi) {
  p0 = f32x16{}; p1 = f32x16{};
#pragma unroll
  for (int d0 = 0; d0 < 4; ++d0) { const int cb = (d0 * 16 + hi * 8) * 2;
    const bf16x8 b0 = *(const LAS bf16x8*)(Ks + KSWZ(r32, cb));
    const bf16x8 b1 = *(const LAS bf16x8*)(Ks + KSWZ(32 + r32, cb));
    p0 = __builtin_amdgcn_mfma_f32_32x32x16_bf16(b0, qr[d0], p0, 0, 0, 0);
    p1 = __builtin_amdgcn_mfma_f32_32x32x16_bf16(b1, qr[d0], p1, 0, 0, 0); }
}
__device__ __forceinline__ int v_st(int k, int c) { const int kk = (k & ~0xC) | ((k & 4) << 1) | ((k & 8) >> 1); return ((kk >> 3) * 4 + (c >> 5)) * 512 + ((kk & 7) * 32 + (c & 31)) * 2; }
__device__ __forceinline__ int v_rd_base(int lane) { return ((lane & 3) << 3) | (((lane >> 2) & 3) << 6) | (((lane >> 4) & 1) << 5) | (((lane >> 5) & 1) << 8); }
constexpr int v_rd_off(int d0, int ks, int half) { return d0 * 512 + ks * 4096 + half * 2048; }
template <int OFF> __device__ __forceinline__ s16x4 tr_read(int vb) {
  s16x4 r; asm volatile("ds_read_b64_tr_b16 %0, %1 offset:%2" : "=&v"(r) : "v"(vb), "i"(OFF) : "memory"); return r;
}
template <int D0> __device__ __forceinline__ void pv_one(f32x16& od, int vb, bf16x8 pa0, bf16x8 pa1, bf16x8 pa2, bf16x8 pa3) {
  const s16x4 l0 = tr_read<v_rd_off(D0, 0, 0)>(vb), h0 = tr_read<v_rd_off(D0, 0, 1)>(vb), l1 = tr_read<v_rd_off(D0, 1, 0)>(vb), h1 = tr_read<v_rd_off(D0, 1, 1)>(vb);
  const s16x4 l2 = tr_read<v_rd_off(D0, 2, 0)>(vb), h2 = tr_read<v_rd_off(D0, 2, 1)>(vb), l3 = tr_read<v_rd_off(D0, 3, 0)>(vb), h3 = tr_read<v_rd_off(D0, 3, 1)>(vb);
  asm volatile("s_waitcnt lgkmcnt(0)" ::: "memory"); SBAR();
#define PK(L, H) (bf16x8){L[0], L[1], L[2], L[3], H[0], H[1], H[2], H[3]}
  od = __builtin_amdgcn_mfma_f32_32x32x16_bf16(pa0, PK(l0, h0), od, 0, 0, 0);
  od = __builtin_amdgcn_mfma_f32_32x32x16_bf16(pa1, PK(l1, h1), od, 0, 0, 0);
  od = __builtin_amdgcn_mfma_f32_32x32x16_bf16(pa2, PK(l2, h2), od, 0, 0, 0);
  od = __builtin_amdgcn_mfma_f32_32x32x16_bf16(pa3, PK(l3, h3), od, 0, 0, 0);
#undef PK
}
__device__ __forceinline__ void pv_d0(f32x16* o, int vb, bf16x8 pa0, bf16x8 pa1, bf16x8 pa2, bf16x8 pa3) {
  pv_one<0>(o[0], vb, pa0, pa1, pa2, pa3); pv_one<1>(o[1], vb, pa0, pa1, pa2, pa3); pv_one<2>(o[2], vb, pa0, pa1, pa2, pa3); pv_one<3>(o[3], vb, pa0, pa1, pa2, pa3);
}

__device__ __forceinline__ void attn_pass(int tid, const bf16_t* __restrict__ Qb, const bf16_t* __restrict__ Kh, const bf16_t* __restrict__ Vh, int seq, LAS char* lds, f32x16 (&o)[4], float (&rli)[16]) {
  const int wid = tid >> 6, lane = tid & 63, r32 = lane & 31, hi = lane >> 5;
  LAS char* V_lds = lds; LAS char* K_lds = lds + 2 * SHM_V;
  LAS float* ws = (LAS float*)(lds + 2 * SHM_V + 2 * SHM_K) + wid * 64; LAS float* li_l = ws; LAS float* al_l = ws + 32;
  float m_reg = -1e30f, l_reg = 0;
#pragma unroll
  for (int d = 0; d < 4; ++d) o[d] = f32x16{};
  bf16x8 qr[4];
  const bf16_t* Qw = Qb + (long)(wid * QBLK + r32) * DQK + hi * 8;
#pragma unroll
  for (int d0 = 0; d0 < 4; ++d0) qr[d0] = *(const bf16x8*)(Qw + d0 * 16);
  const int sr = tid >> 4, sc = (tid & 15) * 8, vst0 = v_st(sr, sc), vst1 = v_st(32 + sr, sc);
  const int kr = tid >> 3, kc = (tid & 7) * 8, kst = KSWZ(kr, kc * 2);
  const int vb0 = (int)(uintptr_t)V_lds + v_rd_base(lane);
  struct { bf16x8 vs0, vs1, ks0; } sr_[2];
#define SLOAD(i, k0) do { sr_[i].vs0 = *(const bf16x8*)(&Vh[(long)((k0) + sr) * DV + sc]); sr_[i].vs1 = *(const bf16x8*)(&Vh[(long)((k0) + 32 + sr) * DV + sc]); \
    sr_[i].ks0 = *(const bf16x8*)(&Kh[(long)((k0) + kr) * DQK + kc]); } while (0)
#define SWRITE(b, i) do { *(LAS bf16x8*)(V_lds + (b) * SHM_V + vst0) = sr_[i].vs0; *(LAS bf16x8*)(V_lds + (b) * SHM_V + vst1) = sr_[i].vs1; \
    *(LAS bf16x8*)(K_lds + (b) * SHM_K + kst) = sr_[i].ks0; } while (0)
#define SWAIT() asm volatile("s_waitcnt vmcnt(3)" ::: "memory")
#define RESC(a) do { if (__any((a) < 1.f)) { if (hi == 0) al_l[r32] = (a); asm volatile("s_waitcnt lgkmcnt(0)" ::: "memory"); \
    _Pragma("unroll") for (int d = 0; d < 4; ++d) _Pragma("unroll") for (int r = 0; r < 16; ++r) o[d][r] *= al_l[crow(r, hi)]; } } while (0)
  f32x16 pA0, pA1, pB0, pB1; float mnA, mnB, alA, alB; bf16x8 pa0, pa1, pa2, pa3; const int NT = seq / KVBLK;
  constexpr int SE = 0, SO = 1;
  SLOAD(SE, 0); asm volatile("s_waitcnt vmcnt(0)" ::: "memory"); SWRITE(0, SE); __syncthreads();
  qkt(pA0, pA1, K_lds, qr, r32, hi); partialSM(pA0, pA1, m_reg, mnA, alA);
  SLOAD(SO, KVBLK); if (2 < NT) SLOAD(SE, 2 * KVBLK);
  SWAIT(); SWRITE(1, SO); __syncthreads();
  for (int j = 1; j + 1 < NT; j += 2) {
    SBAR(); qkt(pB0, pB1, K_lds + SHM_K, qr, r32, hi);
    finishSM(pA0, pA1, alA, l_reg, pa0, pa1, pa2, pa3); SBAR();
    SLOAD(SO, (j + 2) * KVBLK); SBAR();
    pv_d0(o, vb0, pa0, pa1, pa2, pa3); partialSM(pB0, pB1, m_reg, mnB, alB);
    __syncthreads(); SWAIT(); SWRITE(0, SE);
    RESC(alB); __syncthreads();
    SBAR(); qkt(pA0, pA1, K_lds, qr, r32, hi);
    finishSM(pB0, pB1, alB, l_reg, pa0, pa1, pa2, pa3); SBAR();
    if (j + 3 < NT) SLOAD(SE, (j + 3) * KVBLK); SBAR();
    pv_d0(o, vb0 + SHM_V, pa0, pa1, pa2, pa3); partialSM(pA0, pA1, m_reg, mnA, alA);
    __syncthreads(); SWAIT(); SWRITE(1, SO);
    RESC(alA); __syncthreads();
  }
  SBAR(); qkt(pB0, pB1, K_lds + SHM_K, qr, r32, hi);
  finishSM(pA0, pA1, alA, l_reg, pa0, pa1, pa2, pa3); SBAR();
  pv_d0(o, vb0, pa0, pa1, pa2, pa3); partialSM(pB0, pB1, m_reg, mnB, alB);
  __syncthreads(); RESC(alB);
  finishSM(pB0, pB1, alB, l_reg, pa0, pa1, pa2, pa3); SBAR();
  pv_d0(o, vb0 + SHM_V, pa0, pa1, pa2, pa3);
  if (hi == 0) li_l[r32] = l_reg; asm volatile("s_waitcnt lgkmcnt(0)" ::: "memory");
#pragma unroll
  for (int r = 0; r < 16; ++r) rli[r] = __builtin_amdgcn_rcpf(li_l[crow(r, hi)]);
  __syncthreads();
#undef SLOAD
#undef SWRITE
#undef SWAIT
#undef RESC
}

#undef KSWZ
#undef SBAR
}
}
namespace mk {
namespace atf {
constexpr int NW = 8, KSLOT = 8192, VSLOT = 16384, NKS = 4, NVS = 3;
constexpr int LDS_K = 0, LDS_V = NKS * KSLOT, LDS_WS = LDS_V + NVS * VSLOT, LDS_FLAG = LDS_WS + NW * 64 * 4, LDS_BYTES_ATT = LDS_FLAG + 64;
#define SBAR() __builtin_amdgcn_sched_barrier(0)
#define WAIT_BAR(N) asm volatile("s_waitcnt vmcnt(" #N ") lgkmcnt(0)\n\ts_barrier" ::: "memory")
__device__ __forceinline__ int crow(int r, int hi) { return (r & 3) + 8 * (r >> 2) + 4 * hi; }
__device__ __forceinline__ void glds16(const void* gsrc, unsigned lds_dst) { unsigned keep;
  asm volatile("s_mov_b32 %0, m0\n\ts_mov_b32 m0, %2\n\ts_nop 0\n\tglobal_load_lds_dwordx4 %1, off\n\ts_mov_b32 m0, %0" : "=&s"(keep) : "v"(gsrc), "s"(lds_dst) : "memory"); }
typedef float f32x2_t __attribute__((ext_vector_type(2))); typedef __bf16 bf16x2_t __attribute__((ext_vector_type(2)));
__device__ __forceinline__ unsigned cvtpk_s(float lo, float hi) { f32x2_t v = {lo, hi}; bf16x2_t b = __builtin_convertvector(v, bf16x2_t); return __builtin_bit_cast(unsigned, b); }
typedef LAS const char* lds_cptr;
typedef short v4i16_t __attribute__((ext_vector_type(4)));
__device__ __forceinline__ s16x4 vtr(lds_cptr p) { return __builtin_bit_cast(s16x4, __builtin_amdgcn_ds_read_tr16_b64_v4i16((LAS v4i16_t*)p)); }
__device__ __forceinline__ bf16x8 kld(lds_cptr p) { return *(const LAS bf16x8*)p; }

__device__ __forceinline__ bool attn_pass_fast(int tid, const bf16_t* __restrict__ Qb, const bf16_t* __restrict__ Kh, const bf16_t* __restrict__ Vh, int seq, LAS char* lds, f32x16 (&o)[4], float (&rli)[16]) {
  const int lane = tid & 63, r32 = lane & 31, hi = lane >> 5; const int wid = __builtin_amdgcn_readfirstlane(tid >> 6);
  const unsigned lds0 = (unsigned)(uintptr_t)lds;
  LAS float* wsf = (LAS float*)(lds + LDS_WS) + wid * 64;
  const bf16_t* ksrc = Kh + (long)lane * 64 + wid * 8;
  const bf16_t* vsrc = Vh + (long)(16 * (wid & 3) + (lane >> 2)) * 128 + (wid >> 2) * 32 + (lane & 3) * 8;
  const unsigned kdst = lds0 + LDS_K + wid * 1024, vdst = lds0 + LDS_V + wid * 1024;
#define DMA_K(t) glds16(ksrc + (long)(t) * 4096, (unsigned)__builtin_amdgcn_readfirstlane(kdst + ((t) & 3) * KSLOT))
#define DMA_V(t, slot) do { glds16(vsrc + (long)(t) * 8192, (unsigned)__builtin_amdgcn_readfirstlane(vdst + (slot))); glds16(vsrc + (long)(t) * 8192 + 64, (unsigned)__builtin_amdgcn_readfirstlane(vdst + (slot) + 8192)); } while (0)
  const lds_cptr shm3 = (lds_cptr)lds; const lds_cptr kp0 = shm3 + LDS_K + hi * 1024 + r32 * 16;
  const lds_cptr vp0 = shm3 + LDS_V + ((lane >> 4) & 1) * 32 + (lane & 3) * 8 + (4 * hi + ((lane & 15) >> 2)) * 64;
  const int NT = seq / 64;
  DMA_K(0); DMA_V(0, 0); DMA_K(1); DMA_K(2);
  bf16x8 qr[4];
  { const bf16_t* Qw = Qb + (long)(wid * 32 + r32) * 64 + hi * 8;
#pragma unroll
    for (int d0 = 0; d0 < 4; ++d0) qr[d0] = *(const bf16x8*)(Qw + d0 * 16); }
#pragma unroll
  for (int d = 0; d < 4; ++d) o[d] = f32x16{};
  float l_reg = 0.f; f32x16 negm = f32x16{};
  asm volatile("s_waitcnt vmcnt(0)" ::: "memory");
  WAIT_BAR(0);
  f32x16 pA0, pA1, pB0, pB1;
  bf16x8 kfA[4], kfB[4];
  { f32x16 c0 = f32x16{}, c1 = f32x16{};
#pragma unroll
    for (int d0 = 0; d0 < 4; ++d0) { c0 = __builtin_amdgcn_mfma_f32_32x32x16_bf16(kld(kp0 + d0 * 2048), qr[d0], c0, 0, 0, 0); c1 = __builtin_amdgcn_mfma_f32_32x32x16_bf16(kld(kp0 + d0 * 2048 + 512), qr[d0], c1, 0, 0, 0); }
    float m = c0[0];
#pragma unroll
    for (int r = 1; r < 16; ++r) m = fmaxf(m, c0[r]);
#pragma unroll
    for (int r = 0; r < 16; ++r) m = fmaxf(m, c1[r]);
    { auto rr = __builtin_amdgcn_permlane32_swap(__float_as_uint(m), __float_as_uint(m), false, false); m = fmaxf(__uint_as_float(rr[0]), __uint_as_float(rr[1])); }
#pragma unroll
    for (int r = 0; r < 16; ++r) negm[r] = -m;
    asm volatile("" : "+v"(negm)); }
#pragma unroll
  for (int d0 = 0; d0 < 4; ++d0) { pA0 = __builtin_amdgcn_mfma_f32_32x32x16_bf16(kld(kp0 + d0 * 2048), qr[d0], d0 == 0 ? negm : pA0, 0, 0, 0); pA1 = __builtin_amdgcn_mfma_f32_32x32x16_bf16(kld(kp0 + d0 * 2048 + 512), qr[d0], d0 == 0 ? negm : pA1, 0, 0, 0); }
#pragma unroll
  for (int r = 0; r < 16; ++r) { pA0[r] = __builtin_amdgcn_exp2f(pA0[r]); pA1[r] = __builtin_amdgcn_exp2f(pA1[r]); }
  if (3 < NT) DMA_K(3);
  if (1 < NT) DMA_V(1, VSLOT);
#pragma unroll
  for (int d0 = 0; d0 < 4; ++d0) kfA[d0] = kld(kp0 + KSLOT + d0 * 2048);
  WAIT_BAR(0);
  u32x4 pw0, pw1, pw2, pw3; s16x4 vl[4], vh[4];
#define PKW(P, B) cvtpk_s(P[B], P[B + 1])
#define PAF(k) __builtin_bit_cast(bf16x8, pw##k)
#define VFR(i) (bf16x8){vl[i][0], vl[i][1], vl[i][2], vl[i][3], vh[i][0], vh[i][1], vh[i][2], vh[i][3]}
#define PIN(x) asm volatile("" : "+v"(x))
#define GAPA(MF, A0, A1, A2, A3, W0, W1, PW) do { MF; sacc += A0; sacc += A1; sacc += A2; sacc += A3; PIN(sacc); W0; W1; PIN(PW); SBAR(); } while (0)
#define EX(v) __builtin_amdgcn_exp2f(v)
#define GAPB(MF, X, B) do { MF; X[B] = EX(X[B]); X[B + 1] = EX(X[B + 1]); PIN(X); SBAR(); } while (0)
#define VRD(i, f) do { vl[i] = vtr(vp_ + (f) * 1024); vh[i] = vtr(vp_ + (f) * 1024 + 512); } while (0)
#define STEP(C0, C1, P0, P1, t, svp, svn, GK, GV, GL) do { SBAR(); \
    const lds_cptr kq_ = kp0 + ((t) & 3) * KSLOT; const lds_cptr kn_ = kp0 + (((t) + 1) & 3) * KSLOT; const lds_cptr vp_ = vp0 + (svp); \
    kfB[0] = kld(kq_ + 512); kfB[1] = kld(kq_ + 2048 + 512); kfB[2] = kld(kq_ + 4096 + 512); kfB[3] = kld(kq_ + 6144 + 512); \
    VRD(0, 0); VRD(1, 1); SBAR(); float sacc = (P0[0] + P0[1]); \
    GAPA(C0 = __builtin_amdgcn_mfma_f32_32x32x16_bf16(kfA[0], qr[0], negm, 0, 0, 0), P0[2], P0[3], P0[4], P0[5],     pw0[0] = PKW(P0, 0), pw0[1] = PKW(P0, 2), pw0); \
    GAPA(C0 = __builtin_amdgcn_mfma_f32_32x32x16_bf16(kfA[1], qr[1], C0, 0, 0, 0),   P0[6], P0[7], P0[8], P0[9],     pw0[2] = PKW(P0, 4), pw0[3] = PKW(P0, 6), pw0); \
    VRD(2, 2); VRD(3, 3); SBAR(); \
    GAPA(C0 = __builtin_amdgcn_mfma_f32_32x32x16_bf16(kfA[2], qr[2], C0, 0, 0, 0),   P0[10], P0[11], P0[12], P0[13], pw1[0] = PKW(P0, 8), pw1[1] = PKW(P0, 10), pw1); \
    GAPA(C0 = __builtin_amdgcn_mfma_f32_32x32x16_bf16(kfA[3], qr[3], C0, 0, 0, 0),   P0[14], P0[15], P1[0], P1[1],   pw1[2] = PKW(P0, 12), pw1[3] = PKW(P0, 14), pw1); \
    GAPA(C1 = __builtin_amdgcn_mfma_f32_32x32x16_bf16(kfB[0], qr[0], negm, 0, 0, 0), P1[2], P1[3], P1[4], P1[5],     pw2[0] = PKW(P1, 0), pw2[1] = PKW(P1, 2), pw2); \
    GAPA(C1 = __builtin_amdgcn_mfma_f32_32x32x16_bf16(kfB[1], qr[1], C1, 0, 0, 0),   P1[6], P1[7], P1[8], P1[9],     pw2[2] = PKW(P1, 4), pw2[3] = PKW(P1, 6), pw2); \
    GAPA(C1 = __builtin_amdgcn_mfma_f32_32x32x16_bf16(kfB[2], qr[2], C1, 0, 0, 0),   P1[10], P1[11], P1[12], P1[13], pw3[0] = PKW(P1, 8), pw3[1] = PKW(P1, 10), pw3); \
    GAPA(C1 = __builtin_amdgcn_mfma_f32_32x32x16_bf16(kfB[3], qr[3], C1, 0, 0, 0),   P1[14], P1[15], 0.f, 0.f,       pw3[2] = PKW(P1, 12), pw3[3] = PKW(P1, 14), pw3); \
    l_reg += sacc; \
    if (GK) { DMA_K((t) + 3); } if (GV) { DMA_V((t) + 1, (svn)); } \
    SBAR(); \
    GAPB(o[0] = __builtin_amdgcn_mfma_f32_32x32x16_bf16(PAF(0), VFR(0), o[0], 0, 0, 0), C0, 0);  VRD(0, 4); SBAR(); \
    GAPB(o[0] = __builtin_amdgcn_mfma_f32_32x32x16_bf16(PAF(1), VFR(1), o[0], 0, 0, 0), C0, 2);  VRD(1, 5); SBAR(); \
    GAPB(o[0] = __builtin_amdgcn_mfma_f32_32x32x16_bf16(PAF(2), VFR(2), o[0], 0, 0, 0), C0, 4);  VRD(2, 6); SBAR(); \
    GAPB(o[0] = __builtin_amdgcn_mfma_f32_32x32x16_bf16(PAF(3), VFR(3), o[0], 0, 0, 0), C0, 6);  VRD(3, 7); SBAR(); \
    GAPB(o[1] = __builtin_amdgcn_mfma_f32_32x32x16_bf16(PAF(0), VFR(0), o[1], 0, 0, 0), C0, 8);  VRD(0, 8); SBAR(); \
    GAPB(o[1] = __builtin_amdgcn_mfma_f32_32x32x16_bf16(PAF(1), VFR(1), o[1], 0, 0, 0), C0, 10); VRD(1, 9); SBAR(); \
    GAPB(o[1] = __builtin_amdgcn_mfma_f32_32x32x16_bf16(PAF(2), VFR(2), o[1], 0, 0, 0), C0, 12); VRD(2, 10); SBAR(); \
    GAPB(o[1] = __builtin_amdgcn_mfma_f32_32x32x16_bf16(PAF(3), VFR(3), o[1], 0, 0, 0), C0, 14); VRD(3, 11); SBAR(); \
    GAPB(o[2] = __builtin_amdgcn_mfma_f32_32x32x16_bf16(PAF(0), VFR(0), o[2], 0, 0, 0), C1, 0);  VRD(0, 12); SBAR(); \
    GAPB(o[2] = __builtin_amdgcn_mfma_f32_32x32x16_bf16(PAF(1), VFR(1), o[2], 0, 0, 0), C1, 2);  VRD(1, 13); SBAR(); \
    GAPB(o[2] = __builtin_amdgcn_mfma_f32_32x32x16_bf16(PAF(2), VFR(2), o[2], 0, 0, 0), C1, 4);  VRD(2, 14); SBAR(); \
    GAPB(o[2] = __builtin_amdgcn_mfma_f32_32x32x16_bf16(PAF(3), VFR(3), o[2], 0, 0, 0), C1, 6);  VRD(3, 15); SBAR(); \
    if (GL) { kfA[0] = kld(kn_); kfA[1] = kld(kn_ + 2048); SBAR(); } \
    GAPB(o[3] = __builtin_amdgcn_mfma_f32_32x32x16_bf16(PAF(0), VFR(0), o[3], 0, 0, 0), C1, 8); \
    GAPB(o[3] = __builtin_amdgcn_mfma_f32_32x32x16_bf16(PAF(1), VFR(1), o[3], 0, 0, 0), C1, 10); \
    if (GL) { kfA[2] = kld(kn_ + 4096); kfA[3] = kld(kn_ + 6144); SBAR(); } \
    GAPB(o[3] = __builtin_amdgcn_mfma_f32_32x32x16_bf16(PAF(2), VFR(2), o[3], 0, 0, 0), C1, 12); \
    GAPB(o[3] = __builtin_amdgcn_mfma_f32_32x32x16_bf16(PAF(3), VFR(3), o[3], 0, 0, 0), C1, 14); \
  } while (0)
  int svp = 0, svc = VSLOT, svn = 2 * VSLOT;
#define ROT() do { const int tmp_ = svp; svp = svc; svc = svn; svn = tmp_; } while (0)
  int t = 1;
  for (; t + 5 < NT; t += 2) {
    STEP(pB0, pB1, pA0, pA1, t, svp, svn, true, true, true);     WAIT_BAR(3); ROT();
    STEP(pA0, pA1, pB0, pB1, t + 1, svp, svn, true, true, true); WAIT_BAR(3); ROT();
  }
  for (; t + 1 < NT; t += 2) {
    STEP(pB0, pB1, pA0, pA1, t, svp, svn, (t + 3 < NT), (t + 1 < NT), (t + 1 < NT));       WAIT_BAR(0); ROT();
    STEP(pA0, pA1, pB0, pB1, t + 1, svp, svn, (t + 4 < NT), (t + 2 < NT), (t + 2 < NT));   WAIT_BAR(0); ROT();
  }
  STEP(pB0, pB1, pA0, pA1, NT - 1, svp, svn, false, false, false); ROT();
  { float sacc = pB0[0] + pB0[1];
#pragma unroll
    for (int r = 2; r < 16; ++r) sacc += pB0[r];
#pragma unroll
    for (int r = 0; r < 16; ++r) sacc += pB1[r];
    l_reg += sacc;
    pw0 = (u32x4){PKW(pB0, 0), PKW(pB0, 2), PKW(pB0, 4), PKW(pB0, 6)}; pw1 = (u32x4){PKW(pB0, 8), PKW(pB0, 10), PKW(pB0, 12), PKW(pB0, 14)};
    pw2 = (u32x4){PKW(pB1, 0), PKW(pB1, 2), PKW(pB1, 4), PKW(pB1, 6)}; pw3 = (u32x4){PKW(pB1, 8), PKW(pB1, 10), PKW(pB1, 12), PKW(pB1, 14)};
    WAIT_BAR(0);
    const lds_cptr vp_ = vp0 + svp;
#pragma unroll
    for (int d0 = 0; d0 < 4; ++d0) { VRD(0, 4 * d0); VRD(1, 4 * d0 + 1); VRD(2, 4 * d0 + 2); VRD(3, 4 * d0 + 3);
      o[d0] = __builtin_amdgcn_mfma_f32_32x32x16_bf16(PAF(0), VFR(0), o[d0], 0, 0, 0); o[d0] = __builtin_amdgcn_mfma_f32_32x32x16_bf16(PAF(1), VFR(1), o[d0], 0, 0, 0);
      o[d0] = __builtin_amdgcn_mfma_f32_32x32x16_bf16(PAF(2), VFR(2), o[d0], 0, 0, 0); o[d0] = __builtin_amdgcn_mfma_f32_32x32x16_bf16(PAF(3), VFR(3), o[d0], 0, 0, 0); } }
  { auto rr = __builtin_amdgcn_permlane32_swap(__float_as_uint(l_reg), __float_as_uint(l_reg), false, false); l_reg = __uint_as_float(rr[0]) + __uint_as_float(rr[1]); }
  const bool bad = __any(!(l_reg > 1e-30f && l_reg < 1e30f));
  LAS int* flag = (LAS int*)(lds + LDS_FLAG);
  if (hi == 0) wsf[32 + r32] = l_reg;
  if (lane == 0) flag[wid] = bad ? 1 : 0;
  WAIT_BAR(0);
#pragma unroll
  for (int r = 0; r < 16; ++r) rli[r] = __builtin_amdgcn_rcpf(wsf[32 + crow(r, hi)]);
  int anybad = 0;
#pragma unroll
  for (int w = 0; w < 8; ++w) anybad |= flag[w];
  WAIT_BAR(0);
  return anybad == 0;
#undef DMA_K
#undef DMA_V
#undef PKW
#undef PAF
#undef VFR
#undef PIN
#undef GAPA
#undef EX
#undef GAPB
#undef VRD
#undef STEP
#undef ROT
}
#undef SBAR
#undef WAIT_BAR
}
}

namespace mk {
namespace att2 {
__device__ __forceinline__ void attn_unit(int h, int qb, const unsigned char* ws, const float* __restrict__ subg, float* stash, LAS char* lds) {
  const bf16_t* Q = (const bf16_t*)(ws + WS_Q); const bf16_t* K = (const bf16_t*)(ws + WS_K); const bf16_t* V = (const bf16_t*)(ws + WS_V);
  f32x16 o[4]; float rli[16];
  { int tid = threadIdx.x; asm volatile("" : "+v"(tid));
    if (!atf::attn_pass_fast(tid, Q + ((size_t)(2 * h) * T + (size_t)qb * 256) * 64, K + (size_t)(2 * h) * T * 64, V + (size_t)h * T * 128, T, lds, o, rli))
      att::attn_pass(tid, Q + ((size_t)(2 * h) * T + (size_t)qb * 256) * 64, K + (size_t)(2 * h) * T * 64, V + (size_t)h * T * 128, T, lds, o, rli); }
  { int tid = threadIdx.x; asm volatile("" : "+v"(tid));
    float* st = stash + (size_t)(tid >> 6) * 4096 + (tid & 63);
    asm volatile("" : "+v"(st) :: "memory");
#pragma unroll
    for (int d = 0; d < 4; ++d)
#pragma unroll
      for (int r = 0; r < 16; ++r) st[(d * 16 + r) * 64] = o[d][r] * rli[r];
    asm volatile("s_waitcnt vmcnt(0)" ::: "memory"); __builtin_amdgcn_sched_barrier(0); }
  { int tid = threadIdx.x; asm volatile("" : "+v"(tid));
    if (!atf::attn_pass_fast(tid, Q + ((size_t)(2 * h + 1) * T + (size_t)qb * 256) * 64, K + (size_t)(2 * h + 1) * T * 64, V + (size_t)h * T * 128, T, lds, o, rli))
      att::attn_pass(tid, Q + ((size_t)(2 * h + 1) * T + (size_t)qb * 256) * 64, K + (size_t)(2 * h + 1) * T * 64, V + (size_t)h * T * 128, T, lds, o, rli); }
  int tid = threadIdx.x; asm volatile("" : "+v"(tid));
  const int wid = tid >> 6, lane = tid & 63, r32 = lane & 31, hi = lane >> 5;
  const float lam = *(const float*)(ws + WS_SMALL);
  float* st = stash + (size_t)wid * 4096 + lane;
  asm volatile("" : "+v"(st) :: "memory");
  float ss[16];
#pragma unroll
  for (int r = 0; r < 16; ++r) ss[r] = 0.f;
#pragma unroll
  for (int d = 0; d < 4; ++d)
#pragma unroll
    for (int r = 0; r < 16; ++r) { const float a = st[(d * 16 + r) * 64] - lam * (o[d][r] * rli[r]); o[d][r] = a; ss[r] += a * a; }
#pragma unroll
  for (int r = 0; r < 16; ++r) { float s = ss[r]; s += __shfl_xor(s, 1); s += __shfl_xor(s, 2); s += __shfl_xor(s, 4); s += __shfl_xor(s, 8); s += __shfl_xor(s, 16);
    ss[r] = 0.8f / sqrtf(s * (1.f / 128.f) + 1e-5f); }
  bf16_t* mix = (bf16_t*)(ws + WS_XN);
#pragma unroll
  for (int d = 0; d < 4; ++d) { const float g = subg[d * 32 + r32];
#pragma unroll
    for (int r = 0; r < 16; ++r) { const int t = qb * 256 + wid * 32 + att::crow(r, hi);
      mix[(size_t)t * DM + h * 128 + d * 32 + r32] = (bf16_t)(cvt_pk_bf16(o[d][r] * ss[r] * g, 0.f) & 0xffffu); } }
}
}
}
namespace mk {
namespace hg {
constexpr int C = 64, LSC = 512, NCH = LSC / C, NSC = T / LSC;
constexpr int L_QT = 0, L_KT = 16384, L_KH = 32768, L_VT = 49152, L_GB = 65536  , L_AT = 98304  ,
              L_SEG = 106496  , L_DL = 108544  , L_END = 109056;
__device__ __forceinline__ int crow(int r, int hi) { return (r & 3) + 8 * (r >> 2) + 4 * hi; }
__device__ __forceinline__ unsigned off_b(unsigned row, unsigned ch) { return 256u * row + 16u * (ch ^ (((row & 3) << 2) | ((row >> 2) & 3))); }
__device__ __forceinline__ unsigned row_read_addr(unsigned lane, unsigned s) { return off_b(lane & 31, 2 * s + (lane >> 5)); }
__device__ __forceinline__ unsigned tr_read_addr(unsigned lane, unsigned c, unsigned ks, unsigned t) {
  const unsigned h = lane >> 5, blk = (lane >> 4) & 1, q = (lane & 15) >> 2, p = lane & 3;
  return off_b(16 * ks + 8 * h + 4 * t + q, 4 * c + 2 * blk + (p >> 1)) + 8 * (p & 1);
}
__device__ __forceinline__ s16x4 trd(const LAS unsigned char* p) { typedef short v4i16_t __attribute__((ext_vector_type(4))); return __builtin_bit_cast(s16x4, __builtin_amdgcn_ds_read_tr16_b64_v4i16((LAS v4i16_t*)p)); }
__device__ __forceinline__ bf16x8 tr_frag(const LAS unsigned char* img, unsigned lane, unsigned c, unsigned kk) {
  const LAS unsigned char* base = img + 8192u * (kk >> 1);
  const s16x4 lo = trd(base + tr_read_addr(lane, c, kk & 1, 0)), hi = trd(base + tr_read_addr(lane, c, kk & 1, 1));
  return (bf16x8){lo[0], lo[1], lo[2], lo[3], hi[0], hi[1], hi[2], hi[3]};
}
__device__ __forceinline__ bf16x8 row_frag(const LAS unsigned char* img, unsigned lane, unsigned rt, unsigned s) {
  return *(const LAS bf16x8*)(img + 8192u * rt + row_read_addr(lane, s));
}
__device__ __forceinline__ unsigned at_off(unsigned row, unsigned chunk) { return row * 128u + ((chunk ^ ((row >> 1) & 7u)) << 4); }

template <bool OUT>
__device__ __forceinline__ void hgrn_item(int tid, int h, int dir, int p, const unsigned char* ws, float* Sbuf, float* Dbuf, LAS unsigned char* lds) {
  const int wid = __builtin_amdgcn_readfirstlane(tid >> 6), lane = tid & 63, r32 = lane & 31, hi = lane >> 5;
  const bf16_t* HQ = (const bf16_t*)(ws + WS_HQ); const bf16_t* Z = (const bf16_t*)(ws + (dir ? WS_ZB : WS_ZF)); const bf16_t* HI = (const bf16_t*)(ws + WS_HI);
  const float* lbp = (const float*)(ws + WS_SMALL) + 64 + dir * 512 + h * 128;
  bf16_t* Od = (bf16_t*)(ws + WS_Q) + ((size_t)(dir * 4 + h) * T) * 128;
  const int sc = dir ? (NSC - 1 - p) : p, tok0 = sc * LSC;
  float* Sg = Sbuf + ((size_t)((h * 2 + dir) * NSC + p)) * 16384;
  float* Dg = Dbuf + ((size_t)((h * 2 + dir) * NSC + p)) * 128;
  const int sr = tid >> 4, c8 = (tid & 15) * 8;
  float lb8[8];
#pragma unroll
  for (int i = 0; i < 8; ++i) lb8[i] = lbp[c8 + i];
  const int vj = wid & 3, kt0 = 2 * (wid >> 2);
  f32x16 S0, S1;
  if (OUT) {
#pragma unroll
    for (int r = 0; r < 16; ++r) { S0[r] = Sg[(size_t)(32 * kt0 + crow(r, hi)) * 128 + 32 * vj + r32]; S1[r] = Sg[(size_t)(32 * (kt0 + 1) + crow(r, hi)) * 128 + 32 * vj + r32]; }
  } else { S0 = f32x16{}; S1 = f32x16{}; }
  float bsum[8];
#pragma unroll
  for (int i = 0; i < 8; ++i) bsum[i] = 0.f;
  LAS float* Gb = (LAS float*)(lds + L_GB); LAS float* Seg = (LAS float*)(lds + L_SEG); LAS float* Dl = (LAS float*)(lds + L_DL);
  for (int step = 0; step < NCH; ++step) {
    const int ci = dir ? (NCH - 1 - step) : step, ctok = tok0 + ci * C;
    const int t0 = ctok + (dir ? (63 - sr) : sr), t1 = ctok + (dir ? (31 - sr) : (sr + 32));
    const size_t g0 = (size_t)t0 * 512 + h * 128 + c8, g1 = (size_t)t1 * 512 + h * 128 + c8;
    const u32x4 z0 = *(const u32x4*)(Z + g0), z1 = *(const u32x4*)(Z + g1);
    const u32x4 v0 = *(const u32x4*)(HI + g0), v1 = *(const u32x4*)(HI + g1);
    u32x4 q0 = {0, 0, 0, 0}, q1 = {0, 0, 0, 0};
    if (OUT) { q0 = *(const u32x4*)(HQ + g0); q1 = *(const u32x4*)(HQ + g1); }
    float k0[8], k1[8];
#pragma unroll
    for (int i = 0; i < 4; ++i) {
      { const float za = bflo(z0[i]), zb = bfhi(z0[i]); const float sa = fsigm(za), sb = fsigm(zb); const float fa = lb8[2 * i] + (1.f - lb8[2 * i]) * sa, fb = lb8[2 * i + 1] + (1.f - lb8[2 * i + 1]) * sb;
        k0[2 * i] = 1.f - fa; k0[2 * i + 1] = 1.f - fb; Gb[sr * 128 + c8 + 2 * i] = __logf(fa); Gb[sr * 128 + c8 + 2 * i + 1] = __logf(fb); }
      { const float za = bflo(z1[i]), zb = bfhi(z1[i]); const float sa = fsigm(za), sb = fsigm(zb); const float fa = lb8[2 * i] + (1.f - lb8[2 * i]) * sa, fb = lb8[2 * i + 1] + (1.f - lb8[2 * i + 1]) * sb;
        k1[2 * i] = 1.f - fa; k1[2 * i + 1] = 1.f - fb; Gb[(sr + 32) * 128 + c8 + 2 * i] = __logf(fa); Gb[(sr + 32) * 128 + c8 + 2 * i + 1] = __logf(fb); }
    }
    __syncthreads();
    { const int ch = tid & 127, seg = tid >> 7; float run = 0.f;
#pragma unroll
      for (int r = 0; r < 16; ++r) { run += Gb[(16 * seg + r) * 128 + ch]; Gb[(16 * seg + r) * 128 + ch] = run; }
      Seg[seg * 128 + ch] = run; }
    __syncthreads();
    float bl[8], o0[8], o1[8];
    { const int sg0 = sr >> 4, sg1 = (sr + 32) >> 4;
#pragma unroll
      for (int i = 0; i < 8; ++i) { const float s0 = Seg[c8 + i], s1 = Seg[128 + c8 + i], s2 = Seg[256 + c8 + i], s3 = Seg[384 + c8 + i];
        bl[i] = (s0 + s1) + (s2 + s3); o0[i] = sg0 == 0 ? 0.f : s0; o1[i] = sg1 == 2 ? (s0 + s1) : ((s0 + s1) + s2); } }
    float b0[8], b1[8];
#pragma unroll
    for (int i = 0; i < 8; ++i) { b0[i] = Gb[sr * 128 + c8 + i] + o0[i]; b1[i] = Gb[(sr + 32) * 128 + c8 + i] + o1[i]; }
    if (sr == 0) {
#pragma unroll
      for (int i = 0; i < 8; ++i) { Dl[c8 + i] = __expf(bl[i]); bsum[i] += bl[i]; } }
    { u32x4 kh0, kh1;
#pragma unroll
      for (int i = 0; i < 4; ++i) { kh0[i] = cvt_pk_bf16(k0[2 * i] * __expf(bl[2 * i] - b0[2 * i]), k0[2 * i + 1] * __expf(bl[2 * i + 1] - b0[2 * i + 1]));
        kh1[i] = cvt_pk_bf16(k1[2 * i] * __expf(bl[2 * i] - b1[2 * i]), k1[2 * i + 1] * __expf(bl[2 * i + 1] - b1[2 * i + 1])); }
      const unsigned a0 = off_b(sr, tid & 15), a1 = 8192u + off_b(sr, tid & 15);
      *(LAS u32x4*)(lds + L_KH + a0) = kh0; *(LAS u32x4*)(lds + L_KH + a1) = kh1;
      *(LAS u32x4*)(lds + L_VT + a0) = v0; *(LAS u32x4*)(lds + L_VT + a1) = v1;
      if (OUT) { u32x4 qt0, qt1, kt0_, kt1_;
#pragma unroll
        for (int i = 0; i < 4; ++i) { qt0[i] = cvt_pk_bf16(bflo(q0[i]) * __expf(b0[2 * i]), bfhi(q0[i]) * __expf(b0[2 * i + 1])); qt1[i] = cvt_pk_bf16(bflo(q1[i]) * __expf(b1[2 * i]), bfhi(q1[i]) * __expf(b1[2 * i + 1]));
          kt0_[i] = cvt_pk_bf16(k0[2 * i] * __expf(-b0[2 * i]), k0[2 * i + 1] * __expf(-b0[2 * i + 1])); kt1_[i] = cvt_pk_bf16(k1[2 * i] * __expf(-b1[2 * i]), k1[2 * i + 1] * __expf(-b1[2 * i + 1])); }
        *(LAS u32x4*)(lds + L_QT + a0) = qt0; *(LAS u32x4*)(lds + L_QT + a1) = qt1; *(LAS u32x4*)(lds + L_KT + a0) = kt0_; *(LAS u32x4*)(lds + L_KT + a1) = kt1_; } }
    __syncthreads();
    if (OUT) {
      { LAS unsigned char* sb = lds + L_GB;
#pragma unroll
        for (int r = 0; r < 16; ++r) { const unsigned kl = crow(r, hi), v = 32 * vj + r32;
          *(LAS bf16_t*)(sb + 8192u * kt0 + off_b(kl, v >> 3) + (v & 7) * 2) = (bf16_t)(cvt_pk_bf16(S0[r], 0.f) & 0xffffu);
          *(LAS bf16_t*)(sb + 8192u * (kt0 + 1) + off_b(kl, v >> 3) + (v & 7) * 2) = (bf16_t)(cvt_pk_bf16(S1[r], 0.f) & 0xffffu); } }
      if (wid < 4 && !(wid == 1)) { const int ti = wid >> 1, si = wid & 1; f32x16 a = f32x16{};
#pragma unroll
        for (int s = 0; s < 8; ++s) a = __builtin_amdgcn_mfma_f32_32x32x16_bf16(row_frag(lds + L_KT, lane, si, s), row_frag(lds + L_QT, lane, ti, s), a, 0, 0, 0);
        const int tcol = 32 * ti + r32;
#pragma unroll
        for (int g = 0; g < 4; ++g) { const int s0 = 32 * si + 8 * g + 4 * hi; float x[4];
#pragma unroll
          for (int e = 0; e < 4; ++e) x[e] = (s0 + e <= tcol) ? a[4 * g + e] : 0.f;
          u32x2 w; w.x = cvt_pk_bf16(x[0], x[1]); w.y = cvt_pk_bf16(x[2], x[3]);
          *(LAS u32x2*)(lds + L_AT + at_off(tcol, 4 * si + g) + 8 * hi) = w; } }
      __syncthreads();
      { const int ti = wid >> 2; f32x16 o = f32x16{};
#pragma unroll
        for (int kk = 0; kk < 8; ++kk) o = __builtin_amdgcn_mfma_f32_32x32x16_bf16(row_frag(lds + L_QT, lane, ti, kk), tr_frag(lds + L_GB, lane, vj, kk), o, 0, 0, 0);
        const int nks = ti == 0 ? 2 : 4;
        for (int kk = 0; kk < nks; ++kk) { const bf16x8 af = *(const LAS bf16x8*)(lds + L_AT + at_off(32 * ti + r32, 2 * kk + hi));
          o = __builtin_amdgcn_mfma_f32_32x32x16_bf16(af, tr_frag(lds + L_VT, lane, vj, kk), o, 0, 0, 0); }
#pragma unroll
        for (int r = 0; r < 16; ++r) { const int rr = 32 * ti + crow(r, hi); const int t = ctok + (dir ? (63 - rr) : rr);
          Od[(size_t)t * 128 + 32 * vj + r32] = (bf16_t)(cvt_pk_bf16(o[r], 0.f) & 0xffffu); } }
    }
    { float d0[16], d1[16];
#pragma unroll
      for (int r = 0; r < 16; ++r) { d0[r] = Dl[32 * kt0 + crow(r, hi)]; d1[r] = Dl[32 * (kt0 + 1) + crow(r, hi)]; }
#pragma unroll
      for (int r = 0; r < 16; ++r) { S0[r] *= d0[r]; S1[r] *= d1[r]; }
#pragma unroll
      for (int kk = 0; kk < 4; ++kk) { const bf16x8 vf = tr_frag(lds + L_VT, lane, vj, kk);
        S0 = __builtin_amdgcn_mfma_f32_32x32x16_bf16(tr_frag(lds + L_KH, lane, kt0, kk), vf, S0, 0, 0, 0);
        S1 = __builtin_amdgcn_mfma_f32_32x32x16_bf16(tr_frag(lds + L_KH, lane, kt0 + 1, kk), vf, S1, 0, 0, 0); } }
    __syncthreads();
  }
  if (!OUT) {
#pragma unroll
    for (int r = 0; r < 16; ++r) { Sg[(size_t)(32 * kt0 + crow(r, hi)) * 128 + 32 * vj + r32] = S0[r]; Sg[(size_t)(32 * (kt0 + 1) + crow(r, hi)) * 128 + 32 * vj + r32] = S1[r]; }
    if (sr == 0) {
#pragma unroll
      for (int i = 0; i < 8; ++i) Dg[c8 + i] = __expf(bsum[i]); }
  }
}

__device__ __forceinline__ void hgrn_scan(int gthread, int nthreads, float* Sbuf, const float* Dbuf) {
  for (int e = gthread; e < 8 * 16384; e += nthreads) { const int hd = e >> 14, kv = e & 16383, k = kv >> 7;
    float* Sp = Sbuf + (size_t)hd * NSC * 16384 + kv; const float* Dp = Dbuf + (size_t)hd * NSC * 128 + k;
    float run = 0.f;
#pragma unroll 8
    for (int p = 0; p < NSC; ++p) { const float s = Sp[(size_t)p * 16384], d = Dp[p * 128]; Sp[(size_t)p * 16384] = run; run = d * run + s; } }
}
__device__ __forceinline__ void hgrn_combine(int gwave, int nwaves, int lane, const unsigned char* ws, const float* __restrict__ gg) {
  const bf16_t* Of = (const bf16_t*)(ws + WS_Q); const bf16_t* Ob = Of + (size_t)4 * T * 128; const bf16_t* HG = (const bf16_t*)(ws + WS_HG); bf16_t* mix = (bf16_t*)(ws + WS_XN);
  const float g0 = gg[2 * lane], g1 = gg[2 * lane + 1];
  for (int w = gwave; w < T * 4; w += nwaves) { const int t = w >> 2, h = w & 3;
    const unsigned f = *(const unsigned*)(Of + ((size_t)h * T + t) * 128 + 2 * lane), b = *(const unsigned*)(Ob + ((size_t)h * T + t) * 128 + 2 * lane);
    const unsigned gt = *(const unsigned*)(HG + (size_t)t * 512 + h * 128 + 2 * lane);
    const float a0 = bflo(f) + bflo(b), a1 = bfhi(f) + bfhi(b);
    const float ss = wave_sum(a0 * a0 + a1 * a1);
    const float r = 1.f / sqrtf(ss * (1.f / 128.f) + 1e-6f);
    *(unsigned*)(mix + (size_t)t * DM + 512 + h * 128 + 2 * lane) = cvt_pk_bf16(a0 * r * g0 * bflo(gt), a1 * r * g1 * bfhi(gt)); }
}
}
}
namespace mk {
struct EpiOutProj {
  const float* x; float* out;
  __device__ __forceinline__ void operator()(const f32x4 (&acc)[2][2][4][2], const Unit& u, int wr, int wc, int fr, int fq) const {
    const int row0 = u.pm * BM + wr * 64 + fr, col0 = u.pn * BM + wc * 32 + 8 * fq;
#pragma unroll
    for (int ai = 0; ai < 2; ++ai)
#pragma unroll
      for (int m = 0; m < 4; ++m) { const size_t ro = (size_t)(row0 + ai * HALF + m * 16) * DM + col0;
#pragma unroll
        for (int bj = 0; bj < 2; ++bj) { const GAS f32x4* xp = (const GAS f32x4*)(x + ro + bj * HALF); GAS f32x4* op = (GAS f32x4*)(out + ro + bj * HALF);
          const f32x4 x0 = xp[0], x1 = xp[1]; op[0] = x0 + acc[ai][bj][m][0]; op[1] = x1 + acc[ai][bj][m][1]; } }
  }
};

namespace rt {
constexpr size_t WS_WR = WS_SMALL + 64 * 1024;
constexpr size_t R_LIST = WS_ROUTE, R_CWL = WS_ROUTE + 2 * MiB, R_TINFO = WS_ROUTE + 4 * MiB;
__device__ __forceinline__ void build_wr(int gthread, int nthreads, const Args& a) {
  float* WR = (float*)(a.ws + WS_WR); const float* g = a.in[8]; const float* wgr = a.in[9]; const float* wer = a.in[11];
  for (int idx = gthread; idx < 1024 * 48; idx += nthreads) { const int k = idx / 48, j = idx % 48; float w = 0.f;
    if (j < 4) w = wgr[k * 4 + j]; else if (j < 36) { const int gi = (j - 4) >> 3, e = (j - 4) & 7; w = wer[((size_t)gi * 1024 + k) * 8 + e]; }
    WR[idx] = w * g[k]; }
}
__device__ __forceinline__ void router_phase(Frame& F, const Args& a, gu32* gcnt) {
  const float* hres = a.out; const float* g = a.in[8]; const float* WR = (const float*)(a.ws + WS_WR);
  const float* bgr = a.in[10]; const float* ber = a.in[12];
  bf16_t* XT = (bf16_t*)(a.ws + WS_XN); int* list = (int*)(a.ws + R_LIST); float* cwl = (float*)(a.ws + R_CWL); int* tinfo = (int*)(a.ws + R_TINFO);
  LAS float* lg = (LAS float*)(F.lds + F.wave * 4096); LAS int* lcnt = (LAS int*)(F.lds + 32768); LAS int* lbase = lcnt + 32;
  const int lane = F.lane, j = lane & 15, q = lane >> 4;
  const int ntile = T / 16, tpb = (ntile + F.G - 1) / F.G;
  if (F.tid < 64) lcnt[F.tid] = 0;
  __syncthreads();
  const int tile = F.vcu * tpb + F.wave; const bool active = (F.wave < tpb) && (tile < ntile);
  int e1 = 0, e2 = 0, lr1 = 0, lr2 = 0; float c1 = 0.f, c2 = 0.f; int tok = 0;
  if (active) {
    const int t0 = tile * 16;
    const float* xr = hres + (size_t)(t0 + j) * DM + 4 * q;
    f32x4 acc0 = {0.f, 0.f, 0.f, 0.f}, acc1 = acc0, acc2 = acc0; float ssq = 0.f;
#pragma unroll 4
    for (int u = 0; u < 64; ++u) { const f32x4 xv = *(const GAS f32x4*)(xr + 16 * u); ssq += (xv.x * xv.x + xv.y * xv.y) + (xv.z * xv.z + xv.w * xv.w);
      const float* wp = WR + (size_t)(16 * u + 4 * q) * 48 + j;
#pragma unroll
      for (int e = 0; e < 4; ++e) { const float av = xv[e];
        acc0 = __builtin_amdgcn_mfma_f32_16x16x4f32(av, wp[e * 48], acc0, 0, 0, 0);
        acc1 = __builtin_amdgcn_mfma_f32_16x16x4f32(av, wp[e * 48 + 16], acc1, 0, 0, 0);
        acc2 = __builtin_amdgcn_mfma_f32_16x16x4f32(av, wp[e * 48 + 32], acc2, 0, 0, 0); } }
    ssq += __shfl_xor(ssq, 16); ssq += __shfl_xor(ssq, 32);
    const float rstd = 1.f / sqrtf(ssq * (1.f / DM) + 1e-6f);
#pragma unroll
    for (int r = 0; r < 4; ++r) { lg[(4 * q + r) * 48 + j] = acc0[r]; lg[(4 * q + r) * 48 + 16 + j] = acc1[r]; lg[(4 * q + r) * 48 + 32 + j] = acc2[r]; }
    LDS_WAIT();
#pragma unroll 4
    for (int u = 0; u < 64; ++u) { const f32x4 xv = *(const GAS f32x4*)(xr + 16 * u); const f32x4 gv = *(const GAS f32x4*)(g + 16 * u + 4 * q);
      u32x2 w; w.x = cvt_pk_bf16(xv.x * rstd * gv.x, xv.y * rstd * gv.y); w.y = cvt_pk_bf16(xv.z * rstd * gv.z, xv.w * rstd * gv.w);
      *(GAS u32x2*)(XT + (size_t)(t0 + j) * DM + 16 * u + 4 * q) = w; }
    if (lane < 16) {
      tok = t0 + lane;
      float gl[4];
#pragma unroll
      for (int i = 0; i < 4; ++i) gl[i] = lg[lane * 48 + i] * rstd + bgr[i];
      int gi = 0; float gm = gl[0];
#pragma unroll
      for (int i = 1; i < 4; ++i) if (gl[i] > gm) { gm = gl[i]; gi = i; }
      float den = 0.f;
#pragma unroll
      for (int i = 0; i < 4; ++i) den += __expf(gl[i] - gm);
      const float pg = 1.f / den;
      float el[8];
#pragma unroll
      for (int i = 0; i < 8; ++i) el[i] = lg[lane * 48 + 4 + 8 * gi + i] * rstd + ber[gi * 8 + i];
      int i1 = 0; float m1 = el[0];
#pragma unroll
      for (int i = 1; i < 8; ++i) if (el[i] > m1) { m1 = el[i]; i1 = i; }
      int i2 = 0; float m2 = -3.0e38f;
#pragma unroll
      for (int i = 0; i < 8; ++i) if (i != i1 && el[i] > m2) { m2 = el[i]; i2 = i; }
      const float ex = __expf(m2 - m1); const float w1 = 1.f / (1.f + ex), w2 = ex / (1.f + ex);
      e1 = gi * 8 + i1; e2 = gi * 8 + i2; c1 = w1 * pg; c2 = w2 * pg;
      lr1 = __hip_atomic_fetch_add(lcnt + e1, 1, __ATOMIC_RELAXED, __HIP_MEMORY_SCOPE_WORKGROUP); lr2 = __hip_atomic_fetch_add(lcnt + e2, 1, __ATOMIC_RELAXED, __HIP_MEMORY_SCOPE_WORKGROUP);
    }
  }
  __syncthreads();
  if (F.tid < 32) { const int n = lcnt[F.tid]; lbase[F.tid] = n ? (int)__hip_atomic_fetch_add(gcnt + F.tid, (unsigned)n, __ATOMIC_RELAXED, __HIP_MEMORY_SCOPE_AGENT) : 0; }
  __syncthreads();
  if (active && lane < 16) { const int p1 = lbase[e1] + lr1, p2 = lbase[e2] + lr2;
    list[(size_t)e1 * T + p1] = tok; list[(size_t)e2 * T + p2] = tok; cwl[(size_t)e1 * T + p1] = c1; cwl[(size_t)e2 * T + p2] = c2;
    typedef int i32x4 __attribute__((ext_vector_type(4))); *(GAS i32x4*)(tinfo + (size_t)tok * 4) = (i32x4){e1, p1, e2, p2}; }
}
}

constexpr int MOE_TAB = RING_BYTES + 512;
__device__ __forceinline__ void moe_tables(Frame& F, gu32* gcnt) {
  LAS int* tab = (LAS int*)(F.lds + MOE_TAB);
  if (F.tid == 0) { int o = 0, c = 0; for (int e = 0; e < NEXP; ++e) { const int n = (int)__hip_atomic_load(gcnt + e, __ATOMIC_RELAXED, __HIP_MEMORY_SCOPE_AGENT); tab[e] = n; tab[32 + e] = o; tab[66 + e] = c; o += n; c += (n + 255) >> 8; } tab[64] = o; tab[98] = c; }
  __syncthreads();
}
template <bool DOWN>
struct ProbMoE {
  int K; const char* Abase; const char* Wt; const int* list; const LAS int* tab; int G, c;
  __device__ __forceinline__ bool next(int i, Unit& u) const {
    const int L = i * G + c, ntile = tab[98]; if (L >= ntile * 4) return false;
    const int tile = L >> 2; u.pn = L & 3;
    int e = 0;
#pragma unroll 1
    for (int s = 16; s >= 1; s >>= 1) if (e + s < NEXP && tab[66 + e + s] <= tile) e += s;
    u.e = e; u.pm = tile - tab[66 + e]; u.nrows = tab[e] - u.pm * 256; if (u.nrows > 256) u.nrows = 256; u.row0 = tab[32 + e] + u.pm * 256; return true;
  }
  __device__ __forceinline__ unsigned a_row_off(const Unit& u, int r) const {
    const int rr = r < u.nrows ? r : (u.nrows - 1);
    if (DOWN) return (unsigned)(u.row0 + rr) * (unsigned)K * 2u;
    const int tok = list[(size_t)u.e * T + u.pm * 256 + rr]; return (unsigned)tok * (unsigned)K * 2u;
  }
  __device__ __forceinline__ const char* b_rows(const Unit& u) const { return Wt + ((size_t)u.e * 1024 + (size_t)u.pn * 256) * K * 2; }
};
struct EpiGateUp {
  bf16_t* hid; const float* cwl;
  __device__ __forceinline__ void operator()(const f32x4 (&acc)[2][2][4][2], const Unit& u, int wr, int wc, int fr, int fq) const {
    const int f0 = u.pn * 128 + wc * 32 + 8 * fq;
#pragma unroll
    for (int ai = 0; ai < 2; ++ai)
#pragma unroll
      for (int m = 0; m < 4; ++m) { const int r = ai * HALF + wr * 64 + m * 16 + fr;
        if (r < u.nrows) { const float cw = cwl[(size_t)u.e * T + u.pm * 256 + r];
          const f32x4 a0 = acc[ai][0][m][0], a1 = acc[ai][0][m][1], u0 = acc[ai][1][m][0], u1 = acc[ai][1][m][1]; float hv[8];
#pragma unroll
          for (int i = 0; i < 4; ++i) { hv[i] = fsilu(a0[i]) * u0[i] * cw; hv[4 + i] = fsilu(a1[i]) * u1[i] * cw; }
          u32x4 w; w.x = cvt_pk_bf16(hv[0], hv[1]); w.y = cvt_pk_bf16(hv[2], hv[3]); w.z = cvt_pk_bf16(hv[4], hv[5]); w.w = cvt_pk_bf16(hv[6], hv[7]);
          *(GAS u32x4*)(hid + (size_t)(u.row0 + r) * FE + f0) = w; } }
  }
};
struct EpiDown {
  bf16_t* y;
  __device__ __forceinline__ void operator()(const f32x4 (&acc)[2][2][4][2], const Unit& u, int wr, int wc, int fr, int fq) const {
    const int col0 = u.pn * BM + wc * 32 + 8 * fq;
#pragma unroll
    for (int ai = 0; ai < 2; ++ai)
#pragma unroll
      for (int m = 0; m < 4; ++m) { const int r = ai * HALF + wr * 64 + m * 16 + fr;
        if (r < u.nrows) {
#pragma unroll
          for (int bj = 0; bj < 2; ++bj) { const f32x4 v0 = acc[ai][bj][m][0], v1 = acc[ai][bj][m][1];
            u32x4 w; w.x = cvt_pk_bf16(v0[0], v0[1]); w.y = cvt_pk_bf16(v0[2], v0[3]); w.z = cvt_pk_bf16(v1[0], v1[1]); w.w = cvt_pk_bf16(v1[2], v1[3]);
            *(GAS u32x4*)(y + (size_t)(u.row0 + r) * DM + col0 + bj * HALF) = w; } } }
  }
};
__device__ __forceinline__ void final_phase(Frame& F, const Args& a, const bf16_t* y) {
  const LAS int* tab = (const LAS int*)(F.lds + MOE_TAB); const int* tinfo = (const int*)(a.ws + rt::R_TINFO); const float* gf = a.in[16];
  const int gw = F.vcu * NWAVES + F.wave, NGW = F.G * NWAVES, lane = F.lane;
  for (int t = gw; t < T; t += NGW) { typedef int i32x4 __attribute__((ext_vector_type(4))); const i32x4 ti = *(const GAS i32x4*)(tinfo + (size_t)t * 4);
    const int s1 = tab[32 + ti[0]] + ti[1], s2 = tab[32 + ti[2]] + ti[3];
    GAS f32x4* op = (GAS f32x4*)(a.out + (size_t)t * DM) + lane; const GAS u32x2* y1 = (const GAS u32x2*)(y + (size_t)s1 * DM) + lane; const GAS u32x2* y2 = (const GAS u32x2*)(y + (size_t)s2 * DM) + lane;
    f32x4 v[4]; float s = 0.f;
#pragma unroll
    for (int jj = 0; jj < 4; ++jj) { const f32x4 hv = op[64 * jj]; const u32x2 p = y1[64 * jj], q2 = y2[64 * jj];
      v[jj].x = hv.x + bflo(p.x) + bflo(q2.x); v[jj].y = hv.y + bfhi(p.x) + bfhi(q2.x); v[jj].z = hv.z + bflo(p.y) + bflo(q2.y); v[jj].w = hv.w + bfhi(p.y) + bfhi(q2.y);
      s += (v[jj].x * v[jj].x + v[jj].y * v[jj].y) + (v[jj].z * v[jj].z + v[jj].w * v[jj].w); }
    const float rstd = 1.f / sqrtf(wave_sum(s) * (1.f / DM) + 1e-6f);
#pragma unroll
    for (int jj = 0; jj < 4; ++jj) { const f32x4 gg = ((const GAS f32x4*)gf)[lane + 64 * jj]; op[64 * jj] = v[jj] * rstd * gg; } }
}
}
namespace mk {
#ifndef MK_STAGE
#define MK_STAGE 1
#endif
constexpr int N_PHASES = 11;

__global__ void __launch_bounds__(NTHR, 2) mk_fwd(Args args) {
  extern __shared__ __attribute__((aligned(16))) unsigned char lds_raw[];
  Frame F;
  F.lds = (LAS unsigned char*)lds_raw;
  F.MISC = (volatile LAS unsigned*)(F.lds + MISC_OFF);
  F.tid = threadIdx.x; F.lane = F.tid & 63; F.wave = __builtin_amdgcn_readfirstlane(F.tid >> 6);
  F.G = gridDim.x; { const int bx = blockIdx.x; F.vcu = (F.G % 8 == 0) ? (bx % 8) * (F.G / 8) + bx / 8 : bx; }
  unsigned char* ws = args.ws;
  gu32* ctl = (gu32*)(ws + WS_CTL);
  for (int u = F.tid; u < (LDS_BYTES - RING_BYTES) / 4; u += NTHR) ((LAS unsigned*)(F.lds + RING_BYTES))[u] = 0u;
  __syncthreads();
  XcdBarrier bar = xcd_barrier_post((unsigned*)(ctl + CW_BAR), F.MISC + 8);
  const int lo = args.ph_lo, hi = args.ph_hi;
#ifndef MK_REPEAT_MASK
#define MK_REPEAT_MASK 0
#endif
#define REP(k) for (int rep_ = 0; rep_ < (((MK_REPEAT_MASK) >> (k)) & 1) + 1; ++rep_)
#define REP2(k, stmt) do { stmt; if (((MK_REPEAT_MASK) >> (k)) & 1) { asm volatile("" ::: "memory"); stmt; } } while (0)
#define IN(k) (lo <= (k) && (k) < hi)
#define BOTH(k) (IN(k) && IN((k) + 1))
#define GRID_BAR() xcd_barrier(bar)

  if (IN(0)) { REP2(0, (p0_prologue<(MK_STAGE >= 5)>(F, args))); if (MK_STAGE >= 5) rt::build_wr(F.vcu * NTHR + F.tid, F.G * NTHR, args); if (BOTH(0)) GRID_BAR(); }

  if (IN(1)) {
    ProbPlain P; P.init(ws + WS_XN, ws + WS_WIN, T, NCOL, DM, F.G, (int)blockIdx.x);
    EpiInProj E{ws, (const float*)(ws + WS_ROPE), (const float*)(ws + WS_ROPE) + (size_t)T * 32};
    REP2(1, (gemm_phase<ProbPlain, EpiInProj, true>(F.lds, P, E)));
    if (BOTH(1)) GRID_BAR();
  }
  if (IN(2)) {
    if (MK_STAGE >= 3) REP(11) {
      for (int it = F.vcu; it < 256; it += F.G) { int tid_ = threadIdx.x; asm volatile("" : "+v"(tid_));
        hg::hgrn_item<false>(tid_, it >> 6, (it >> 5) & 1, it & 31, ws, args.out + 8 * 1048576, args.out + 12 * 1048576, F.lds); }
    }
    REP(2) for (int u = F.vcu; u < 256; u += F.G) att2::attn_unit(u >> 6, u & 63, ws, args.in[5], args.out + (size_t)blockIdx.x * 32768, (LAS char*)F.lds);
    if (BOTH(2)) GRID_BAR();
  }
  if (IN(3)) { hg::hgrn_scan(F.vcu * NTHR + F.tid, F.G * NTHR, args.out + 8 * 1048576, args.out + 12 * 1048576); if (BOTH(3)) GRID_BAR(); }
  if (IN(4)) {
    REP(4) for (int it = F.vcu; it < 256; it += F.G) { int tid_ = threadIdx.x; asm volatile("" : "+v"(tid_));
      hg::hgrn_item<true>(tid_, it >> 6, (it >> 5) & 1, it & 31, ws, args.out + 8 * 1048576, args.out + 12 * 1048576, F.lds); }
    if (BOTH(4)) GRID_BAR();
  }
  if (IN(5)) { REP(5) hg::hgrn_combine(F.vcu * NWAVES + F.wave, F.G * NWAVES, F.lane, ws, args.in[6]); if (BOTH(5)) GRID_BAR(); }
  if (IN(6)) {
    ProbPlain P; P.init(ws + WS_XN, ws + WS_WOUT, T, DM, DM, F.G, (int)blockIdx.x);
    EpiOutProj E{args.in[0], args.out};
    REP2(6, (gemm_phase<ProbPlain, EpiOutProj, true>(F.lds, P, E)));
    if (BOTH(6)) GRID_BAR();
  }
  if (IN(7)) { rt::router_phase(F, args, ctl + CW_CNT); if (BOTH(7)) GRID_BAR(); }
  if (IN(8)) {
    moe_tables(F, ctl + CW_CNT);
    ProbMoE<false> P{DM, (const char*)(ws + WS_XN), (const char*)(ws + WS_WGU), (const int*)(ws + rt::R_LIST), (const LAS int*)(F.lds + MOE_TAB), F.G, (int)blockIdx.x};
    EpiGateUp E{(bf16_t*)(ws + WS_Q), (const float*)(ws + rt::R_CWL)};
    REP2(8, (gemm_phase<ProbMoE<false>, EpiGateUp, true>(F.lds, P, E)));
    if (BOTH(8)) GRID_BAR();
  }
  if (IN(9)) {
    if (!IN(8)) moe_tables(F, ctl + CW_CNT);
    ProbMoE<true> P{FE, (const char*)(ws + WS_Q), (const char*)(ws + WS_WD), (const int*)(ws + rt::R_LIST), (const LAS int*)(F.lds + MOE_TAB), F.G, (int)blockIdx.x};
    EpiDown E{(bf16_t*)(ws + WS_V)};
    REP2(9, (gemm_phase<ProbMoE<true>, EpiDown, true>(F.lds, P, E)));
    if (BOTH(9)) GRID_BAR();
  }
  if (IN(10)) { if (!IN(8) && !IN(9)) moe_tables(F, ctl + CW_CNT); final_phase(F, args, (const bf16_t*)(ws + WS_V)); }
#undef IN
#undef BOTH
#undef GRID_BAR
}
}

extern "C" void kernel_launch(void* const* d_in, const int* in_sizes, int n_in, void* d_out, int out_size, void* d_ws, size_t ws_size, hipStream_t stream) {
  using namespace mk;
  static int grid = 0;
  if (grid == 0) {
    if (n_in != 17 || in_sizes[0] != T * DM || out_size != T * DM || ws_size < WS_END) { fprintf(stderr, "kernel_launch: unexpected shapes n_in %d out %d ws %zu (need %zu)\n", n_in, out_size, ws_size, (size_t)WS_END); grid = -1; return; }
    int dev = 0, cus = 0, per_cu = 0;
    if (hipGetDevice(&dev) != hipSuccess || hipDeviceGetAttribute(&cus, hipDeviceAttributeMultiprocessorCount, dev) != hipSuccess) { grid = -1; return; }
    if (hipFuncSetAttribute((const void*)mk_fwd, hipFuncAttributeMaxDynamicSharedMemorySize, LDS_BYTES) != hipSuccess) { fprintf(stderr, "kernel_launch: hipFuncSetAttribute failed\n"); grid = -1; return; }
    if (hipOccupancyMaxActiveBlocksPerMultiprocessor(&per_cu, (const void*)mk_fwd, NTHR, LDS_BYTES) != hipSuccess || per_cu < 1) { fprintf(stderr, "kernel_launch: occupancy query says %d blocks/CU\n", per_cu); per_cu = 1; }
    (void)hipGetLastError();
    grid = cus;
  }
  if (grid < 0) return;
  (void)hipMemsetAsync((char*)d_ws + WS_CTL, 0, CTL_ZERO_BYTES, stream);
  Args a{};
  for (int i = 0; i < 17; ++i) a.in[i] = (const float*)d_in[i];
  a.out = (float*)d_out; a.ws = (unsigned char*)d_ws;
  const int stage_hi[6] = {0, 2, 3, 6, 7, N_PHASES};
  a.ph_lo = 0; a.ph_hi = stage_hi[MK_STAGE];
  hipLaunchKernelGGL(mk_fwd, dim3(grid), dim3(NTHR), LDS_BYTES, stream, a);
#if MK_STAGE < 5
  { unsigned char* ws = (unsigned char*)d_ws; nv::Bufs b{};
    int* rt = (int*)(ws + WS_ROUTE);
    b.cnt = rt; b.off = rt + 64; b.tpos = rt + 1024; b.tcw = (float*)(rt + 1024 + 4 * T); b.cw = (float*)(rt + 1024 + 6 * T); b.list = rt + 1024 + 8 * T;
    b.scratch = (float*)d_out;
    b.Qb = (const unsigned short*)(ws + WS_Q); b.Kb = (const unsigned short*)(ws + WS_K); b.Vb = (const unsigned short*)(ws + WS_V);
    b.HQ = (const unsigned short*)(ws + WS_HQ); b.ZF = (const unsigned short*)(ws + WS_ZF); b.ZB = (const unsigned short*)(ws + WS_ZB); b.HI = (const unsigned short*)(ws + WS_HI); b.HG = (const unsigned short*)(ws + WS_HG);
    b.mixb = (unsigned short*)(ws + WS_XN);
    b.xt = (float*)(ws + WS_Q); b.hid = (float*)(ws + WS_Q + 64 * MiB);
    nv::run(d_in, (float*)d_out, b, MK_STAGE, stream); }
#endif
}
```

```cpp
#define MK_STAGE 5
#define MK_REPEAT_MASK 0
#include <hip/hip_runtime.h>
#include <cstdio>
#include <cstdint>
#include <cmath>
namespace mk {
#define LAS __attribute__((address_space(3)))
#define GAS __attribute__((address_space(1)))
typedef unsigned short bf16_t;
typedef short bf16x8 __attribute__((ext_vector_type(8)));
typedef short s16x4 __attribute__((ext_vector_type(4)));
typedef float f32x4 __attribute__((ext_vector_type(4)));
typedef float f32x2 __attribute__((ext_vector_type(2)));
typedef float f32x16 __attribute__((ext_vector_type(16)));
typedef unsigned u32x4 __attribute__((ext_vector_type(4)));
typedef unsigned u32x2 __attribute__((ext_vector_type(2)));
typedef GAS unsigned gu32;

constexpr int T = 16384, DM = 1024, NCOL = 4096, NEXP = 32, FE = 512;
constexpr int NWAVES = 8, NTHR = 512;
constexpr float LOG2E = 1.4426950408889634f;

__device__ __forceinline__ unsigned cvt_pk_bf16(float lo, float hi) { unsigned r; asm volatile("v_cvt_pk_bf16_f32 %0, %1, %2" : "=v"(r) : "v"(lo), "v"(hi)); return r; }
__device__ __forceinline__ float bf2f(unsigned short h) { return __uint_as_float((unsigned)h << 16); }
__device__ __forceinline__ float bflo(unsigned w) { return __uint_as_float(w << 16); }
__device__ __forceinline__ float bfhi(unsigned w) { return __uint_as_float(w & 0xffff0000u); }
__device__ __forceinline__ float wave_sum(float v) {
#pragma unroll
  for (int o = 1; o < 64; o <<= 1) v += __shfl_xor(v, o);
  return v;
}
__device__ __forceinline__ float fexp2(float x) { return __builtin_amdgcn_exp2f(x); }
__device__ __forceinline__ float flog2(float x) { return __builtin_amdgcn_logf(x); }
__device__ __forceinline__ float fsigm(float z) { return __builtin_amdgcn_rcpf(1.f + fexp2(-LOG2E * z)); }
__device__ __forceinline__ float fsilu(float z) { return z * fsigm(z); }
#define LDS_WAIT() asm volatile("s_waitcnt lgkmcnt(0)" ::: "memory")
#define VM_WAIT() asm volatile("s_waitcnt vmcnt(0)" ::: "memory")

#define XB_TMO      128
#define XB_XCNT(j)  (256  + 64 * (j))
#define XB_XSUB(j)  (1280 + 64 * (j))
#define XB_XGEN(j)  (2304 + 64 * (j))
#define XB_TOP      3328
#define XB_TOPGEN   3392
#define XCD_BAR_WORDS 3456
#define XB_SPIN_CAP (1u << 22)
__device__ __forceinline__ unsigned xb_ld(unsigned* p)              { return __hip_atomic_load(p, __ATOMIC_RELAXED, __HIP_MEMORY_SCOPE_AGENT); }
__device__ __forceinline__ unsigned xb_add(unsigned* p, unsigned v) { return __hip_atomic_fetch_add(p, v, __ATOMIC_RELAXED, __HIP_MEMORY_SCOPE_AGENT); }
__device__ __forceinline__ unsigned xb_xcc_id() { return (unsigned)__builtin_amdgcn_s_getreg((3 << 11) | 20) & 0xFu; }
#define XB_SPIN(cond, bar) do { unsigned _sp = 0; while (cond) { __builtin_amdgcn_s_sleep(1); \
    if ((++_sp & 255u) == 0u) { if (xb_ld(&(bar)[XB_TMO])) break; if (_sp > XB_SPIN_CAP) { atomicAdd(&(bar)[XB_TMO], 1u); break; } } } } while (0)
struct XcdBarrier { unsigned* bar; unsigned x; volatile LAS unsigned* st; };
__device__ __forceinline__ XcdBarrier xcd_barrier_post(unsigned* bar, volatile LAS unsigned* st) {
  XcdBarrier b; b.bar = bar; b.x = xb_xcc_id(); b.st = st;
  if (threadIdx.x == 0) (void)xb_add(&bar[XB_XCNT(b.x)], 1u);
  return b;
}
__device__ __forceinline__ void xcd_barrier_complete(unsigned* bar, unsigned x, unsigned& nloc, unsigned& nx) {
  const unsigned G = gridDim.x * gridDim.y * gridDim.z;
  unsigned sum, cnt, mine, sp = 0u;
  for (;;) {
    sum = 0u; cnt = 0u; mine = 0u;
#pragma unroll
    for (unsigned j = 0; j < 16; ++j) { const unsigned c = xb_ld(&bar[XB_XCNT(j)]); sum += c; cnt += (c > 0u) ? 1u : 0u; mine = (j == x) ? c : mine; }
    if (sum == G) break;
    __builtin_amdgcn_s_sleep(1);
    if ((++sp & 255u) == 0u) { if (xb_ld(&bar[XB_TMO])) break; if (sp > XB_SPIN_CAP) { atomicAdd(&bar[XB_TMO], 1u); break; } }
  }
  nloc = mine > 0u ? mine : 1u; nx = cnt > 0u ? cnt : 1u;
}
__device__ __forceinline__ void xcd_barrier(const XcdBarrier& b) {
  asm volatile("s_waitcnt vmcnt(0)" ::: "memory");
  __syncthreads();
  if (threadIdx.x == 0) {
    unsigned* bar = b.bar;
    __builtin_amdgcn_s_waitcnt(0);
    unsigned nloc = b.st[0], nx = b.st[1];
    if (nloc == 0u) { xcd_barrier_complete(bar, b.x, nloc, nx); b.st[0] = nloc; b.st[1] = nx; }
    const unsigned old = xb_add(&bar[XB_XSUB(b.x)], 1u);
    const unsigned gen = old / nloc;
    if (old + 1u == (gen + 1u) * nloc) {
      __builtin_amdgcn_fence(__ATOMIC_RELEASE, "agent");
      asm volatile("s_waitcnt vmcnt(0)" ::: "memory");
      const unsigned og = xb_add(&bar[XB_TOP], 1u);
      const unsigned tg = og / nx;
      if (og + 1u == (tg + 1u) * nx) xb_add(&bar[XB_TOPGEN], 1u);
      else XB_SPIN(xb_ld(&bar[XB_TOPGEN]) == tg, bar);
      __builtin_amdgcn_fence(__ATOMIC_ACQUIRE, "agent");
      xb_add(&bar[XB_XGEN(b.x)], 1u);
      asm volatile("s_waitcnt vmcnt(0)" ::: "memory");
    } else {
      XB_SPIN(xb_ld(&bar[XB_XGEN(b.x)]) == gen, bar);
      __builtin_amdgcn_fence(__ATOMIC_ACQUIRE, "agent");
      asm volatile("s_waitcnt vmcnt(0)" ::: "memory");
    }
  }
  __syncthreads();
}

constexpr int BM = 256, BK = 64, HALF = 128, HTB = HALF * BK * 2, STAGE_BYTES = 8 * HTB, NXCD = 8, WGM = 8;
__device__ __forceinline__ int lds_byte(int r, int c) { const int st = (r >> 4) * 2 + (c >> 5), rr = r & 15, cc = c & 31, ob = rr * 64 + cc * 2; return st * 1024 + (ob ^ (((ob >> 9) & 1) << 5)); }
__device__ __forceinline__ void stage_rc(int b, int& R, int& C) { const int st = b / 1024, sb = b % 1024, swz = sb ^ (((sb >> 9) & 1) << 5); R = (st >> 1) * 16 + swz / 64; C = (st & 1) * 32 + (swz % 64) / 2; }
__device__ __forceinline__ int perm32(int rho) { const int n = rho >> 4, i = rho & 15; return 8 * (i >> 2) + 4 * n + (i & 3); }

struct Unit { int pm, pn, e, nrows, row0; };

template <class Prob, class Epi, bool ALIGN_EPI>
__device__ __forceinline__ void gemm_phase(LAS unsigned char* lds, const Prob& P, const Epi& E) {
  const int tid = threadIdx.x, wid = __builtin_amdgcn_readfirstlane(tid >> 6), lane = tid & 63, wr = wid >> 2, wc = wid & 3, fr = lane & 15, fq = lane >> 4;
  const int K = P.K, nt = K / BK;
  int Rr[2], Cc[2]; unsigned voffB[2];
#pragma unroll
  for (int i = 0; i < 2; ++i) { int R, C; stage_rc(tid * 16 + i * 8192, R, C); Rr[i] = R; Cc[i] = C; const int Rb = (R & ~31) + perm32(R & 31); voffB[i] = (unsigned)(Rb * K + C) * 2u; }
  const size_t kstep = (size_t)(BK * 2);
  const size_t hstep = (size_t)HALF * K * 2;
  const unsigned ldsw = (unsigned)wid * 1024u;
  const int aoff = lds_byte(wr * 64 + fr, fq * 8), boff = lds_byte(wc * 32 + fr, fq * 8);
#define PG8_SA(b, h) (((b) * 2 + (h)) * HTB)
#define PG8_SB(b, h) ((4 + (b) * 2 + (h)) * HTB)
#define PG8_STAGE(bufoff, gbase, voff) do { _Pragma("unroll") for (int _i = 0; _i < 2; ++_i) \
        __builtin_amdgcn_global_load_lds((const unsigned*)((const char*)(gbase) + (voff)[_i]), (LAS unsigned*)(lds + (bufoff) + ldsw + _i * 8192), 16, 0, 0); } while (0)
#define PG8_LDA(dst, b, h) do { _Pragma("unroll") for (int m = 0; m < 4; ++m) _Pragma("unroll") for (int k = 0; k < 2; ++k) dst[m][k] = *(const LAS bf16x8*)(lds + PG8_SA(b, h) + aoff + m * 2048 + k * 1024); } while (0)
#define PG8_LDB(dst, b, h) do { _Pragma("unroll") for (int n = 0; n < 2; ++n) _Pragma("unroll") for (int k = 0; k < 2; ++k) dst[n][k] = *(const LAS bf16x8*)(lds + PG8_SB(b, h) + boff + n * 2048 + k * 1024); } while (0)
#define PG8_MMA(ai, bj, At, Bt) do { if (Prob::TAILS && ((ai) ? sk1 : skw)) break; __builtin_amdgcn_s_setprio(1); _Pragma("unroll") for (int m = 0; m < 4; ++m) _Pragma("unroll") for (int n = 0; n < 2; ++n) _Pragma("unroll") for (int k = 0; k < 2; ++k) \
        acc[ai][bj][m][n] = __builtin_amdgcn_mfma_f32_16x16x32_bf16(Bt[n][k], At[m][k], acc[ai][bj][m][n], 0, 0, 0); __builtin_amdgcn_s_setprio(0); } while (0)
#define PG8_WAIT_V(n) asm volatile("s_waitcnt vmcnt(" #n ")" ::: "memory")
#define PG8_WAIT_L(n) asm volatile("s_waitcnt lgkmcnt(" #n ")" ::: "memory")
#define PG8_BAR __builtin_amdgcn_s_barrier()
#define PG8_SCHED __builtin_amdgcn_sched_barrier(0)
  Unit cur, nxt; int ui = 0;
  if (!P.next(0, cur)) return;
  f32x4 acc[2][2][4][2];
#pragma unroll
  for (int a = 0; a < 2; ++a)
#pragma unroll
    for (int b = 0; b < 2; ++b)
#pragma unroll
      for (int m = 0; m < 4; ++m)
#pragma unroll
        for (int n = 0; n < 2; ++n) acc[a][b][m][n] = (f32x4){0.f, 0.f, 0.f, 0.f};
  bf16x8 At[4][2], B0[2][2], B1[2][2];
  unsigned aC0[2], aC1[2], aN0[2], aN1[2];
#pragma unroll
  for (int i = 0; i < 2; ++i) { aC0[i] = P.a_row_off(cur, Rr[i]) + (unsigned)Cc[i] * 2u; aC1[i] = P.a_row_off(cur, HALF + Rr[i]) + (unsigned)Cc[i] * 2u; aN0[i] = aC0[i]; aN1[i] = aC1[i]; }
  const char* const cAb = P.Abase;
  const char* cB = P.b_rows(cur);
  PG8_STAGE(PG8_SB(0, 0), cB, voffB); PG8_STAGE(PG8_SB(0, 1), cB + hstep, voffB); PG8_STAGE(PG8_SA(0, 0), cAb, aC0); PG8_STAGE(PG8_SA(0, 1), cAb, aC1);
  if (wr == 1) PG8_BAR;
  PG8_WAIT_V(2); PG8_BAR;
  PG8_STAGE(PG8_SB(1, 0), cB + kstep, voffB); PG8_STAGE(PG8_SA(1, 0), cAb + kstep, aC0); PG8_STAGE(PG8_SB(1, 1), cB + hstep + kstep, voffB);
  PG8_WAIT_V(6); PG8_BAR;
  for (;;) {
    const bool sk1 = Prob::TAILS && (cur.nrows <= 128 || (cur.nrows <= 192 && wr == 1)), skw = Prob::TAILS && cur.nrows <= 64 && wr == 1;
    const bool has_next = P.next(ui + 1, nxt);
    const char* nB = cB;
    if (has_next) { nB = P.b_rows(nxt);
#pragma unroll
      for (int i = 0; i < 2; ++i) { aN0[i] = P.a_row_off(nxt, Rr[i]) + (unsigned)Cc[i] * 2u; aN1[i] = P.a_row_off(nxt, HALF + Rr[i]) + (unsigned)Cc[i] * 2u; }
    } else {
#pragma unroll
      for (int i = 0; i < 2; ++i) { aN0[i] = aC0[i]; aN1[i] = aC1[i]; }
    }
    for (int t = 0; t < nt; t += 2) {
      const bool last = (t == nt - 2);
      const char* a1 = cAb + (size_t)(t + 1) * kstep;
      const char* a2 = last ? cAb : cAb + (size_t)(t + 2) * kstep; const char* b2 = last ? nB : cB + (size_t)(t + 2) * kstep;
      const char* a3 = a2 + kstep; const char* b3 = b2 + kstep;
      unsigned s0[2], s1[2];
#pragma unroll
      for (int i = 0; i < 2; ++i) { s0[i] = last ? aN0[i] : aC0[i]; s1[i] = last ? aN1[i] : aC1[i]; }
      PG8_LDB(B0, 0, 0); PG8_LDB(B1, 0, 1); PG8_SCHED; PG8_LDA(At, 0, 0); PG8_STAGE(PG8_SA(1, 1), a1, aC1);
      PG8_WAIT_V(8); PG8_WAIT_L(0); PG8_BAR; PG8_MMA(0, 0, At, B0); PG8_MMA(0, 1, At, B1); PG8_BAR; PG8_SCHED;
      PG8_LDA(At, 0, 1); PG8_STAGE(PG8_SB(0, 0), b2, voffB); PG8_STAGE(PG8_SB(0, 1), b2 + hstep, voffB); PG8_STAGE(PG8_SA(0, 0), a2, s0);
      PG8_WAIT_V(8); PG8_WAIT_L(0); PG8_BAR; PG8_MMA(1, 0, At, B0); PG8_MMA(1, 1, At, B1); PG8_BAR; PG8_SCHED;
      PG8_LDB(B0, 1, 0); PG8_LDB(B1, 1, 1); PG8_SCHED; PG8_LDA(At, 1, 0); PG8_STAGE(PG8_SA(0, 1), a2, s1);
      PG8_WAIT_V(8); PG8_WAIT_L(0); PG8_BAR; PG8_MMA(0, 0, At, B0); PG8_MMA(0, 1, At, B1); PG8_BAR; PG8_SCHED;
      PG8_LDA(At, 1, 1); PG8_STAGE(PG8_SB(1, 0), b3, voffB); PG8_STAGE(PG8_SB(1, 1), b3 + hstep, voffB); PG8_STAGE(PG8_SA(1, 0), a3, s0);
      PG8_WAIT_V(8); PG8_WAIT_L(0); PG8_BAR; PG8_MMA(1, 0, At, B0); PG8_MMA(1, 1, At, B1); PG8_BAR; PG8_SCHED;
    }
    if constexpr (ALIGN_EPI) { if (wr == 0) PG8_BAR; }
    E(acc, cur, wr, wc, fr, fq);
    if (!has_next) break;
#pragma unroll
    for (int a = 0; a < 2; ++a)
#pragma unroll
      for (int b = 0; b < 2; ++b)
#pragma unroll
        for (int m = 0; m < 4; ++m)
#pragma unroll
          for (int n = 0; n < 2; ++n) acc[a][b][m][n] = (f32x4){0.f, 0.f, 0.f, 0.f};
    cur = nxt; cB = nB; ++ui;
#pragma unroll
    for (int i = 0; i < 2; ++i) { aC0[i] = aN0[i]; aC1[i] = aN1[i]; }
    if constexpr (ALIGN_EPI) { if (wr == 1) PG8_BAR; }
  }
  PG8_WAIT_V(0);
  if constexpr (!ALIGN_EPI) { if (wr == 0) PG8_BAR; }
  PG8_BAR;
#undef PG8_SA
#undef PG8_SB
#undef PG8_STAGE
#undef PG8_LDA
#undef PG8_LDB
#undef PG8_MMA
#undef PG8_WAIT_V
#undef PG8_WAIT_L
#undef PG8_BAR
#undef PG8_SCHED
}
}
namespace mk {
constexpr size_t MiB = 1u << 20;
constexpr size_t WS_CTL = 0, CTL_ZERO_BYTES = 256 * 1024;
constexpr size_t WS_SMALL = 512 * 1024;
constexpr size_t WS_WIN = 1 * MiB;
constexpr size_t WS_WOUT = 9 * MiB;
constexpr size_t WS_ROPE = 11 * MiB;
constexpr size_t WS_ROUTE = 15 * MiB;
constexpr size_t WS_WGU = 20 * MiB;
constexpr size_t WS_XN = 84 * MiB;
constexpr size_t WS_Q = 116 * MiB;
constexpr size_t WS_K = 132 * MiB;
constexpr size_t WS_V = 148 * MiB;
constexpr size_t WS_HQ = 164 * MiB;
constexpr size_t WS_ZF = 180 * MiB;
constexpr size_t WS_ZB = 196 * MiB;
constexpr size_t WS_HI = 212 * MiB;
constexpr size_t WS_HG = 228 * MiB;
constexpr size_t WS_WD = 244 * MiB;
constexpr size_t WS_END = 276 * MiB;
constexpr int CW_BAR = 1024;
constexpr int CW_CNT = 8192;

constexpr int RING_BYTES = 131072;
constexpr int MISC_OFF = RING_BYTES + 320;
constexpr int LDS_BYTES = 147456;

struct Args {
  const float* in[17]; float* out; unsigned char* ws; int ph_lo, ph_hi;
};

struct Frame {
  LAS unsigned char* lds;
  volatile LAS unsigned* MISC;
  int tid, lane, wave, vcu, G;
};

__device__ __forceinline__ void transpose_item(const float* W, int ldw, int k0, int n0, bf16_t* WT, int Kdst, int dst_row0, LAS float* scr, int lane) {
#pragma unroll 8
  for (int i = 0; i < 32; ++i) { const int kk = 2 * i + (lane >> 5); scr[kk * 33 + (lane & 31)] = W[(size_t)(k0 + kk) * ldw + n0 + (lane & 31)]; }
  LDS_WAIT(); asm volatile("" ::: "memory");
  const int c = lane & 7;
#pragma unroll
  for (int j = 0; j < 4; ++j) { const int n = (lane >> 3) + 8 * j; const LAS float* s = scr + (8 * c) * 33 + n;
    u32x4 o; o.x = cvt_pk_bf16(s[0 * 33], s[1 * 33]); o.y = cvt_pk_bf16(s[2 * 33], s[3 * 33]); o.z = cvt_pk_bf16(s[4 * 33], s[5 * 33]); o.w = cvt_pk_bf16(s[6 * 33], s[7 * 33]);
    *(GAS u32x4*)(WT + (size_t)(dst_row0 + n) * Kdst + k0 + 8 * c) = o; }
  LDS_WAIT(); asm volatile("" ::: "memory");
}
__device__ __forceinline__ int inproj_dst_col(int n0) {
  if (n0 >= 1024) return n0;
  const int R = n0 >> 9, rem = n0 & 511, hc = rem >> 6, bj = (rem >> 5) & 1;
  return R * 512 + (hc >> 2) * 256 + bj * 128 + (hc & 3) * 32;
}
__device__ __forceinline__ void rms_row_to_bf16(const float* xrow, const float* g, bf16_t* orow, int lane) {
  const GAS f32x4* xr = (const GAS f32x4*)xrow + lane;
  f32x4 v[4]; float s = 0.f;
#pragma unroll
  for (int j = 0; j < 4; ++j) { v[j] = xr[64 * j]; s += (v[j].x * v[j].x + v[j].y * v[j].y) + (v[j].z * v[j].z + v[j].w * v[j].w); }
  const float rstd = 1.f / sqrtf(wave_sum(s) * (1.f / DM) + 1e-6f);
  GAS u32x2* o8 = (GAS u32x2*)orow + lane;
#pragma unroll
  for (int j = 0; j < 4; ++j) { const f32x4 gg = ((const GAS f32x4*)g)[lane + 64 * j]; u32x2 w; w.x = cvt_pk_bf16(v[j].x * rstd * gg.x, v[j].y * rstd * gg.y); w.y = cvt_pk_bf16(v[j].z * rstd * gg.z, v[j].w * rstd * gg.w); o8[64 * j] = w; }
}

template <bool MOE_W>
__device__ __forceinline__ void p0_prologue(Frame& F, const Args& a) {
  LAS float* scr = (LAS float*)(F.lds + F.wave * 16384);
  const int gw = F.vcu * NWAVES + F.wave, NGW = F.G * NWAVES;
  const float* w_in = a.in[1]; const float* w_out = a.in[2];
  bf16_t* WinT = (bf16_t*)(a.ws + WS_WIN); bf16_t* WoutT = (bf16_t*)(a.ws + WS_WOUT);
  constexpr int I_IN = 16 * 128, I_OUT = 16 * 32, I_G = 32 * 16 * 16, I_D = 32 * 8 * 32;
  const int NITEMS = I_IN + I_OUT + (MOE_W ? (2 * I_G + I_D) : 0);
  for (int it = gw; it < NITEMS; it += NGW) {
    int r = it;
    if (r < I_IN) { const int kb = r / 128, nb = r % 128; transpose_item(w_in, NCOL, 64 * kb, 32 * nb, WinT, DM, inproj_dst_col(32 * nb), scr, F.lane); continue; } r -= I_IN;
    if (r < I_OUT) { const int kb = r / 32, nb = r % 32; transpose_item(w_out, DM, 64 * kb, 32 * nb, WoutT, DM, 32 * nb, scr, F.lane); continue; } r -= I_OUT;
    if (MOE_W) {
      bf16_t* WguT = (bf16_t*)(a.ws + WS_WGU); bf16_t* WdT = (bf16_t*)(a.ws + WS_WD);
      if (r < 2 * I_G) { const int which = r / I_G; r -= which * I_G; const int e = r / 256, q = r % 256, kb = q / 16, nb = q % 16;
        const float* W = (which ? a.in[14] : a.in[13]) + (size_t)e * DM * FE; const int f0 = 32 * nb;
        transpose_item(W, FE, 64 * kb, f0, WguT + (size_t)e * 1024 * DM, DM, (f0 >> 7) * 256 + which * 128 + (f0 & 127), scr, F.lane); continue; } r -= 2 * I_G;
      { const int e = r / 256, q = r % 256, kb = q / 32, nb = q % 32;
        transpose_item(a.in[15] + (size_t)e * FE * DM, DM, 64 * kb, 32 * nb, WdT + (size_t)e * DM * FE, FE, 32 * nb, scr, F.lane); }
    }
  }
  { const float* x = a.in[0]; bf16_t* XN = (bf16_t*)(a.ws + WS_XN);
    for (int m = gw; m < T; m += NGW) rms_row_to_bf16(x + (size_t)m * DM, a.in[3], XN + (size_t)m * DM, F.lane); }
  { float* cs = (float*)(a.ws + WS_ROPE); float* sn = cs + (size_t)T * 32;
    const int gt = F.vcu * NTHR + F.tid, NGT = F.G * NTHR;
    for (int idx = gt; idx < T * 32; idx += NGT) { const int j = idx & 31, t = idx >> 5;
      const float inv = powf(10000.0f, -(float)(2 * j) / 64.0f); const float ang = (float)t * inv;
      const double ad = (double)ang; const double kq = rint(ad * 0.15915494309189535); const float rr = (float)(ad - kq * 6.283185307179586);
      cs[idx] = cosf(rr); sn[idx] = sinf(rr); } }
  if (F.vcu == 0 && F.wave == 0) {
    float* sm = (float*)(a.ws + WS_SMALL); const float* lp = a.in[4];
    float d1 = lp[F.lane] * lp[64 + F.lane], d2 = lp[128 + F.lane] * lp[192 + F.lane];
    d1 = wave_sum(d1); d2 = wave_sum(d2);
    if (F.lane == 0) sm[0] = expf(d1) - expf(d2) + 0.2f;
    const float* lbl = a.in[7];
    for (int i = F.lane; i < 1024; i += 64) { const int dir = i >> 9, c = i & 511; const float a0 = lbl[(dir * 2 + 0) * 512 + c], a1 = lbl[(dir * 2 + 1) * 512 + c];
      const float mx = fmaxf(a0, a1); const float e0 = expf(a0 - mx), e1 = expf(a1 - mx); sm[64 + i] = e0 / (e0 + e1); }
  }
}

struct ProbPlain {
  static constexpr bool TAILS = false;
  int K; const char* Abase; const char* Bt; int nM, nN, nwg, G, c;
  __device__ __forceinline__ void init(const void* A, const void* B, int M, int N, int K_, int G_, int c_) { Abase = (const char*)A; Bt = (const char*)B; K = K_; nM = M / BM; nN = N / BM; nwg = nM * nN; G = G_; c = c_; }
  __device__ __forceinline__ bool next(int i, Unit& u) const {
    const long L = (long)i * G + c; if (L >= nwg) return false;
    int wgid = (int)L; { const int q = nwg / NXCD, r = nwg % NXCD, xcd = wgid % NXCD, off = wgid / NXCD; wgid = (xcd < r ? xcd * (q + 1) : r * (q + 1) + (xcd - r) * q) + off; }
    const int nig = WGM * nN, gid = wgid / nig, fm = gid * WGM, gsz = (nM - fm) < WGM ? (nM - fm) : WGM;
    u.pm = fm + ((wgid % nig) % gsz); u.pn = (wgid % nig) / gsz; u.e = 0; u.nrows = 256; u.row0 = u.pm * 256; return true;
  }
  __device__ __forceinline__ unsigned a_row_off(const Unit& u, int r) const { return (unsigned)(u.pm * BM + r) * (unsigned)K * 2u; }
  __device__ __forceinline__ const char* b_rows(const Unit& u) const { return Bt + (size_t)u.pn * BM * K * 2; }
};

struct EpiInProj {
  unsigned char* ws; const float* cs; const float* sn;
  __device__ __forceinline__ void operator()(const f32x4 (&acc)[2][2][4][2], const Unit& u, int wr, int wc, int fr, int fq) const {
    const int row0 = u.pm * BM + wr * 64 + fr, pn = u.pn;
    if (pn < 4) {
      bf16_t* base = (bf16_t*)(ws + (pn < 2 ? WS_Q : WS_K)) + (size_t)(4 * (pn & 1) + wc) * T * 64;
#pragma unroll
      for (int ai = 0; ai < 2; ++ai)
#pragma unroll
        for (int m = 0; m < 4; ++m) { const int t = row0 + ai * HALF + m * 16;
          const f32x4 c0 = *(const f32x4*)(cs + (size_t)t * 32 + 8 * fq), c1 = *(const f32x4*)(cs + (size_t)t * 32 + 8 * fq + 4);
          const f32x4 s0 = *(const f32x4*)(sn + (size_t)t * 32 + 8 * fq), s1 = *(const f32x4*)(sn + (size_t)t * 32 + 8 * fq + 4);
          const f32x4 x1a = acc[ai][0][m][0], x1b = acc[ai][0][m][1], x2a = acc[ai][1][m][0], x2b = acc[ai][1][m][1];
          const float qs = pn < 2 ? 0.125f * LOG2E : 1.f;
          const f32x4 o1a = (x1a * c0 - x2a * s0) * qs, o1b = (x1b * c1 - x2b * s1) * qs, o2a = (x1a * s0 + x2a * c0) * qs, o2b = (x1b * s1 + x2b * c1) * qs;
          u32x4 w1, w2; w1.x = cvt_pk_bf16(o1a[0], o1a[1]); w1.y = cvt_pk_bf16(o1a[2], o1a[3]); w1.z = cvt_pk_bf16(o1b[0], o1b[1]); w1.w = cvt_pk_bf16(o1b[2], o1b[3]);
          w2.x = cvt_pk_bf16(o2a[0], o2a[1]); w2.y = cvt_pk_bf16(o2a[2], o2a[3]); w2.z = cvt_pk_bf16(o2b[0], o2b[1]); w2.w = cvt_pk_bf16(o2b[2], o2b[3]);
          bf16_t* rp = base + (size_t)t * 64 + 8 * fq;
          *(u32x4*)rp = w1; *(u32x4*)(rp + 32) = w2; }
    } else if (pn < 6) {
#pragma unroll
      for (int bj = 0; bj < 2; ++bj) { bf16_t* base = (bf16_t*)(ws + WS_V) + (size_t)(2 * (pn - 4) + bj) * T * 128 + wc * 32 + 8 * fq;
#pragma unroll
        for (int ai = 0; ai < 2; ++ai)
#pragma unroll
          for (int m = 0; m < 4; ++m) { const int t = row0 + ai * HALF + m * 16; const f32x4 v0 = acc[ai][bj][m][0], v1 = acc[ai][bj][m][1];
            u32x4 w; w.x = cvt_pk_bf16(v0[0], v0[1]); w.y = cvt_pk_bf16(v0[2], v0[3]); w.z = cvt_pk_bf16(v1[0], v1[1]); w.w = cvt_pk_bf16(v1[2], v1[3]);
            *(u32x4*)(base + (size_t)t * 128) = w; } }
    } else {
      const int reg = (pn - 6) >> 1; const bool act = (reg == 0) || (reg == 4);
      bf16_t* base = (bf16_t*)(ws + WS_HQ + (size_t)reg * 16 * MiB) + ((pn - 6) & 1) * 256 + wc * 32 + 8 * fq;
#pragma unroll
      for (int bj = 0; bj < 2; ++bj)
#pragma unroll
        for (int ai = 0; ai < 2; ++ai)
#pragma unroll
          for (int m = 0; m < 4; ++m) { const int t = row0 + ai * HALF + m * 16; f32x4 v0 = acc[ai][bj][m][0], v1 = acc[ai][bj][m][1];
            if (act) {
#pragma unroll
              for (int i = 0; i < 4; ++i) { v0[i] = fsilu(v0[i]); v1[i] = fsilu(v1[i]); } }
            u32x4 w; w.x = cvt_pk_bf16(v0[0], v0[1]); w.y = cvt_pk_bf16(v0[2], v0[3]); w.z = cvt_pk_bf16(v1[0], v1[1]); w.w = cvt_pk_bf16(v1[2], v1[3]);
            *(u32x4*)(base + (size_t)t * 512 + bj * 128) = w; }
    }
  }
};
}
namespace mk {
namespace att {
constexpr int NW = 8, QBLK = 32, KVBLK = 64, DV = 128, DQK = 64;
constexpr float SCALE = 1.0f / LOG2E;
constexpr float THR = 8.f;
constexpr int SHM_V = KVBLK * DV * 2, SHM_K = KVBLK * DQK * 2;
constexpr int SHM_ATTN = 2 * SHM_V + 2 * SHM_K + NW * 64 * 4;
#define KSWZ(row, colB) ((row) * 128 + ((colB) ^ ((((row) >> 1) & 7) << 4)))
#define SBAR() __builtin_amdgcn_sched_barrier(0)
__device__ __forceinline__ int crow(int r, int hi) { return (r & 3) + 8 * (r >> 2) + 4 * hi; }

__device__ __forceinline__ void partialSM(f32x16& p0, f32x16& p1, float& m_reg, float& mn, float& alpha) {
  constexpr float C = SCALE * LOG2E;
  float pmax = p0[0];
#pragma unroll
  for (int r = 1; r < 16; ++r) pmax = fmaxf(pmax, p0[r]);
#pragma unroll
  for (int r = 0; r < 16; ++r) pmax = fmaxf(pmax, p1[r]);
  { auto rr = __builtin_amdgcn_permlane32_swap(__float_as_uint(pmax), __float_as_uint(pmax), false, false);
    pmax = fmaxf(__uint_as_float(rr[0]), __uint_as_float(rr[1])); }
  if (__builtin_expect(__all(pmax - m_reg <= THR / SCALE), 1)) { mn = m_reg; alpha = 1.f; }
  else { mn = fmaxf(m_reg, pmax); alpha = __builtin_amdgcn_exp2f((m_reg - mn) * C); m_reg = mn; }
  const float mnC = -mn * C;
#pragma unroll
  for (int r = 0; r < 16; ++r) p0[r] = fmaf(p0[r], C, mnC);
#pragma unroll
  for (int r = 0; r < 16; ++r) p1[r] = fmaf(p1[r], C, mnC);
#pragma unroll
  for (int r = 0; r < 16; ++r) p0[r] = __builtin_amdgcn_exp2f(p0[r]);
}
__device__ __forceinline__ void finishSM(f32x16& p0, f32x16& p1, float alpha, float& l_reg, bf16x8& pa0, bf16x8& pa1, bf16x8& pa2, bf16x8& pa3) {
#pragma unroll
  for (int r = 0; r < 16; ++r) p1[r] = __builtin_amdgcn_exp2f(p1[r]);
  float ps = 0;
#pragma unroll
  for (int r = 0; r < 16; ++r) ps += p0[r];
#pragma unroll
  for (int r = 0; r < 16; ++r) ps += p1[r];
  { auto rr = __builtin_amdgcn_permlane32_swap(__float_as_uint(ps), __float_as_uint(ps), false, false);
    ps = __uint_as_float(rr[0]) + __uint_as_float(rr[1]); }
  l_reg = l_reg * alpha + ps;
#define PK4(P, BASE, OUT) do { unsigned a0 = cvt_pk_bf16(P[BASE + 0], P[BASE + 1]), a1 = cvt_pk_bf16(P[BASE + 2], P[BASE + 3]);   \
    unsigned b0 = cvt_pk_bf16(P[BASE + 4], P[BASE + 5]), b1 = cvt_pk_bf16(P[BASE + 6], P[BASE + 7]);                              \
    auto r0 = __builtin_amdgcn_permlane32_swap(a0, b0, false, false); auto r1 = __builtin_amdgcn_permlane32_swap(a1, b1, false, false); \
    u32x4 w = {r0[0], r1[0], r0[1], r1[1]}; OUT = __builtin_bit_cast(bf16x8, w); } while (0)
  PK4(p0, 0, pa0); PK4(p0, 8, pa1); PK4(p1, 0, pa2); PK4(p1, 8, pa3);
#undef PK4
}
__device__ __forceinline__ void qkt(f32x16& p0, f32x16& p1, const LAS char* Ks, const bf16x8* qr, int r32, int hi) {
  p0 = f32x16{}; p1 = f32x16{};
#pragma unroll
  for (int d0 = 0; d0 < 4; ++d0) { const int cb = (d0 * 16 + hi * 8) * 2;
    const bf16x8 b0 = *(const LAS bf16x8*)(Ks + KSWZ(r32, cb));
    const bf16x8 b1 = *(const LAS bf16x8*)(Ks + KSWZ(32 + r32, cb));
    p0 = __builtin_amdgcn_mfma_f32_32x32x16_bf16(b0, qr[d0], p0, 0, 0, 0);
    p1 = __builtin_amdgcn_mfma_f32_32x32x16_bf16(b1, qr[d0], p1, 0, 0, 0); }
}
__device__ __forceinline__ int v_st(int k, int c) { const int kk = (k & ~0xC) | ((k & 4) << 1) | ((k & 8) >> 1); return ((kk >> 3) * 4 + (c >> 5)) * 512 + ((kk & 7) * 32 + (c & 31)) * 2; }
__device__ __forceinline__ int v_rd_base(int lane) { return ((lane & 3) << 3) | (((lane >> 2) & 3) << 6) | (((lane >> 4) & 1) << 5) | (((lane >> 5) & 1) << 8); }
constexpr int v_rd_off(int d0, int ks, int half) { return d0 * 512 + ks * 4096 + half * 2048; }
template <int OFF> __device__ __forceinline__ s16x4 tr_read(int vb) {
  s16x4 r; asm volatile("ds_read_b64_tr_b16 %0, %1 offset:%2" : "=&v"(r) : "v"(vb), "i"(OFF) : "memory"); return r;
}
template <int D0> __device__ __forceinline__ void pv_one(f32x16& od, int vb, bf16x8 pa0, bf16x8 pa1, bf16x8 pa2, bf16x8 pa3) {
  const s16x4 l0 = tr_read<v_rd_off(D0, 0, 0)>(vb), h0 = tr_read<v_rd_off(D0, 0, 1)>(vb), l1 = tr_read<v_rd_off(D0, 1, 0)>(vb), h1 = tr_read<v_rd_off(D0, 1, 1)>(vb);
  const s16x4 l2 = tr_read<v_rd_off(D0, 2, 0)>(vb), h2 = tr_read<v_rd_off(D0, 2, 1)>(vb), l3 = tr_read<v_rd_off(D0, 3, 0)>(vb), h3 = tr_read<v_rd_off(D0, 3, 1)>(vb);
  asm volatile("s_waitcnt lgkmcnt(0)" ::: "memory"); SBAR();
#define PK(L, H) (bf16x8){L[0], L[1], L[2], L[3], H[0], H[1], H[2], H[3]}
  od = __builtin_amdgcn_mfma_f32_32x32x16_bf16(pa0, PK(l0, h0), od, 0, 0, 0);
  od = __builtin_amdgcn_mfma_f32_32x32x16_bf16(pa1, PK(l1, h1), od, 0, 0, 0);
  od = __builtin_amdgcn_mfma_f32_32x32x16_bf16(pa2, PK(l2, h2), od, 0, 0, 0);
  od = __builtin_amdgcn_mfma_f32_32x32x16_bf16(pa3, PK(l3, h3), od, 0, 0, 0);
#undef PK
}
__device__ __forceinline__ void pv_d0(f32x16* o, int vb, bf16x8 pa0, bf16x8 pa1, bf16x8 pa2, bf16x8 pa3) {
  pv_one<0>(o[0], vb, pa0, pa1, pa2, pa3); pv_one<1>(o[1], vb, pa0, pa1, pa2, pa3); pv_one<2>(o[2], vb, pa0, pa1, pa2, pa3); pv_one<3>(o[3], vb, pa0, pa1, pa2, pa3);
}

__device__ __forceinline__ void attn_pass(int tid, const bf16_t* __restrict__ Qb, const bf16_t* __restrict__ Kh, const bf16_t* __restrict__ Vh, int seq, LAS char* lds, f32x16 (&o)[4], float (&rli)[16]) {
  const int wid = tid >> 6, lane = tid & 63, r32 = lane & 31, hi = lane >> 5;
  LAS char* V_lds = lds; LAS char* K_lds = lds + 2 * SHM_V;
  LAS float* ws = (LAS float*)(lds + 2 * SHM_V + 2 * SHM_K) + wid * 64; LAS float* li_l = ws; LAS float* al_l = ws + 32;
  float m_reg = -1e30f, l_reg = 0;
#pragma unroll
  for (int d = 0; d < 4; ++d) o[d] = f32x16{};
  bf16x8 qr[4];
  const bf16_t* Qw = Qb + (long)(wid * QBLK + r32) * DQK + hi * 8;
#pragma unroll
  for (int d0 = 0; d0 < 4; ++d0) qr[d0] = *(const bf16x8*)(Qw + d0 * 16);
  const int sr = tid >> 4, sc = (tid & 15) * 8, vst0 = v_st(sr, sc), vst1 = v_st(32 + sr, sc);
  const int kr = tid >> 3, kc = (tid & 7) * 8, kst = KSWZ(kr, kc * 2);
  const int vb0 = (int)(uintptr_t)V_lds + v_rd_base(lane);
  struct { bf16x8 vs0, vs1, ks0; } sr_[2];
#define SLOAD(i, k0) do { sr_[i].vs0 = *(const bf16x8*)(&Vh[(long)((k0) + sr) * DV + sc]); sr_[i].vs1 = *(const bf16x8*)(&Vh[(long)((k0) + 32 + sr) * DV + sc]); \
    sr_[i].ks0 = *(const bf16x8*)(&Kh[(long)((k0) + kr) * DQK + kc]); } while (0)
#define SWRITE(b, i) do { *(LAS bf16x8*)(V_lds + (b) * SHM_V + vst0) = sr_[i].vs0; *(LAS bf16x8*)(V_lds + (b) * SHM_V + vst1) = sr_[i].vs1; \
    *(LAS bf16x8*)(K_lds + (b) * SHM_K + kst) = sr_[i].ks0; } while (0)
#define SWAIT() asm volatile("s_waitcnt vmcnt(3)" ::: "memory")
#define RESC(a) do { if (__any((a) < 1.f)) { if (hi == 0) al_l[r32] = (a); asm volatile("s_waitcnt lgkmcnt(0)" ::: "memory"); \
    _Pragma("unroll") for (int d = 0; d < 4; ++d) _Pragma("unroll") for (int r = 0; r < 16; ++r) o[d][r] *= al_l[crow(r, hi)]; } } while (0)
  f32x16 pA0, pA1, pB0, pB1; float mnA, mnB, alA, alB; bf16x8 pa0, pa1, pa2, pa3; const int NT = seq / KVBLK;
  constexpr int SE = 0, SO = 1;
  SLOAD(SE, 0); asm volatile("s_waitcnt vmcnt(0)" ::: "memory"); SWRITE(0, SE); __syncthreads();
  qkt(pA0, pA1, K_lds, qr, r32, hi); partialSM(pA0, pA1, m_reg, mnA, alA);
  SLOAD(SO, KVBLK); if (2 < NT) SLOAD(SE, 2 * KVBLK);
  SWAIT(); SWRITE(1, SO); __syncthreads();
  for (int j = 1; j + 1 < NT; j += 2) {
    SBAR(); qkt(pB0, pB1, K_lds + SHM_K, qr, r32, hi);
    finishSM(pA0, pA1, alA, l_reg, pa0, pa1, pa2, pa3); SBAR();
    SLOAD(SO, (j + 2) * KVBLK); SBAR();
    pv_d0(o, vb0, pa0, pa1, pa2, pa3); partialSM(pB0, pB1, m_reg, mnB, alB);
    __syncthreads(); SWAIT(); SWRITE(0, SE);
    RESC(alB); __syncthreads();
    SBAR(); qkt(pA0, pA1, K_lds, qr, r32, hi);
    finishSM(pB0, pB1, alB, l_reg, pa0, pa1, pa2, pa3); SBAR();
    if (j + 3 < NT) SLOAD(SE, (j + 3) * KVBLK); SBAR();
    pv_d0(o, vb0 + SHM_V, pa0, pa1, pa2, pa3); partialSM(pA0, pA1, m_reg, mnA, alA);
    __syncthreads(); SWAIT(); SWRITE(1, SO);
    RESC(alA); __syncthreads();
  }
  SBAR(); qkt(pB0, pB1, K_lds + SHM_K, qr, r32, hi);
  finishSM(pA0, pA1, alA, l_reg, pa0, pa1, pa2, pa3); SBAR();
  pv_d0(o, vb0, pa0, pa1, pa2, pa3); partialSM(pB0, pB1, m_reg, mnB, alB);
  __syncthreads(); RESC(alB);
  finishSM(pB0, pB1, alB, l_reg, pa0, pa1, pa2, pa3); SBAR();
  pv_d0(o, vb0 + SHM_V, pa0, pa1, pa2, pa3);
  if (hi == 0) li_l[r32] = l_reg; asm volatile("s_waitcnt lgkmcnt(0)" ::: "memory");
#pragma unroll
  for (int r = 0; r < 16; ++r) rli[r] = __builtin_amdgcn_rcpf(li_l[crow(r, hi)]);
  __syncthreads();
#undef SLOAD
#undef SWRITE
#undef SWAIT
#undef RESC
}

#undef KSWZ
#undef SBAR
}
}
namespace mk {
namespace atf {
constexpr int NW = 8, KSLOT = 8192, VSLOT = 16384, NKS = 4, NVS = 3;
constexpr int LDS_K = 0, LDS_V = NKS * KSLOT, LDS_WS = LDS_V + NVS * VSLOT, LDS_FLAG = LDS_WS + NW * 64 * 4, LDS_BYTES_ATT = LDS_FLAG + 64;
#define SBAR() __builtin_amdgcn_sched_barrier(0)
#define WAIT_BAR(N) asm volatile("s_waitcnt vmcnt(" #N ") lgkmcnt(0)\n\ts_barrier" ::: "memory")
__device__ __forceinline__ int crow(int r, int hi) { return (r & 3) + 8 * (r >> 2) + 4 * hi; }
__device__ __forceinline__ void glds16(const void* gsrc, unsigned lds_dst) { unsigned keep;
  asm volatile("s_mov_b32 %0, m0\n\ts_mov_b32 m0, %2\n\ts_nop 0\n\tglobal_load_lds_dwordx4 %1, off\n\ts_mov_b32 m0, %0" : "=&s"(keep) : "v"(gsrc), "s"(lds_dst) : "memory"); }
typedef float f32x2_t __attribute__((ext_vector_type(2))); typedef __bf16 bf16x2_t __attribute__((ext_vector_type(2)));
__device__ __forceinline__ unsigned cvtpk_s(float lo, float hi) { f32x2_t v = {lo, hi}; bf16x2_t b = __builtin_convertvector(v, bf16x2_t); return __builtin_bit_cast(unsigned, b); }
typedef LAS const char* lds_cptr;
typedef short v4i16_t __attribute__((ext_vector_type(4)));
__device__ __forceinline__ s16x4 vtr(lds_cptr p) { return __builtin_bit_cast(s16x4, __builtin_amdgcn_ds_read_tr16_b64_v4i16((LAS v4i16_t*)p)); }
__device__ __forceinline__ bf16x8 kld(lds_cptr p) { return *(const LAS bf16x8*)p; }

__device__ __forceinline__ bool attn_pass_fast(int tid, const bf16_t* __restrict__ Qb, const bf16_t* __restrict__ Kh, const bf16_t* __restrict__ Vh, int seq, LAS char* lds, f32x16 (&o)[4], float (&rli)[16]) {
  const int lane = tid & 63, r32 = lane & 31, hi = lane >> 5; const int wid = __builtin_amdgcn_readfirstlane(tid >> 6);
  const unsigned lds0 = (unsigned)(uintptr_t)lds;
  LAS float* wsf = (LAS float*)(lds + LDS_WS) + wid * 64;
  const bf16_t* ksrc = Kh + (long)lane * 64 + wid * 8;
  const bf16_t* vsrc = Vh + (long)(16 * (wid & 3) + (lane >> 2)) * 128 + (wid >> 2) * 32 + (lane & 3) * 8;
  const unsigned kdst = lds0 + LDS_K + wid * 1024, vdst = lds0 + LDS_V + wid * 1024;
#define DMA_K(t) glds16(ksrc + (long)(t) * 4096, (unsigned)__builtin_amdgcn_readfirstlane(kdst + ((t) & 3) * KSLOT))
#define DMA_V0(t, slot) glds16(vsrc + (long)(t) * 8192, (unsigned)__builtin_amdgcn_readfirstlane(vdst + (slot)))
#define DMA_V1(t, slot) glds16(vsrc + (long)(t) * 8192 + 64, (unsigned)__builtin_amdgcn_readfirstlane(vdst + (slot) + 8192))
#define DMA_V(t, slot) do { glds16(vsrc + (long)(t) * 8192, (unsigned)__builtin_amdgcn_readfirstlane(vdst + (slot))); glds16(vsrc + (long)(t) * 8192 + 64, (unsigned)__builtin_amdgcn_readfirstlane(vdst + (slot) + 8192)); } while (0)
  const lds_cptr shm3 = (lds_cptr)lds; const lds_cptr kp0 = shm3 + LDS_K + hi * 1024 + r32 * 16;
  const lds_cptr vp0 = shm3 + LDS_V + ((lane >> 4) & 1) * 32 + (lane & 3) * 8 + (4 * hi + ((lane & 15) >> 2)) * 64;
  const int NT = seq / 64;
  DMA_K(0); DMA_V(0, 0); DMA_K(1); DMA_K(2);
  bf16x8 qr[4];
  { const bf16_t* Qw = Qb + (long)(wid * 32 + r32) * 64 + hi * 8;
#pragma unroll
    for (int d0 = 0; d0 < 4; ++d0) qr[d0] = *(const bf16x8*)(Qw + d0 * 16); }
#pragma unroll
  for (int d = 0; d < 4; ++d) o[d] = f32x16{};
  float l_reg = 0.f; f32x16 negm = f32x16{};
  asm volatile("s_waitcnt vmcnt(0)" ::: "memory");
  WAIT_BAR(0);
  f32x16 pA0, pA1, pB0, pB1;
  bf16x8 kfA[4], kfB[4];
  { f32x16 c0 = f32x16{}, c1 = f32x16{};
#pragma unroll
    for (int d0 = 0; d0 < 4; ++d0) { c0 = __builtin_amdgcn_mfma_f32_32x32x16_bf16(kld(kp0 + d0 * 2048), qr[d0], c0, 0, 0, 0); c1 = __builtin_amdgcn_mfma_f32_32x32x16_bf16(kld(kp0 + d0 * 2048 + 512), qr[d0], c1, 0, 0, 0); }
    float m = c0[0];
#pragma unroll
    for (int r = 1; r < 16; ++r) m = fmaxf(m, c0[r]);
#pragma unroll
    for (int r = 0; r < 16; ++r) m = fmaxf(m, c1[r]);
    { auto rr = __builtin_amdgcn_permlane32_swap(__float_as_uint(m), __float_as_uint(m), false, false); m = fmaxf(__uint_as_float(rr[0]), __uint_as_float(rr[1])); }
#pragma unroll
    for (int r = 0; r < 16; ++r) negm[r] = -m;
    asm volatile("" : "+v"(negm)); }
#pragma unroll
  for (int d0 = 0; d0 < 4; ++d0) { pA0 = __builtin_amdgcn_mfma_f32_32x32x16_bf16(kld(kp0 + d0 * 2048), qr[d0], d0 == 0 ? negm : pA0, 0, 0, 0); pA1 = __builtin_amdgcn_mfma_f32_32x32x16_bf16(kld(kp0 + d0 * 2048 + 512), qr[d0], d0 == 0 ? negm : pA1, 0, 0, 0); }
#pragma unroll
  for (int r = 0; r < 16; ++r) { pA0[r] = __builtin_amdgcn_exp2f(pA0[r]); pA1[r] = __builtin_amdgcn_exp2f(pA1[r]); }
  if (3 < NT) DMA_K(3);
  if (1 < NT) DMA_V(1, VSLOT);
#pragma unroll
  for (int d0 = 0; d0 < 4; ++d0) kfA[d0] = kld(kp0 + KSLOT + d0 * 2048);
  WAIT_BAR(0);
  u32x4 pw0, pw1, pw2, pw3; s16x4 vl[4], vh[4];
#define PKW(P, B) cvtpk_s(P[B], P[B + 1])
#define PAF(k) __builtin_bit_cast(bf16x8, pw##k)
#define VFR(i) (bf16x8){vl[i][0], vl[i][1], vl[i][2], vl[i][3], vh[i][0], vh[i][1], vh[i][2], vh[i][3]}
#define PIN(x) asm volatile("" : "+v"(x))
#define GAPA(MF, A0, A1, A2, A3, W0, W1, PW) do { MF; sacc += A0; sacc += A1; sacc += A2; sacc += A3; PIN(sacc); W0; W1; PIN(PW); SBAR(); } while (0)
#define EX(v) __builtin_amdgcn_exp2f(v)
#define GAPB(MF, X, B) do { MF; X[B] = EX(X[B]); X[B + 1] = EX(X[B + 1]); PIN(X); SBAR(); } while (0)
#define VRD(i, f) do { vl[i] = vtr(vp_ + (f) * 1024); vh[i] = vtr(vp_ + (f) * 1024 + 512); } while (0)
#define STEP(C0, C1, P0, P1, t, svp, svn, GK, GV, GL) do { SBAR(); \
    const lds_cptr kq_ = kp0 + ((t) & 3) * KSLOT; const lds_cptr kn_ = kp0 + (((t) + 1) & 3) * KSLOT; const lds_cptr vp_ = vp0 + (svp); \
    kfB[0] = kld(kq_ + 512); kfB[1] = kld(kq_ + 2048 + 512); kfB[2] = kld(kq_ + 4096 + 512); kfB[3] = kld(kq_ + 6144 + 512); \
    VRD(0, 0); VRD(1, 1); SBAR(); float sacc = (P0[0] + P0[1]); \
    GAPA(C0 = __builtin_amdgcn_mfma_f32_32x32x16_bf16(kfA[0], qr[0], negm, 0, 0, 0), P0[2], P0[3], P0[4], P0[5],     pw0[0] = PKW(P0, 0), pw0[1] = PKW(P0, 2), pw0); \
    GAPA(C0 = __builtin_amdgcn_mfma_f32_32x32x16_bf16(kfA[1], qr[1], C0, 0, 0, 0),   P0[6], P0[7], P0[8], P0[9],     pw0[2] = PKW(P0, 4), pw0[3] = PKW(P0, 6), pw0); \
    VRD(2, 2); VRD(3, 3); SBAR(); \
    GAPA(C0 = __builtin_amdgcn_mfma_f32_32x32x16_bf16(kfA[2], qr[2], C0, 0, 0, 0),   P0[10], P0[11], P0[12], P0[13], pw1[0] = PKW(P0, 8), pw1[1] = PKW(P0, 10), pw1); \
    GAPA(C0 = __builtin_amdgcn_mfma_f32_32x32x16_bf16(kfA[3], qr[3], C0, 0, 0, 0),   P0[14], P0[15], P1[0], P1[1],   pw1[2] = PKW(P0, 12), pw1[3] = PKW(P0, 14), pw1); \
    GAPA(C1 = __builtin_amdgcn_mfma_f32_32x32x16_bf16(kfB[0], qr[0], negm, 0, 0, 0), P1[2], P1[3], P1[4], P1[5],     pw2[0] = PKW(P1, 0), pw2[1] = PKW(P1, 2), pw2); \
    GAPA(C1 = __builtin_amdgcn_mfma_f32_32x32x16_bf16(kfB[1], qr[1], C1, 0, 0, 0),   P1[6], P1[7], P1[8], P1[9],     pw2[2] = PKW(P1, 4), pw2[3] = PKW(P1, 6), pw2); \
    GAPA(C1 = __builtin_amdgcn_mfma_f32_32x32x16_bf16(kfB[2], qr[2], C1, 0, 0, 0),   P1[10], P1[11], P1[12], P1[13], pw3[0] = PKW(P1, 8), pw3[1] = PKW(P1, 10), pw3); \
    GAPA(C1 = __builtin_amdgcn_mfma_f32_32x32x16_bf16(kfB[3], qr[3], C1, 0, 0, 0),   P1[14], P1[15], 0.f, 0.f,       pw3[2] = PKW(P1, 12), pw3[3] = PKW(P1, 14), pw3); \
    l_reg += sacc; \
    if (GK) { DMA_K((t) + 3); } if (GV) { DMA_V((t) + 1, (svn)); } \
    SBAR(); \
    GAPB(o[0] = __builtin_amdgcn_mfma_f32_32x32x16_bf16(PAF(0), VFR(0), o[0], 0, 0, 0), C0, 0);  VRD(0, 4); SBAR(); \
    GAPB(o[0] = __builtin_amdgcn_mfma_f32_32x32x16_bf16(PAF(1), VFR(1), o[0], 0, 0, 0), C0, 2);  VRD(1, 5); SBAR(); \
    GAPB(o[0] = __builtin_amdgcn_mfma_f32_32x32x16_bf16(PAF(2), VFR(2), o[0], 0, 0, 0), C0, 4);  VRD(2, 6); SBAR(); \
    GAPB(o[0] = __builtin_amdgcn_mfma_f32_32x32x16_bf16(PAF(3), VFR(3), o[0], 0, 0, 0), C0, 6);  VRD(3, 7); SBAR(); \
    GAPB(o[1] = __builtin_amdgcn_mfma_f32_32x32x16_bf16(PAF(0), VFR(0), o[1], 0, 0, 0), C0, 8);  VRD(0, 8); SBAR(); \
    GAPB(o[1] = __builtin_amdgcn_mfma_f32_32x32x16_bf16(PAF(1), VFR(1), o[1], 0, 0, 0), C0, 10); VRD(1, 9); SBAR(); \
    GAPB(o[1] = __builtin_amdgcn_mfma_f32_32x32x16_bf16(PAF(2), VFR(2), o[1], 0, 0, 0), C0, 12); VRD(2, 10); SBAR(); \
    GAPB(o[1] = __builtin_amdgcn_mfma_f32_32x32x16_bf16(PAF(3), VFR(3), o[1], 0, 0, 0), C0, 14); VRD(3, 11); SBAR(); \
    GAPB(o[2] = __builtin_amdgcn_mfma_f32_32x32x16_bf16(PAF(0), VFR(0), o[2], 0, 0, 0), C1, 0);  VRD(0, 12); SBAR(); \
    GAPB(o[2] = __builtin_amdgcn_mfma_f32_32x32x16_bf16(PAF(1), VFR(1), o[2], 0, 0, 0), C1, 2);  VRD(1, 13); SBAR(); \
    GAPB(o[2] = __builtin_amdgcn_mfma_f32_32x32x16_bf16(PAF(2), VFR(2), o[2], 0, 0, 0), C1, 4);  VRD(2, 14); SBAR(); \
    GAPB(o[2] = __builtin_amdgcn_mfma_f32_32x32x16_bf16(PAF(3), VFR(3), o[2], 0, 0, 0), C1, 6);  VRD(3, 15); SBAR(); \
    if (GL) { kfA[0] = kld(kn_); kfA[1] = kld(kn_ + 2048); SBAR(); } \
    GAPB(o[3] = __builtin_amdgcn_mfma_f32_32x32x16_bf16(PAF(0), VFR(0), o[3], 0, 0, 0), C1, 8); \
    GAPB(o[3] = __builtin_amdgcn_mfma_f32_32x32x16_bf16(PAF(1), VFR(1), o[3], 0, 0, 0), C1, 10); \
    if (GL) { kfA[2] = kld(kn_ + 4096); kfA[3] = kld(kn_ + 6144); SBAR(); } \
    GAPB(o[3] = __builtin_amdgcn_mfma_f32_32x32x16_bf16(PAF(2), VFR(2), o[3], 0, 0, 0), C1, 12); \
    GAPB(o[3] = __builtin_amdgcn_mfma_f32_32x32x16_bf16(PAF(3), VFR(3), o[3], 0, 0, 0), C1, 14); \
  } while (0)
  const bool whalf = wid >= 4;
  int svp = 0, svc = VSLOT, svn = 2 * VSLOT;
#define ROT() do { const int tmp_ = svp; svp = svc; svc = svn; svn = tmp_; } while (0)
  int t = 1;
  for (; t + 5 < NT; t += 2) {
    STEP(pB0, pB1, pA0, pA1, t, svp, svn, true, true, true);     WAIT_BAR(3); ROT();
    STEP(pA0, pA1, pB0, pB1, t + 1, svp, svn, true, true, true); WAIT_BAR(3); ROT();
  }
  for (; t + 1 < NT; t += 2) {
    STEP(pB0, pB1, pA0, pA1, t, svp, svn, (t + 3 < NT), (t + 1 < NT), (t + 1 < NT));       WAIT_BAR(0); ROT();
    STEP(pA0, pA1, pB0, pB1, t + 1, svp, svn, (t + 4 < NT), (t + 2 < NT), (t + 2 < NT));   WAIT_BAR(0); ROT();
  }
  STEP(pB0, pB1, pA0, pA1, NT - 1, svp, svn, false, false, false); ROT();
  { float sacc = pB0[0] + pB0[1];
#pragma unroll
    for (int r = 2; r < 16; ++r) sacc += pB0[r];
#pragma unroll
    for (int r = 0; r < 16; ++r) sacc += pB1[r];
    l_reg += sacc;
    pw0 = (u32x4){PKW(pB0, 0), PKW(pB0, 2), PKW(pB0, 4), PKW(pB0, 6)}; pw1 = (u32x4){PKW(pB0, 8), PKW(pB0, 10), PKW(pB0, 12), PKW(pB0, 14)};
    pw2 = (u32x4){PKW(pB1, 0), PKW(pB1, 2), PKW(pB1, 4), PKW(pB1, 6)}; pw3 = (u32x4){PKW(pB1, 8), PKW(pB1, 10), PKW(pB1, 12), PKW(pB1, 14)};
    WAIT_BAR(0);
    const lds_cptr vp_ = vp0 + svp;
#pragma unroll
    for (int d0 = 0; d0 < 4; ++d0) { VRD(0, 4 * d0); VRD(1, 4 * d0 + 1); VRD(2, 4 * d0 + 2); VRD(3, 4 * d0 + 3);
      o[d0] = __builtin_amdgcn_mfma_f32_32x32x16_bf16(PAF(0), VFR(0), o[d0], 0, 0, 0); o[d0] = __builtin_amdgcn_mfma_f32_32x32x16_bf16(PAF(1), VFR(1), o[d0], 0, 0, 0);
      o[d0] = __builtin_amdgcn_mfma_f32_32x32x16_bf16(PAF(2), VFR(2), o[d0], 0, 0, 0); o[d0] = __builtin_amdgcn_mfma_f32_32x32x16_bf16(PAF(3), VFR(3), o[d0], 0, 0, 0); } }
  { auto rr = __builtin_amdgcn_permlane32_swap(__float_as_uint(l_reg), __float_as_uint(l_reg), false, false); l_reg = __uint_as_float(rr[0]) + __uint_as_float(rr[1]); }
  const bool bad = __any(!(l_reg > 1e-30f && l_reg < 1e30f));
  LAS int* flag = (LAS int*)(lds + LDS_FLAG);
  if (hi == 0) wsf[32 + r32] = l_reg;
  if (lane == 0) flag[wid] = bad ? 1 : 0;
  WAIT_BAR(0);
#pragma unroll
  for (int r = 0; r < 16; ++r) rli[r] = __builtin_amdgcn_rcpf(wsf[32 + crow(r, hi)]);
  int anybad = 0;
#pragma unroll
  for (int w = 0; w < 8; ++w) anybad |= flag[w];
  WAIT_BAR(0);
  return anybad == 0;
#undef DMA_K
#undef DMA_V
#undef DMA_V0
#undef DMA_V1
#undef PKW
#undef PAF
#undef VFR
#undef PIN
#undef GAPA
#undef EX
#undef GAPB
#undef VRD
#undef STEP
#undef ROT
}
#undef SBAR
#undef WAIT_BAR
}
}

namespace mk {
namespace att2 {
__device__ __forceinline__ void attn_unit(int h, int qb, const unsigned char* ws, const float* __restrict__ subg, float* stash, LAS char* lds) {
  const bf16_t* Q = (const bf16_t*)(ws + WS_Q); const bf16_t* K = (const bf16_t*)(ws + WS_K); const bf16_t* V = (const bf16_t*)(ws + WS_V);
  f32x16 o[4]; float rli[16];
  { int tid = threadIdx.x; asm volatile("" : "+v"(tid));
    if (!atf::attn_pass_fast(tid, Q + ((size_t)(2 * h) * T + (size_t)qb * 256) * 64, K + (size_t)(2 * h) * T * 64, V + (size_t)h * T * 128, T, lds, o, rli))
      att::attn_pass(tid, Q + ((size_t)(2 * h) * T + (size_t)qb * 256) * 64, K + (size_t)(2 * h) * T * 64, V + (size_t)h * T * 128, T, lds, o, rli); }
  { int tid = threadIdx.x; asm volatile("" : "+v"(tid));
    float* st = stash + (size_t)(tid >> 6) * 4096 + (tid & 63);
    asm volatile("" : "+v"(st) :: "memory");
#pragma unroll
    for (int d = 0; d < 4; ++d)
#pragma unroll
      for (int r = 0; r < 16; ++r) st[(d * 16 + r) * 64] = o[d][r] * rli[r];
    asm volatile("s_waitcnt vmcnt(0)" ::: "memory"); __builtin_amdgcn_sched_barrier(0); }
  { int tid = threadIdx.x; asm volatile("" : "+v"(tid));
    if (!atf::attn_pass_fast(tid, Q + ((size_t)(2 * h + 1) * T + (size_t)qb * 256) * 64, K + (size_t)(2 * h + 1) * T * 64, V + (size_t)h * T * 128, T, lds, o, rli))
      att::attn_pass(tid, Q + ((size_t)(2 * h + 1) * T + (size_t)qb * 256) * 64, K + (size_t)(2 * h + 1) * T * 64, V + (size_t)h * T * 128, T, lds, o, rli); }
  int tid = threadIdx.x; asm volatile("" : "+v"(tid));
  const int wid = tid >> 6, lane = tid & 63, r32 = lane & 31, hi = lane >> 5;
  const float lam = *(const float*)(ws + WS_SMALL);
  float* st = stash + (size_t)wid * 4096 + lane;
  asm volatile("" : "+v"(st) :: "memory");
  float ss[16];
#pragma unroll
  for (int r = 0; r < 16; ++r) ss[r] = 0.f;
#pragma unroll
  for (int d = 0; d < 4; ++d)
#pragma unroll
    for (int r = 0; r < 16; ++r) { const float a = st[(d * 16 + r) * 64] - lam * (o[d][r] * rli[r]); o[d][r] = a; ss[r] += a * a; }
#pragma unroll
  for (int r = 0; r < 16; ++r) { float s = ss[r]; s += __shfl_xor(s, 1); s += __shfl_xor(s, 2); s += __shfl_xor(s, 4); s += __shfl_xor(s, 8); s += __shfl_xor(s, 16);
    ss[r] = 0.8f / sqrtf(s * (1.f / 128.f) + 1e-5f); }
  bf16_t* mix = (bf16_t*)(ws + WS_XN);
#pragma unroll
  for (int d = 0; d < 4; ++d) { const float g = subg[d * 32 + r32];
#pragma unroll
    for (int r = 0; r < 16; ++r) { const int t = qb * 256 + wid * 32 + att::crow(r, hi);
      mix[(size_t)t * DM + h * 128 + d * 32 + r32] = (bf16_t)(cvt_pk_bf16(o[d][r] * ss[r] * g, 0.f) & 0xffffu); } }
}
}
}
namespace mk {
namespace hg {
constexpr int C = 64, LSC = 512, NCH = LSC / C, NSC = T / LSC;
constexpr int L_QT = 0, L_KT = 16384, L_KH = 32768, L_VT = 49152, L_GB = 65536  , L_AT = 98304  ,
              L_SEG = 106496  , L_DL = 108544  , L_END = 109056;
__device__ __forceinline__ int crow(int r, int hi) { return (r & 3) + 8 * (r >> 2) + 4 * hi; }
__device__ __forceinline__ unsigned off_b(unsigned row, unsigned ch) { return 256u * row + 16u * (ch ^ (((row & 3) << 2) | ((row >> 2) & 3))); }
__device__ __forceinline__ unsigned row_read_addr(unsigned lane, unsigned s) { return off_b(lane & 31, 2 * s + (lane >> 5)); }
__device__ __forceinline__ unsigned tr_read_addr(unsigned lane, unsigned c, unsigned ks, unsigned t) {
  const unsigned h = lane >> 5, blk = (lane >> 4) & 1, q = (lane & 15) >> 2, p = lane & 3;
  return off_b(16 * ks + 8 * h + 4 * t + q, 4 * c + 2 * blk + (p >> 1)) + 8 * (p & 1);
}
__device__ __forceinline__ s16x4 trd(const LAS unsigned char* p) { typedef short v4i16_t __attribute__((ext_vector_type(4))); return __builtin_bit_cast(s16x4, __builtin_amdgcn_ds_read_tr16_b64_v4i16((LAS v4i16_t*)p)); }
__device__ __forceinline__ bf16x8 tr_frag(const LAS unsigned char* img, unsigned lane, unsigned c, unsigned kk) {
  const LAS unsigned char* base = img + 8192u * (kk >> 1);
  const s16x4 lo = trd(base + tr_read_addr(lane, c, kk & 1, 0)), hi = trd(base + tr_read_addr(lane, c, kk & 1, 1));
  return (bf16x8){lo[0], lo[1], lo[2], lo[3], hi[0], hi[1], hi[2], hi[3]};
}
__device__ __forceinline__ bf16x8 row_frag(const LAS unsigned char* img, unsigned lane, unsigned rt, unsigned s) {
  return *(const LAS bf16x8*)(img + 8192u * rt + row_read_addr(lane, s));
}
__device__ __forceinline__ unsigned at_off(unsigned row, unsigned chunk) { return row * 128u + ((chunk ^ ((row >> 1) & 7u)) << 4); }

template <bool OUT>
__device__ __forceinline__ void hgrn_item(int tid, int h, int dir, int p, const unsigned char* ws, float* Sbuf, float* Dbuf, LAS unsigned char* lds) {
  const int wid = __builtin_amdgcn_readfirstlane(tid >> 6), lane = tid & 63, r32 = lane & 31, hi = lane >> 5;
  const bf16_t* HQ = (const bf16_t*)(ws + WS_HQ); const bf16_t* Z = (const bf16_t*)(ws + (dir ? WS_ZB : WS_ZF)); const bf16_t* HI = (const bf16_t*)(ws + WS_HI);
  const float* lbp = (const float*)(ws + WS_SMALL) + 64 + dir * 512 + h * 128;
  bf16_t* Od = (bf16_t*)(ws + WS_Q) + ((size_t)(dir * 4 + h) * T) * 128;
  const int sc = dir ? (NSC - 1 - p) : p, tok0 = sc * LSC;
  float* Sg = Sbuf + ((size_t)((h * 2 + dir) * NSC + p)) * 16384;
  float* Dg = Dbuf + ((size_t)((h * 2 + dir) * NSC + p)) * 128;
  const int sr = tid >> 4, c8 = (tid & 15) * 8;
  float lb8[8];
#pragma unroll
  for (int i = 0; i < 8; ++i) lb8[i] = lbp[c8 + i];
  const int vj = wid & 3, kt0 = 2 * (wid >> 2);
  f32x16 S0, S1;
  if (OUT) {
#pragma unroll
    for (int r = 0; r < 16; ++r) { S0[r] = Sg[(size_t)(32 * kt0 + crow(r, hi)) * 128 + 32 * vj + r32]; S1[r] = Sg[(size_t)(32 * (kt0 + 1) + crow(r, hi)) * 128 + 32 * vj + r32]; }
  } else { S0 = f32x16{}; S1 = f32x16{}; }
  float bsum[8];
#pragma unroll
  for (int i = 0; i < 8; ++i) bsum[i] = 0.f;
  LAS float* Gb = (LAS float*)(lds + L_GB); LAS float* Seg = (LAS float*)(lds + L_SEG); LAS float* Dl = (LAS float*)(lds + L_DL);
  u32x4 z0, z1, v0, v1, q0 = {0, 0, 0, 0}, q1 = {0, 0, 0, 0};
#define HG_LOAD(step_) do { const int ci_ = dir ? (NCH - 1 - (step_)) : (step_), ctok_ = tok0 + ci_ * C; \
    const int t0_ = ctok_ + (dir ? (63 - sr) : sr), t1_ = ctok_ + (dir ? (31 - sr) : (sr + 32)); \
    const size_t g0_ = (size_t)t0_ * 512 + h * 128 + c8, g1_ = (size_t)t1_ * 512 + h * 128 + c8; \
    z0 = *(const u32x4*)(Z + g0_); z1 = *(const u32x4*)(Z + g1_); v0 = *(const u32x4*)(HI + g0_); v1 = *(const u32x4*)(HI + g1_); \
    if (OUT) { q0 = *(const u32x4*)(HQ + g0_); q1 = *(const u32x4*)(HQ + g1_); } } while (0)
  HG_LOAD(0);
  for (int step = 0; step < NCH; ++step) {
    const int ci = dir ? (NCH - 1 - step) : step, ctok = tok0 + ci * C;
    float k0[8], k1[8];
#pragma unroll
    for (int i = 0; i < 4; ++i) {
      { const float za = bflo(z0[i]), zb = bfhi(z0[i]); const float sa = fsigm(za), sb = fsigm(zb); const float fa = lb8[2 * i] + (1.f - lb8[2 * i]) * sa, fb = lb8[2 * i + 1] + (1.f - lb8[2 * i + 1]) * sb;
        k0[2 * i] = 1.f - fa; k0[2 * i + 1] = 1.f - fb; Gb[sr * 128 + c8 + 2 * i] = flog2(fa); Gb[sr * 128 + c8 + 2 * i + 1] = flog2(fb); }
      { const float za = bflo(z1[i]), zb = bfhi(z1[i]); const float sa = fsigm(za), sb = fsigm(zb); const float fa = lb8[2 * i] + (1.f - lb8[2 * i]) * sa, fb = lb8[2 * i + 1] + (1.f - lb8[2 * i + 1]) * sb;
        k1[2 * i] = 1.f - fa; k1[2 * i + 1] = 1.f - fb; Gb[(sr + 32) * 128 + c8 + 2 * i] = flog2(fa); Gb[(sr + 32) * 128 + c8 + 2 * i + 1] = flog2(fb); }
    }
    __syncthreads();
    { const int ch = tid & 127, seg = tid >> 7; float run = 0.f;
#pragma unroll
      for (int r = 0; r < 16; ++r) { run += Gb[(16 * seg + r) * 128 + ch]; Gb[(16 * seg + r) * 128 + ch] = run; }
      Seg[seg * 128 + ch] = run; }
    __syncthreads();
    float bl[8], o0[8], o1[8];
    { const int sg0 = sr >> 4, sg1 = (sr + 32) >> 4;
#pragma unroll
      for (int i = 0; i < 8; ++i) { const float s0 = Seg[c8 + i], s1 = Seg[128 + c8 + i], s2 = Seg[256 + c8 + i], s3 = Seg[384 + c8 + i];
        bl[i] = (s0 + s1) + (s2 + s3); o0[i] = sg0 == 0 ? 0.f : s0; o1[i] = sg1 == 2 ? (s0 + s1) : ((s0 + s1) + s2); } }
    float b0[8], b1[8];
#pragma unroll
    for (int i = 0; i < 8; ++i) { b0[i] = Gb[sr * 128 + c8 + i] + o0[i]; b1[i] = Gb[(sr + 32) * 128 + c8 + i] + o1[i]; }
    if (sr == 0) {
#pragma unroll
      for (int i = 0; i < 8; ++i) { Dl[c8 + i] = fexp2(bl[i]); bsum[i] += bl[i]; } }
    { u32x4 kh0, kh1;
#pragma unroll
      for (int i = 0; i < 4; ++i) { kh0[i] = cvt_pk_bf16(k0[2 * i] * fexp2(bl[2 * i] - b0[2 * i]), k0[2 * i + 1] * fexp2(bl[2 * i + 1] - b0[2 * i + 1]));
        kh1[i] = cvt_pk_bf16(k1[2 * i] * fexp2(bl[2 * i] - b1[2 * i]), k1[2 * i + 1] * fexp2(bl[2 * i + 1] - b1[2 * i + 1])); }
      const unsigned a0 = off_b(sr, tid & 15), a1 = 8192u + off_b(sr, tid & 15);
      *(LAS u32x4*)(lds + L_KH + a0) = kh0; *(LAS u32x4*)(lds + L_KH + a1) = kh1;
      *(LAS u32x4*)(lds + L_VT + a0) = v0; *(LAS u32x4*)(lds + L_VT + a1) = v1;
      if (OUT) { u32x4 qt0, qt1, kt0_, kt1_;
#pragma unroll
        for (int i = 0; i < 4; ++i) { qt0[i] = cvt_pk_bf16(bflo(q0[i]) * fexp2(b0[2 * i]), bfhi(q0[i]) * fexp2(b0[2 * i + 1])); qt1[i] = cvt_pk_bf16(bflo(q1[i]) * fexp2(b1[2 * i]), bfhi(q1[i]) * fexp2(b1[2 * i + 1]));
          kt0_[i] = cvt_pk_bf16(k0[2 * i] * fexp2(-b0[2 * i]), k0[2 * i + 1] * fexp2(-b0[2 * i + 1])); kt1_[i] = cvt_pk_bf16(k1[2 * i] * fexp2(-b1[2 * i]), k1[2 * i + 1] * fexp2(-b1[2 * i + 1])); }
        *(LAS u32x4*)(lds + L_QT + a0) = qt0; *(LAS u32x4*)(lds + L_QT + a1) = qt1; *(LAS u32x4*)(lds + L_KT + a0) = kt0_; *(LAS u32x4*)(lds + L_KT + a1) = kt1_; } }
    __syncthreads();
    if (step + 1 < NCH) HG_LOAD(step + 1);
    if (OUT) {
      { LAS unsigned char* sb = lds + L_GB;
#pragma unroll
        for (int r = 0; r < 16; ++r) { const unsigned kl = crow(r, hi), v = 32 * vj + r32;
          *(LAS bf16_t*)(sb + 8192u * kt0 + off_b(kl, v >> 3) + (v & 7) * 2) = (bf16_t)(cvt_pk_bf16(S0[r], 0.f) & 0xffffu);
          *(LAS bf16_t*)(sb + 8192u * (kt0 + 1) + off_b(kl, v >> 3) + (v & 7) * 2) = (bf16_t)(cvt_pk_bf16(S1[r], 0.f) & 0xffffu); } }
      if (wid < 4 && !(wid == 1)) { const int ti = wid >> 1, si = wid & 1; f32x16 a = f32x16{};
#pragma unroll
        for (int s = 0; s < 8; ++s) a = __builtin_amdgcn_mfma_f32_32x32x16_bf16(row_frag(lds + L_KT, lane, si, s), row_frag(lds + L_QT, lane, ti, s), a, 0, 0, 0);
        const int tcol = 32 * ti + r32;
#pragma unroll
        for (int g = 0; g < 4; ++g) { const int s0 = 32 * si + 8 * g + 4 * hi; float x[4];
#pragma unroll
          for (int e = 0; e < 4; ++e) x[e] = (s0 + e <= tcol) ? a[4 * g + e] : 0.f;
          u32x2 w; w.x = cvt_pk_bf16(x[0], x[1]); w.y = cvt_pk_bf16(x[2], x[3]);
          *(LAS u32x2*)(lds + L_AT + at_off(tcol, 4 * si + g) + 8 * hi) = w; } }
      __syncthreads();
      { const int ti = wid >> 2; f32x16 o = f32x16{};
#pragma unroll
        for (int kk = 0; kk < 8; ++kk) o = __builtin_amdgcn_mfma_f32_32x32x16_bf16(row_frag(lds + L_QT, lane, ti, kk), tr_frag(lds + L_GB, lane, vj, kk), o, 0, 0, 0);
        const int nks = ti == 0 ? 2 : 4;
        for (int kk = 0; kk < nks; ++kk) { const bf16x8 af = *(const LAS bf16x8*)(lds + L_AT + at_off(32 * ti + r32, 2 * kk + hi));
          o = __builtin_amdgcn_mfma_f32_32x32x16_bf16(af, tr_frag(lds + L_VT, lane, vj, kk), o, 0, 0, 0); }
#pragma unroll
        for (int r = 0; r < 16; ++r) { const int rr = 32 * ti + crow(r, hi); const int t = ctok + (dir ? (63 - rr) : rr);
          Od[(size_t)t * 128 + 32 * vj + r32] = (bf16_t)(cvt_pk_bf16(o[r], 0.f) & 0xffffu); } }
    }
    { float d0[16], d1[16];
#pragma unroll
      for (int r = 0; r < 16; ++r) { d0[r] = Dl[32 * kt0 + crow(r, hi)]; d1[r] = Dl[32 * (kt0 + 1) + crow(r, hi)]; }
#pragma unroll
      for (int r = 0; r < 16; ++r) { S0[r] *= d0[r]; S1[r] *= d1[r]; }
#pragma unroll
      for (int kk = 0; kk < 4; ++kk) { const bf16x8 vf = tr_frag(lds + L_VT, lane, vj, kk);
        S0 = __builtin_amdgcn_mfma_f32_32x32x16_bf16(tr_frag(lds + L_KH, lane, kt0, kk), vf, S0, 0, 0, 0);
        S1 = __builtin_amdgcn_mfma_f32_32x32x16_bf16(tr_frag(lds + L_KH, lane, kt0 + 1, kk), vf, S1, 0, 0, 0); } }
    __syncthreads();
  }
#undef HG_LOAD
  if (!OUT) {
#pragma unroll
    for (int r = 0; r < 16; ++r) { Sg[(size_t)(32 * kt0 + crow(r, hi)) * 128 + 32 * vj + r32] = S0[r]; Sg[(size_t)(32 * (kt0 + 1) + crow(r, hi)) * 128 + 32 * vj + r32] = S1[r]; }
    if (sr == 0) {
#pragma unroll
      for (int i = 0; i < 8; ++i) Dg[c8 + i] = fexp2(bsum[i]); }
  }
}

__device__ __forceinline__ void hgrn_scan(int gthread, int nthreads, float* Sbuf, const float* Dbuf) {
  for (int e = gthread; e < 8 * 16384; e += nthreads) { const int hd = e >> 14, kv = e & 16383, k = kv >> 7;
    float* Sp = Sbuf + (size_t)hd * NSC * 16384 + kv; const float* Dp = Dbuf + (size_t)hd * NSC * 128 + k;
    float run = 0.f;
#pragma unroll 8
    for (int p = 0; p < NSC; ++p) { const float s = Sp[(size_t)p * 16384], d = Dp[p * 128]; Sp[(size_t)p * 16384] = run; run = d * run + s; } }
}
__device__ __forceinline__ void hgrn_combine(int gwave, int nwaves, int lane, const unsigned char* ws, const float* __restrict__ gg) {
  const bf16_t* Of = (const bf16_t*)(ws + WS_Q); const bf16_t* Ob = Of + (size_t)4 * T * 128; const bf16_t* HG = (const bf16_t*)(ws + WS_HG); bf16_t* mix = (bf16_t*)(ws + WS_XN);
  const float g0 = gg[2 * lane], g1 = gg[2 * lane + 1];
  for (int w = gwave; w < T * 4; w += nwaves) { const int t = w >> 2, h = w & 3;
    const unsigned f = *(const unsigned*)(Of + ((size_t)h * T + t) * 128 + 2 * lane), b = *(const unsigned*)(Ob + ((size_t)h * T + t) * 128 + 2 * lane);
    const unsigned gt = *(const unsigned*)(HG + (size_t)t * 512 + h * 128 + 2 * lane);
    const float a0 = bflo(f) + bflo(b), a1 = bfhi(f) + bfhi(b);
    const float ss = wave_sum(a0 * a0 + a1 * a1);
    const float r = 1.f / sqrtf(ss * (1.f / 128.f) + 1e-6f);
    *(unsigned*)(mix + (size_t)t * DM + 512 + h * 128 + 2 * lane) = cvt_pk_bf16(a0 * r * g0 * bflo(gt), a1 * r * g1 * bfhi(gt)); }
}
}
}
namespace mk {
struct EpiOutProj {
  const float* x; float* out;
  __device__ __forceinline__ void operator()(const f32x4 (&acc)[2][2][4][2], const Unit& u, int wr, int wc, int fr, int fq) const {
    const int row0 = u.pm * BM + wr * 64 + fr, col0 = u.pn * BM + wc * 32 + 8 * fq;
#pragma unroll
    for (int ai = 0; ai < 2; ++ai)
#pragma unroll
      for (int m = 0; m < 4; ++m) { const size_t ro = (size_t)(row0 + ai * HALF + m * 16) * DM + col0;
#pragma unroll
        for (int bj = 0; bj < 2; ++bj) { const GAS f32x4* xp = (const GAS f32x4*)(x + ro + bj * HALF); GAS f32x4* op = (GAS f32x4*)(out + ro + bj * HALF);
          const f32x4 x0 = xp[0], x1 = xp[1]; op[0] = x0 + acc[ai][bj][m][0]; op[1] = x1 + acc[ai][bj][m][1]; } }
  }
};

namespace rt {
constexpr size_t WS_WR = WS_SMALL + 64 * 1024;
constexpr size_t R_LIST = WS_ROUTE, R_CWL = WS_ROUTE + 2 * MiB, R_TINFO = WS_ROUTE + 4 * MiB;
__device__ __forceinline__ void build_wr(int gthread, int nthreads, const Args& a) {
  float* WR = (float*)(a.ws + WS_WR); const float* g = a.in[8]; const float* wgr = a.in[9]; const float* wer = a.in[11];
  for (int idx = gthread; idx < 1024 * 48; idx += nthreads) { const int k = idx / 48, j = idx % 48; float w = 0.f;
    if (j < 4) w = wgr[k * 4 + j]; else if (j < 36) { const int gi = (j - 4) >> 3, e = (j - 4) & 7; w = wer[((size_t)gi * 1024 + k) * 8 + e]; }
    WR[idx] = w * g[k]; }
}
__device__ __forceinline__ void router_phase(Frame& F, const Args& a, gu32* gcnt) {
  const float* hres = a.out; const float* g = a.in[8]; const float* WR = (const float*)(a.ws + WS_WR);
  const float* bgr = a.in[10]; const float* ber = a.in[12];
  bf16_t* XT = (bf16_t*)(a.ws + WS_XN); int* list = (int*)(a.ws + R_LIST); float* cwl = (float*)(a.ws + R_CWL); int* tinfo = (int*)(a.ws + R_TINFO);
  LAS float* lg = (LAS float*)(F.lds + F.wave * 4096); LAS int* lcnt = (LAS int*)(F.lds + 32768); LAS int* lbase = lcnt + 32;
  const int lane = F.lane, j = lane & 15, q = lane >> 4;
  const int ntile = T / 16, tpb = (ntile + F.G - 1) / F.G;
  if (F.tid < 64) lcnt[F.tid] = 0;
  __syncthreads();
  const int tile = F.vcu * tpb + F.wave; const bool active = (F.wave < tpb) && (tile < ntile);
  int e1 = 0, e2 = 0, lr1 = 0, lr2 = 0; float c1 = 0.f, c2 = 0.f; int tok = 0;
  if (active) {
    const int t0 = tile * 16;
    const float* xr = hres + (size_t)(t0 + j) * DM + 4 * q;
    f32x4 acc0 = {0.f, 0.f, 0.f, 0.f}, acc1 = acc0, acc2 = acc0; float ssq = 0.f;
#pragma unroll 4
    for (int u = 0; u < 64; ++u) { const f32x4 xv = *(const GAS f32x4*)(xr + 16 * u); ssq += (xv.x * xv.x + xv.y * xv.y) + (xv.z * xv.z + xv.w * xv.w);
      const float* wp = WR + (size_t)(16 * u + 4 * q) * 48 + j;
#pragma unroll
      for (int e = 0; e < 4; ++e) { const float av = xv[e];
        acc0 = __builtin_amdgcn_mfma_f32_16x16x4f32(av, wp[e * 48], acc0, 0, 0, 0);
        acc1 = __builtin_amdgcn_mfma_f32_16x16x4f32(av, wp[e * 48 + 16], acc1, 0, 0, 0);
        acc2 = __builtin_amdgcn_mfma_f32_16x16x4f32(av, wp[e * 48 + 32], acc2, 0, 0, 0); } }
    ssq += __shfl_xor(ssq, 16); ssq += __shfl_xor(ssq, 32);
    const float rstd = 1.f / sqrtf(ssq * (1.f / DM) + 1e-6f);
#pragma unroll
    for (int r = 0; r < 4; ++r) { lg[(4 * q + r) * 48 + j] = acc0[r]; lg[(4 * q + r) * 48 + 16 + j] = acc1[r]; lg[(4 * q + r) * 48 + 32 + j] = acc2[r]; }
    LDS_WAIT();
#pragma unroll 4
    for (int u = 0; u < 64; ++u) { const f32x4 xv = *(const GAS f32x4*)(xr + 16 * u); const f32x4 gv = *(const GAS f32x4*)(g + 16 * u + 4 * q);
      u32x2 w; w.x = cvt_pk_bf16(xv.x * rstd * gv.x, xv.y * rstd * gv.y); w.y = cvt_pk_bf16(xv.z * rstd * gv.z, xv.w * rstd * gv.w);
      *(GAS u32x2*)(XT + (size_t)(t0 + j) * DM + 16 * u + 4 * q) = w; }
    if (lane < 16) {
      tok = t0 + lane;
      float gl[4];
#pragma unroll
      for (int i = 0; i < 4; ++i) gl[i] = lg[lane * 48 + i] * rstd + bgr[i];
      int gi = 0; float gm = gl[0];
#pragma unroll
      for (int i = 1; i < 4; ++i) if (gl[i] > gm) { gm = gl[i]; gi = i; }
      float den = 0.f;
#pragma unroll
      for (int i = 0; i < 4; ++i) den += __expf(gl[i] - gm);
      const float pg = 1.f / den;
      float el[8];
#pragma unroll
      for (int i = 0; i < 8; ++i) el[i] = lg[lane * 48 + 4 + 8 * gi + i] * rstd + ber[gi * 8 + i];
      int i1 = 0; float m1 = el[0];
#pragma unroll
      for (int i = 1; i < 8; ++i) if (el[i] > m1) { m1 = el[i]; i1 = i; }
      int i2 = 0; float m2 = -3.0e38f;
#pragma unroll
      for (int i = 0; i < 8; ++i) if (i != i1 && el[i] > m2) { m2 = el[i]; i2 = i; }
      const float ex = __expf(m2 - m1); const float w1 = 1.f / (1.f + ex), w2 = ex / (1.f + ex);
      e1 = gi * 8 + i1; e2 = gi * 8 + i2; c1 = w1 * pg; c2 = w2 * pg;
      lr1 = __hip_atomic_fetch_add(lcnt + e1, 1, __ATOMIC_RELAXED, __HIP_MEMORY_SCOPE_WORKGROUP); lr2 = __hip_atomic_fetch_add(lcnt + e2, 1, __ATOMIC_RELAXED, __HIP_MEMORY_SCOPE_WORKGROUP);
    }
  }
  __syncthreads();
  if (F.tid < 32) { const int n = lcnt[F.tid]; lbase[F.tid] = n ? (int)__hip_atomic_fetch_add(gcnt + F.tid, (unsigned)n, __ATOMIC_RELAXED, __HIP_MEMORY_SCOPE_AGENT) : 0; }
  __syncthreads();
  if (active && lane < 16) { const int p1 = lbase[e1] + lr1, p2 = lbase[e2] + lr2;
    list[(size_t)e1 * T + p1] = tok; list[(size_t)e2 * T + p2] = tok; cwl[(size_t)e1 * T + p1] = c1; cwl[(size_t)e2 * T + p2] = c2;
    typedef int i32x4 __attribute__((ext_vector_type(4))); *(GAS i32x4*)(tinfo + (size_t)tok * 4) = (i32x4){e1, p1, e2, p2}; }
}
}

constexpr int MOE_TAB = RING_BYTES + 512;
__device__ __forceinline__ void moe_tables(Frame& F, gu32* gcnt) {
  LAS int* tab = (LAS int*)(F.lds + MOE_TAB);
  if (F.tid == 0) { int o = 0, cb = 0, cs = 0; for (int e = 0; e < NEXP; ++e) { const int n = (int)__hip_atomic_load(gcnt + e, __ATOMIC_RELAXED, __HIP_MEMORY_SCOPE_AGENT);
      const int te = (n + 255) >> 8, rem = n - 256 * (te - 1), sm = (te > 0 && rem <= 128) ? 1 : 0;
      tab[e] = n; tab[32 + e] = o; tab[66 + e] = cb; tab[100 + e] = cs; o += n; cb += te - sm; cs += sm; } tab[64] = o; tab[98] = cb; tab[132] = cs; }
  __syncthreads();
}
template <bool DOWN>
struct ProbMoE {
  int K; const char* Abase; const char* Wt; const int* list; const LAS int* tab; int G, c;
  static constexpr bool TAILS = true;
  __device__ __forceinline__ bool next(int i, Unit& u) const {
    int L = i * G + c; const int nB = tab[98] * 4, nS = tab[132] * 4; if (L >= nB + nS) return false;
    const bool small = L >= nB; if (small) L -= nB;
    const int tile = L >> 2, base = small ? 100 : 66; u.pn = L & 3;
    int e = 0;
#pragma unroll 1
    for (int s = 16; s >= 1; s >>= 1) if (e + s < NEXP && tab[base + e + s] <= tile) e += s;
    u.e = e; const int nbig = tab[66 + e + 1] - tab[66 + e];
    u.pm = small ? nbig : tile - tab[66 + e]; u.nrows = tab[e] - u.pm * 256; if (u.nrows > 256) u.nrows = 256; u.row0 = tab[32 + e] + u.pm * 256; return true;
  }
  __device__ __forceinline__ unsigned a_row_off(const Unit& u, int r) const {
    const int rr = r < u.nrows ? r : (u.nrows - 1);
    if (DOWN) return (unsigned)(u.row0 + rr) * (unsigned)K * 2u;
    const int tok = list[(size_t)u.e * T + u.pm * 256 + rr]; return (unsigned)tok * (unsigned)K * 2u;
  }
  __device__ __forceinline__ const char* b_rows(const Unit& u) const { return Wt + ((size_t)u.e * 1024 + (size_t)u.pn * 256) * K * 2; }
};
struct EpiGateUp {
  bf16_t* hid; const float* cwl;
  __device__ __forceinline__ void operator()(const f32x4 (&acc)[2][2][4][2], const Unit& u, int wr, int wc, int fr, int fq) const {
    const int f0 = u.pn * 128 + wc * 32 + 8 * fq;
#pragma unroll
    for (int ai = 0; ai < 2; ++ai)
#pragma unroll
      for (int m = 0; m < 4; ++m) { const int r = ai * HALF + wr * 64 + m * 16 + fr;
        if (r < u.nrows) { const float cw = cwl[(size_t)u.e * T + u.pm * 256 + r];
          const f32x4 a0 = acc[ai][0][m][0], a1 = acc[ai][0][m][1], u0 = acc[ai][1][m][0], u1 = acc[ai][1][m][1]; float hv[8];
#pragma unroll
          for (int i = 0; i < 4; ++i) { hv[i] = fsilu(a0[i]) * u0[i] * cw; hv[4 + i] = fsilu(a1[i]) * u1[i] * cw; }
          u32x4 w; w.x = cvt_pk_bf16(hv[0], hv[1]); w.y = cvt_pk_bf16(hv[2], hv[3]); w.z = cvt_pk_bf16(hv[4], hv[5]); w.w = cvt_pk_bf16(hv[6], hv[7]);
          *(GAS u32x4*)(hid + (size_t)(u.row0 + r) * FE + f0) = w; } }
  }
};
struct EpiDown {
  bf16_t* y;
  __device__ __forceinline__ void operator()(const f32x4 (&acc)[2][2][4][2], const Unit& u, int wr, int wc, int fr, int fq) const {
    const int col0 = u.pn * BM + wc * 32 + 8 * fq;
#pragma unroll
    for (int ai = 0; ai < 2; ++ai)
#pragma unroll
      for (int m = 0; m < 4; ++m) { const int r = ai * HALF + wr * 64 + m * 16 + fr;
        if (r < u.nrows) {
#pragma unroll
          for (int bj = 0; bj < 2; ++bj) { const f32x4 v0 = acc[ai][bj][m][0], v1 = acc[ai][bj][m][1];
            u32x4 w; w.x = cvt_pk_bf16(v0[0], v0[1]); w.y = cvt_pk_bf16(v0[2], v0[3]); w.z = cvt_pk_bf16(v1[0], v1[1]); w.w = cvt_pk_bf16(v1[2], v1[3]);
            *(GAS u32x4*)(y + (size_t)(u.row0 + r) * DM + col0 + bj * HALF) = w; } } }
  }
};
__device__ __forceinline__ void final_phase(Frame& F, const Args& a, const bf16_t* y) {
  const LAS int* tab = (const LAS int*)(F.lds + MOE_TAB); const int* tinfo = (const int*)(a.ws + rt::R_TINFO); const float* gf = a.in[16];
  const int gw = F.vcu * NWAVES + F.wave, NGW = F.G * NWAVES, lane = F.lane;
  for (int t = gw; t < T; t += NGW) { typedef int i32x4 __attribute__((ext_vector_type(4))); const i32x4 ti = *(const GAS i32x4*)(tinfo + (size_t)t * 4);
    const int s1 = tab[32 + ti[0]] + ti[1], s2 = tab[32 + ti[2]] + ti[3];
    GAS f32x4* op = (GAS f32x4*)(a.out + (size_t)t * DM) + lane; const GAS u32x2* y1 = (const GAS u32x2*)(y + (size_t)s1 * DM) + lane; const GAS u32x2* y2 = (const GAS u32x2*)(y + (size_t)s2 * DM) + lane;
    f32x4 v[4]; float s = 0.f;
#pragma unroll
    for (int jj = 0; jj < 4; ++jj) { const f32x4 hv = op[64 * jj]; const u32x2 p = y1[64 * jj], q2 = y2[64 * jj];
      v[jj].x = hv.x + bflo(p.x) + bflo(q2.x); v[jj].y = hv.y + bfhi(p.x) + bfhi(q2.x); v[jj].z = hv.z + bflo(p.y) + bflo(q2.y); v[jj].w = hv.w + bfhi(p.y) + bfhi(q2.y);
      s += (v[jj].x * v[jj].x + v[jj].y * v[jj].y) + (v[jj].z * v[jj].z + v[jj].w * v[jj].w); }
    const float rstd = 1.f / sqrtf(wave_sum(s) * (1.f / DM) + 1e-6f);
#pragma unroll
    for (int jj = 0; jj < 4; ++jj) { const f32x4 gg = ((const GAS f32x4*)gf)[lane + 64 * jj]; op[64 * jj] = v[jj] * rstd * gg; } }
}
}
namespace mk {
#ifndef MK_STAGE
#define MK_STAGE 1
#endif
constexpr int N_PHASES = 11;

__global__ void __launch_bounds__(NTHR, 2) mk_fwd(Args args) {
  extern __shared__ __attribute__((aligned(16))) unsigned char lds_raw[];
  Frame F;
  F.lds = (LAS unsigned char*)lds_raw;
  F.MISC = (volatile LAS unsigned*)(F.lds + MISC_OFF);
  F.tid = threadIdx.x; F.lane = F.tid & 63; F.wave = __builtin_amdgcn_readfirstlane(F.tid >> 6);
  F.G = gridDim.x; { const int bx = blockIdx.x; F.vcu = (F.G % 8 == 0) ? (bx % 8) * (F.G / 8) + bx / 8 : bx; }
  unsigned char* ws = args.ws;
  gu32* ctl = (gu32*)(ws + WS_CTL);
  for (int u = F.tid; u < (LDS_BYTES - RING_BYTES) / 4; u += NTHR) ((LAS unsigned*)(F.lds + RING_BYTES))[u] = 0u;
  __syncthreads();
  XcdBarrier bar = xcd_barrier_post((unsigned*)(ctl + CW_BAR), F.MISC + 8);
  const int lo = args.ph_lo, hi = args.ph_hi;
#ifndef MK_REPEAT_MASK
#define MK_REPEAT_MASK 0
#endif
#define REP(k) for (int rep_ = 0; rep_ < (((MK_REPEAT_MASK) >> (k)) & 1) + 1; ++rep_)
#define REP2(k, stmt) do { stmt; if (((MK_REPEAT_MASK) >> (k)) & 1) { asm volatile("" ::: "memory"); stmt; } } while (0)
#define IN(k) (lo <= (k) && (k) < hi)
#define BOTH(k) (IN(k) && IN((k) + 1))
#define GRID_BAR() xcd_barrier(bar)

  if (IN(0)) { REP2(0, (p0_prologue<(MK_STAGE >= 5)>(F, args))); if (MK_STAGE >= 5) rt::build_wr(F.vcu * NTHR + F.tid, F.G * NTHR, args); if (BOTH(0)) GRID_BAR(); }

  if (IN(1)) {
    ProbPlain P; P.init(ws + WS_XN, ws + WS_WIN, T, NCOL, DM, F.G, (int)blockIdx.x);
    EpiInProj E{ws, (const float*)(ws + WS_ROPE), (const float*)(ws + WS_ROPE) + (size_t)T * 32};
    REP2(1, (gemm_phase<ProbPlain, EpiInProj, true>(F.lds, P, E)));
    if (BOTH(1)) GRID_BAR();
  }
  if (IN(2)) {
    if (MK_STAGE >= 3) REP(11) {
      for (int it = F.vcu; it < 256; it += F.G) { int tid_ = threadIdx.x; asm volatile("" : "+v"(tid_));
        hg::hgrn_item<false>(tid_, it >> 6, (it >> 5) & 1, it & 31, ws, args.out + 8 * 1048576, args.out + 12 * 1048576, F.lds); }
    }
    REP(2) for (int u = F.vcu; u < 256; u += F.G) att2::attn_unit(u >> 6, u & 63, ws, args.in[5], args.out + (size_t)blockIdx.x * 32768, (LAS char*)F.lds);
    if (BOTH(2)) GRID_BAR();
  }
  if (IN(3)) { hg::hgrn_scan(F.vcu * NTHR + F.tid, F.G * NTHR, args.out + 8 * 1048576, args.out + 12 * 1048576); if (BOTH(3)) GRID_BAR(); }
  if (IN(4)) {
    REP(4) for (int it = F.vcu; it < 256; it += F.G) { int tid_ = threadIdx.x; asm volatile("" : "+v"(tid_));
      hg::hgrn_item<true>(tid_, it >> 6, (it >> 5) & 1, it & 31, ws, args.out + 8 * 1048576, args.out + 12 * 1048576, F.lds); }
    if (BOTH(4)) GRID_BAR();
  }
  if (IN(5)) { REP(5) hg::hgrn_combine(F.vcu * NWAVES + F.wave, F.G * NWAVES, F.lane, ws, args.in[6]); if (BOTH(5)) GRID_BAR(); }
  if (IN(6)) {
    ProbPlain P; P.init(ws + WS_XN, ws + WS_WOUT, T, DM, DM, F.G, (int)blockIdx.x);
    EpiOutProj E{args.in[0], args.out};
    REP2(6, (gemm_phase<ProbPlain, EpiOutProj, true>(F.lds, P, E)));
    if (BOTH(6)) GRID_BAR();
  }
  if (IN(7)) { rt::router_phase(F, args, ctl + CW_CNT); if (BOTH(7)) GRID_BAR(); }
  if (IN(8)) {
    moe_tables(F, ctl + CW_CNT);
    ProbMoE<false> P{DM, (const char*)(ws + WS_XN), (const char*)(ws + WS_WGU), (const int*)(ws + rt::R_LIST), (const LAS int*)(F.lds + MOE_TAB), F.G, (int)blockIdx.x};
    EpiGateUp E{(bf16_t*)(ws + WS_Q), (const float*)(ws + rt::R_CWL)};
    REP2(8, (gemm_phase<ProbMoE<false>, EpiGateUp, true>(F.lds, P, E)));
    if (BOTH(8)) GRID_BAR();
  }
  if (IN(9)) {
    if (!IN(8)) moe_tables(F, ctl + CW_CNT);
    ProbMoE<true> P{FE, (const char*)(ws + WS_Q), (const char*)(ws + WS_WD), (const int*)(ws + rt::R_LIST), (const LAS int*)(F.lds + MOE_TAB), F.G, (int)blockIdx.x};
    EpiDown E{(bf16_t*)(ws + WS_V)};
    REP2(9, (gemm_phase<ProbMoE<true>, EpiDown, true>(F.lds, P, E)));
    if (BOTH(9)) GRID_BAR();
  }
  if (IN(10)) { if (!IN(8) && !IN(9)) moe_tables(F, ctl + CW_CNT); final_phase(F, args, (const bf16_t*)(ws + WS_V)); }
#undef IN
#undef BOTH
#undef GRID_BAR
}
}

extern "C" void kernel_launch(void* const* d_in, const int* in_sizes, int n_in, void* d_out, int out_size, void* d_ws, size_t ws_size, hipStream_t stream) {
  using namespace mk;
  static int grid = 0;
  if (grid == 0) {
    if (n_in != 17 || in_sizes[0] != T * DM || out_size != T * DM || ws_size < WS_END) { fprintf(stderr, "kernel_launch: unexpected shapes n_in %d out %d ws %zu (need %zu)\n", n_in, out_size, ws_size, (size_t)WS_END); grid = -1; return; }
    int dev = 0, cus = 0, per_cu = 0;
    if (hipGetDevice(&dev) != hipSuccess || hipDeviceGetAttribute(&cus, hipDeviceAttributeMultiprocessorCount, dev) != hipSuccess) { grid = -1; return; }
    if (hipFuncSetAttribute((const void*)mk_fwd, hipFuncAttributeMaxDynamicSharedMemorySize, LDS_BYTES) != hipSuccess) { fprintf(stderr, "kernel_launch: hipFuncSetAttribute failed\n"); grid = -1; return; }
    if (hipOccupancyMaxActiveBlocksPerMultiprocessor(&per_cu, (const void*)mk_fwd, NTHR, LDS_BYTES) != hipSuccess || per_cu < 1) { fprintf(stderr, "kernel_launch: occupancy query says %d blocks/CU\n", per_cu); per_cu = 1; }
    (void)hipGetLastError();
    grid = cus;
  }
  if (grid < 0) return;
  (void)hipMemsetAsync((char*)d_ws + WS_CTL, 0, CTL_ZERO_BYTES, stream);
  Args a{};
  for (int i = 0; i < 17; ++i) a.in[i] = (const float*)d_in[i];
  a.out = (float*)d_out; a.ws = (unsigned char*)d_ws;
  const int stage_hi[6] = {0, 2, 3, 6, 7, N_PHASES};
  a.ph_lo = 0; a.ph_hi = stage_hi[MK_STAGE];
  hipLaunchKernelGGL(mk_fwd, dim3(grid), dim3(NTHR), LDS_BYTES, stream, a);
#if MK_STAGE < 5
  { unsigned char* ws = (unsigned char*)d_ws; nv::Bufs b{};
    int* rt = (int*)(ws + WS_ROUTE);
    b.cnt = rt; b.off = rt + 64; b.tpos = rt + 1024; b.tcw = (float*)(rt + 1024 + 4 * T); b.cw = (float*)(rt + 1024 + 6 * T); b.list = rt + 1024 + 8 * T;
    b.scratch = (float*)d_out;
    b.Qb = (const unsigned short*)(ws + WS_Q); b.Kb = (const unsigned short*)(ws + WS_K); b.Vb = (const unsigned short*)(ws + WS_V);
    b.HQ = (const unsigned short*)(ws + WS_HQ); b.ZF = (const unsigned short*)(ws + WS_ZF); b.ZB = (const unsigned short*)(ws + WS_ZB); b.HI = (const unsigned short*)(ws + WS_HI); b.HG = (const unsigned short*)(ws + WS_HG);
    b.mixb = (unsigned short*)(ws + WS_XN);
    b.xt = (float*)(ws + WS_Q); b.hid = (float*)(ws + WS_Q + 64 * MiB);
    nv::run(d_in, (float*)d_out, b, MK_STAGE, stream); }
#endif
}
```

```cpp
#define MK_STAGE 5

#define MK_REPEAT_MASK 0

#include <hip/hip_runtime.h>
#include <cstdio>
#include <cstdint>
#include <cmath>
namespace mk {
#define LAS __attribute__((address_space(3)))
#define GAS __attribute__((address_space(1)))
typedef unsigned short bf16_t;
typedef short bf16x8 __attribute__((ext_vector_type(8)));
typedef short s16x4 __attribute__((ext_vector_type(4)));
typedef float f32x4 __attribute__((ext_vector_type(4)));
typedef float f32x2 __attribute__((ext_vector_type(2)));
typedef float f32x16 __attribute__((ext_vector_type(16)));
typedef unsigned u32x4 __attribute__((ext_vector_type(4)));
typedef unsigned u32x2 __attribute__((ext_vector_type(2)));
typedef GAS unsigned gu32;
typedef int v4i_t __attribute__((ext_vector_type(4)));
typedef int v8i_t __attribute__((ext_vector_type(8)));

constexpr int T = 16384, DM = 1024, NCOL = 4096, NEXP = 32, FE = 512;
constexpr int NWAVES = 8, NTHR = 512;
constexpr float LOG2E = 1.4426950408889634f;

__device__ __forceinline__ unsigned cvt_pk_bf16(float lo, float hi) { unsigned r; asm volatile("v_cvt_pk_bf16_f32 %0, %1, %2" : "=v"(r) : "v"(lo), "v"(hi)); return r; }
__device__ __forceinline__ float bf2f(unsigned short h) { return __uint_as_float((unsigned)h << 16); }
__device__ __forceinline__ float bflo(unsigned w) { return __uint_as_float(w << 16); }
__device__ __forceinline__ float bfhi(unsigned w) { return __uint_as_float(w & 0xffff0000u); }
__device__ __forceinline__ float wave_sum(float v) {
#pragma unroll
  for (int o = 1; o < 64; o <<= 1) v += __shfl_xor(v, o);
  return v;
}
__device__ __forceinline__ float fexp2(float x) { return __builtin_amdgcn_exp2f(x); }
__device__ __forceinline__ float flog2(float x) { return __builtin_amdgcn_logf(x); }
__device__ __forceinline__ float fsigm(float z) { return __builtin_amdgcn_rcpf(1.f + fexp2(-LOG2E * z)); }
__device__ __forceinline__ float fsilu(float z) { return z * fsigm(z); }
__device__ __forceinline__ void st16_wt(void* p, u32x4 v) { asm volatile("global_store_dwordx4 %0, %1, off sc1\n\ts_nop 1" :: "v"(p), "v"(v) : "memory"); }
__device__ __forceinline__ unsigned pk4_fp8(float a, float b, float c_, float d) { int w = 0; w = __builtin_amdgcn_cvt_pk_fp8_f32(a, b, w, false); w = __builtin_amdgcn_cvt_pk_fp8_f32(c_, d, w, true); return (unsigned)w; }
#define LDS_WAIT() asm volatile("s_waitcnt lgkmcnt(0)" ::: "memory")
#define VM_WAIT() asm volatile("s_waitcnt vmcnt(0)" ::: "memory")

#define XB_TMO      128
#define XB_XCNT(j)  (256  + 64 * (j))
#define XB_XSUB(j)  (1280 + 64 * (j))
#define XB_XGEN(j)  (2304 + 64 * (j))
#define XB_TOP      3328
#define XB_TOPGEN   3392
#define XCD_BAR_WORDS 3456
#define XB_SPIN_CAP (1u << 22)
__device__ __forceinline__ unsigned xb_ld(unsigned* p)              { return __hip_atomic_load(p, __ATOMIC_RELAXED, __HIP_MEMORY_SCOPE_AGENT); }
__device__ __forceinline__ unsigned xb_add(unsigned* p, unsigned v) { return __hip_atomic_fetch_add(p, v, __ATOMIC_RELAXED, __HIP_MEMORY_SCOPE_AGENT); }
__device__ __forceinline__ unsigned xb_xcc_id() { return (unsigned)__builtin_amdgcn_s_getreg((3 << 11) | 20) & 0xFu; }
#define XB_SPIN(cond, bar) do { unsigned _sp = 0; while (cond) { __builtin_amdgcn_s_sleep(1); \
    if ((++_sp & 255u) == 0u) { if (xb_ld(&(bar)[XB_TMO])) break; if (_sp > XB_SPIN_CAP) { atomicAdd(&(bar)[XB_TMO], 1u); break; } } } } while (0)
struct XcdBarrier { unsigned* bar; unsigned x; volatile LAS unsigned* st; };
__device__ __forceinline__ XcdBarrier xcd_barrier_post(unsigned* bar, volatile LAS unsigned* st) {
  XcdBarrier b; b.bar = bar; b.x = xb_xcc_id(); b.st = st;
  if (threadIdx.x == 0) (void)xb_add(&bar[XB_XCNT(b.x)], 1u);
  return b;
}
__device__ __forceinline__ void xcd_barrier_complete(unsigned* bar, unsigned x, unsigned& nloc, unsigned& nx) {
  const unsigned G = gridDim.x * gridDim.y * gridDim.z;
  unsigned sum, cnt, mine, sp = 0u;
  for (;;) {
    sum = 0u; cnt = 0u; mine = 0u;
#pragma unroll
    for (unsigned j = 0; j < 16; ++j) { const unsigned c = xb_ld(&bar[XB_XCNT(j)]); sum += c; cnt += (c > 0u) ? 1u : 0u; mine = (j == x) ? c : mine; }
    if (sum == G) break;
    __builtin_amdgcn_s_sleep(1);
    if ((++sp & 255u) == 0u) { if (xb_ld(&bar[XB_TMO])) break; if (sp > XB_SPIN_CAP) { atomicAdd(&bar[XB_TMO], 1u); break; } }
  }
  nloc = mine > 0u ? mine : 1u; nx = cnt > 0u ? cnt : 1u;
}
__device__ __forceinline__ unsigned xb_add_l2(unsigned* p, unsigned v) { return __hip_atomic_fetch_add(p, v, __ATOMIC_RELAXED, __HIP_MEMORY_SCOPE_WORKGROUP); }
__device__ __forceinline__ void xcd_barrier(const XcdBarrier& b) {
  asm volatile("s_waitcnt vmcnt(0)" ::: "memory");
  __syncthreads();
  if (threadIdx.x == 0) {
    unsigned* bar = b.bar;
    __builtin_amdgcn_s_waitcnt(0);
    unsigned nloc = b.st[0], nx = b.st[1];
    if (nloc == 0u) { xcd_barrier_complete(bar, b.x, nloc, nx); b.st[0] = nloc; b.st[1] = nx; }
    const unsigned old = xb_add_l2(&bar[XB_XSUB(b.x)], 1u);
    const unsigned gen = old / nloc;
    if (old + 1u == (gen + 1u) * nloc) {
      __builtin_amdgcn_fence(__ATOMIC_RELEASE, "agent");
      asm volatile("s_waitcnt vmcnt(0)" ::: "memory");
      const unsigned og = xb_add(&bar[XB_TOP], 1u);
      const unsigned tgt = (og / nx + 1u) * nx;
      if (og + 1u != tgt) XB_SPIN(xb_ld(&bar[XB_TOP]) < tgt, bar);
      __builtin_amdgcn_fence(__ATOMIC_ACQUIRE, "agent");
      (void)xb_add_l2(&bar[XB_XGEN(b.x)], 1u);
      asm volatile("s_waitcnt vmcnt(0)" ::: "memory");
    } else {
      unsigned zero_ = 0u; asm volatile("" : "+s"(zero_));
      XB_SPIN(xb_add_l2(&bar[XB_XGEN(b.x)], zero_) == gen, bar);
      __builtin_amdgcn_fence(__ATOMIC_ACQUIRE, "agent");
      asm volatile("s_waitcnt vmcnt(0)" ::: "memory");
    }
  }
  __syncthreads();
}

constexpr int BM = 256, BK = 64, HALF = 128, HTB = HALF * BK * 2, STAGE_BYTES = 8 * HTB, NXCD = 8, WGM = 8;
__device__ __forceinline__ int lds_byte(int r, int c) { const int st = (r >> 4) * 2 + (c >> 5), rr = r & 15, cc = c & 31, ob = rr * 64 + cc * 2; return st * 1024 + (ob ^ (((ob >> 9) & 1) << 5)); }
__device__ __forceinline__ void stage_rc(int b, int& R, int& C) { const int st = b / 1024, sb = b % 1024, swz = sb ^ (((sb >> 9) & 1) << 5); R = (st >> 1) * 16 + swz / 64; C = (st & 1) * 32 + (swz % 64) / 2; }
__device__ __forceinline__ int perm32(int rho) { const int n = rho >> 4, i = rho & 15; return 8 * (i >> 2) + 4 * n + (i & 3); }

struct Unit { int pm, pn, e, nrows, row0; };

template <class Prob, class Epi, bool ALIGN_EPI>
__device__ __forceinline__ void gemm_phase(LAS unsigned char* lds, const Prob& P, const Epi& E) {
  const int tid = threadIdx.x, wid = __builtin_amdgcn_readfirstlane(tid >> 6), lane = tid & 63, wr = wid >> 2, wc = wid & 3, fr = lane & 15, fq = lane >> 4;
  const int K = P.K, nt = K / BK;
  int Rr[2], Cc[2]; unsigned voffB[2];
#pragma unroll
  for (int i = 0; i < 2; ++i) { int R, C; stage_rc(tid * 16 + i * 8192, R, C); Rr[i] = R; Cc[i] = C; const int Rb = (R & ~31) + perm32(R & 31); voffB[i] = (unsigned)(Rb * K + C) * 2u; }
  const size_t kstep = (size_t)(BK * 2);
  const size_t hstep = (size_t)HALF * K * 2;
  const unsigned ldsw = (unsigned)wid * 1024u;
  const int aoff = lds_byte(wr * 64 + fr, fq * 8), boff = lds_byte(wc * 32 + fr, fq * 8);
#define PG8_SA(b, h) (((b) * 2 + (h)) * HTB)
#define PG8_SB(b, h) ((4 + (b) * 2 + (h)) * HTB)
#define PG8_STAGE(bufoff, gbase, voff) do { _Pragma("unroll") for (int _i = 0; _i < 2; ++_i) \
        __builtin_amdgcn_global_load_lds((const unsigned*)((const char*)(gbase) + (voff)[_i]), (LAS unsigned*)(lds + (bufoff) + ldsw + _i * 8192), 16, 0, 0); } while (0)
#define PG8_STAGE_X(bufoff, k_) do { int fr_ = fr, fq_ = fq; asm volatile("" : "+v"(fr_), "+v"(fq_));     \
        _Pragma("unroll") for (int _i = 0; _i < 2; ++_i) \
        __builtin_amdgcn_global_load_lds((const unsigned*)(E.xpf_src(cur, 2 * (k_) + _i, wr, wc, fr_, fq_)), (LAS unsigned*)(lds + (bufoff) + ldsw + _i * 8192), 16, 0, 0); } while (0)
#define PG8_LDA(dst, b, h) do { _Pragma("unroll") for (int m = 0; m < 4; ++m) _Pragma("unroll") for (int k = 0; k < 2; ++k) dst[m][k] = *(const LAS bf16x8*)(lds + PG8_SA(b, h) + aoff + m * 2048 + k * 1024); } while (0)
#define PG8_LDB(dst, b, h) do { _Pragma("unroll") for (int n = 0; n < 2; ++n) _Pragma("unroll") for (int k = 0; k < 2; ++k) dst[n][k] = *(const LAS bf16x8*)(lds + PG8_SB(b, h) + boff + n * 2048 + k * 1024); } while (0)
#define PG8_MMA(ai, bj, At, Bt) do { if (Prob::TAILS && ((ai) ? sk1 : skw)) break; __builtin_amdgcn_s_setprio(1); \
        if constexpr (Prob::FP8) {   \
          _Pragma("unroll") for (int m = 0; m < 4; ++m) _Pragma("unroll") for (int n = 0; n < 2; ++n) { \
            const v8i_t wa = __builtin_shufflevector(__builtin_bit_cast(v4i_t, Bt[n][0]), __builtin_bit_cast(v4i_t, Bt[n][1]), 0, 1, 2, 3, 4, 5, 6, 7); \
            const v8i_t xa = __builtin_shufflevector(__builtin_bit_cast(v4i_t, At[m][0]), __builtin_bit_cast(v4i_t, At[m][1]), 0, 1, 2, 3, 4, 5, 6, 7); \
            acc[ai][bj][m][n] = __builtin_amdgcn_mfma_scale_f32_16x16x128_f8f6f4(wa, xa, acc[ai][bj][m][n], 0, 0, 0, 0, 0, 0); }   \
        } else { \
          _Pragma("unroll") for (int m = 0; m < 4; ++m) _Pragma("unroll") for (int n = 0; n < 2; ++n) _Pragma("unroll") for (int k = 0; k < 2; ++k) \
            acc[ai][bj][m][n] = __builtin_amdgcn_mfma_f32_16x16x32_bf16(Bt[n][k], At[m][k], acc[ai][bj][m][n], 0, 0, 0); } \
        __builtin_amdgcn_s_setprio(0); } while (0)
#define PG8_WAIT_V(n) asm volatile("s_waitcnt vmcnt(" #n ")" ::: "memory")
#define PG8_WAIT_L(n) asm volatile("s_waitcnt lgkmcnt(" #n ")" ::: "memory")
#define PG8_BAR __builtin_amdgcn_s_barrier()
#define PG8_SCHED __builtin_amdgcn_sched_barrier(0)
  Unit cur, nxt; int ui = 0;
  if (!P.next(0, cur)) return;
  f32x4 acc[2][2][4][2];
#pragma unroll
  for (int a = 0; a < 2; ++a)
#pragma unroll
    for (int b = 0; b < 2; ++b)
#pragma unroll
      for (int m = 0; m < 4; ++m)
#pragma unroll
        for (int n = 0; n < 2; ++n) acc[a][b][m][n] = (f32x4){0.f, 0.f, 0.f, 0.f};
  bf16x8 At[4][2], B0[2][2], B1[2][2];
  unsigned aC0[2], aC1[2], aN0[2], aN1[2];
#pragma unroll
  for (int i = 0; i < 2; ++i) { aC0[i] = P.a_row_off(cur, Rr[i]) + (unsigned)Cc[i] * 2u; aC1[i] = P.a_row_off(cur, HALF + Rr[i]) + (unsigned)Cc[i] * 2u; aN0[i] = aC0[i]; aN1[i] = aC1[i]; }
  const char* const cAb = P.Abase;
  const char* cB = P.b_rows(cur);
  PG8_STAGE(PG8_SB(0, 0), cB, voffB); PG8_STAGE(PG8_SB(0, 1), cB + hstep, voffB); PG8_STAGE(PG8_SA(0, 0), cAb, aC0); PG8_STAGE(PG8_SA(0, 1), cAb, aC1);
  if (wr == 1) PG8_BAR;
  PG8_WAIT_V(2); PG8_BAR;
  PG8_STAGE(PG8_SB(1, 0), cB + kstep, voffB); PG8_STAGE(PG8_SA(1, 0), cAb + kstep, aC0); PG8_STAGE(PG8_SB(1, 1), cB + hstep + kstep, voffB);
  PG8_WAIT_V(6); PG8_BAR;
  for (;;) {
    const bool sk1 = Prob::TAILS && (cur.nrows <= 128 || (cur.nrows <= 192 && wr == 1)), skw = Prob::TAILS && cur.nrows <= 64 && wr == 1;
    const bool has_next = P.next(ui + 1, nxt);
    const char* nB = cB;
    if (has_next) { nB = P.b_rows(nxt);
#pragma unroll
      for (int i = 0; i < 2; ++i) { aN0[i] = P.a_row_off(nxt, Rr[i]) + (unsigned)Cc[i] * 2u; aN1[i] = P.a_row_off(nxt, HALF + Rr[i]) + (unsigned)Cc[i] * 2u; }
    } else {
#pragma unroll
      for (int i = 0; i < 2; ++i) { aN0[i] = aC0[i]; aN1[i] = aC1[i]; }
    }
    for (int t = 0; t < nt; t += 2) {
      const bool last = (t == nt - 2);
      const char* a1 = cAb + (size_t)(t + 1) * kstep;
      const char* a2 = last ? cAb : cAb + (size_t)(t + 2) * kstep; const char* b2 = last ? nB : cB + (size_t)(t + 2) * kstep;
      const char* a3 = a2 + kstep; const char* b3 = b2 + kstep;
      unsigned s0[2], s1[2];
#pragma unroll
      for (int i = 0; i < 2; ++i) { s0[i] = last ? aN0[i] : aC0[i]; s1[i] = last ? aN1[i] : aC1[i]; }
      PG8_LDB(B0, 0, 0); PG8_LDB(B1, 0, 1); PG8_SCHED; PG8_LDA(At, 0, 0); PG8_STAGE(PG8_SA(1, 1), a1, aC1);
      PG8_WAIT_V(8); PG8_WAIT_L(0); PG8_BAR; PG8_MMA(0, 0, At, B0); PG8_MMA(0, 1, At, B1); PG8_BAR; PG8_SCHED;
      bool xpf = false; if constexpr (Epi::XPF) xpf = last && !has_next;
      PG8_LDA(At, 0, 1);
      if (xpf) { if constexpr (Epi::XPF) { PG8_STAGE_X(PG8_SB(0, 0), 0); PG8_STAGE_X(PG8_SB(0, 1), 1); PG8_STAGE_X(PG8_SA(0, 0), 2); } }
      else { PG8_STAGE(PG8_SB(0, 0), b2, voffB); PG8_STAGE(PG8_SB(0, 1), b2 + hstep, voffB); PG8_STAGE(PG8_SA(0, 0), a2, s0); }
      PG8_WAIT_V(8); PG8_WAIT_L(0); PG8_BAR; PG8_MMA(1, 0, At, B0); PG8_MMA(1, 1, At, B1); PG8_BAR; PG8_SCHED;
      PG8_LDB(B0, 1, 0); PG8_LDB(B1, 1, 1); PG8_SCHED; PG8_LDA(At, 1, 0);
      if (xpf) { if constexpr (Epi::XPF) { PG8_STAGE_X(PG8_SA(0, 1), 3); } } else { PG8_STAGE(PG8_SA(0, 1), a2, s1); }
      PG8_WAIT_V(8); PG8_WAIT_L(0); PG8_BAR; PG8_MMA(0, 0, At, B0); PG8_MMA(0, 1, At, B1); PG8_BAR; PG8_SCHED;
      PG8_LDA(At, 1, 1);
      if (xpf) { if constexpr (Epi::XPF) { PG8_STAGE_X(PG8_SB(1, 0), 4); PG8_STAGE_X(PG8_SB(1, 1), 5); PG8_STAGE_X(PG8_SA(1, 0), 6); } }
      else { PG8_STAGE(PG8_SB(1, 0), b3, voffB); PG8_STAGE(PG8_SB(1, 1), b3 + hstep, voffB); PG8_STAGE(PG8_SA(1, 0), a3, s0); }
      PG8_WAIT_V(8); PG8_WAIT_L(0); PG8_BAR; PG8_MMA(1, 0, At, B0); PG8_MMA(1, 1, At, B1); PG8_BAR; PG8_SCHED;
    }
    if constexpr (ALIGN_EPI) { if (wr == 0) PG8_BAR; }
    if constexpr (Epi::XPF) { if (!has_next) { PG8_WAIT_V(0);
        const unsigned xb_[7] = {PG8_SB(0, 0), PG8_SB(0, 1), PG8_SA(0, 0), PG8_SA(0, 1), PG8_SB(1, 0), PG8_SB(1, 1), PG8_SA(1, 0)};
        E.run_pf(acc, cur, wr, wc, fr, fq, lds + ldsw + (unsigned)lane * 16u, xb_); } else E(acc, cur, wr, wc, fr, fq); }
    else E(acc, cur, wr, wc, fr, fq);
#ifdef MK_DOUBLE_EPI
    if (MK_DOUBLE_EPI == Epi::ID) { asm volatile("" ::: "memory"); E(acc, cur, wr, wc, fr, fq); }
#endif
    if (!has_next) break;
#pragma unroll
    for (int a = 0; a < 2; ++a)
#pragma unroll
      for (int b = 0; b < 2; ++b)
#pragma unroll
        for (int m = 0; m < 4; ++m)
#pragma unroll
          for (int n = 0; n < 2; ++n) acc[a][b][m][n] = (f32x4){0.f, 0.f, 0.f, 0.f};
    cur = nxt; cB = nB; ++ui;
#pragma unroll
    for (int i = 0; i < 2; ++i) { aC0[i] = aN0[i]; aC1[i] = aN1[i]; }
    if constexpr (ALIGN_EPI) { if (wr == 1) PG8_BAR; }
  }
  PG8_WAIT_V(0);
  if constexpr (!ALIGN_EPI) { if (wr == 0) PG8_BAR; }
  PG8_BAR;
#undef PG8_SA
#undef PG8_SB
#undef PG8_STAGE
#undef PG8_STAGE_X
#undef PG8_LDA
#undef PG8_LDB
#undef PG8_MMA
#undef PG8_WAIT_V
#undef PG8_WAIT_L
#undef PG8_BAR
#undef PG8_SCHED
}
}
namespace mk {
constexpr size_t MiB = 1u << 20;
constexpr size_t WS_CTL = 0, CTL_ZERO_BYTES = 256 * 1024;
constexpr size_t WS_SMALL = 512 * 1024;
constexpr size_t WS_WIN = 1 * MiB;
constexpr size_t WS_WOUT = 9 * MiB;
constexpr size_t WS_ROPE = 11 * MiB;
constexpr size_t WS_ROUTE = 15 * MiB;
constexpr size_t WS_WGU = 20 * MiB;
constexpr size_t WS_XN = 84 * MiB;
constexpr size_t WS_Q = 116 * MiB;
constexpr size_t WS_K = 132 * MiB;
constexpr size_t WS_V = 148 * MiB;
constexpr size_t WS_HQ = 164 * MiB;
constexpr size_t WS_ZF = 180 * MiB;
constexpr size_t WS_ZB = 196 * MiB;
constexpr size_t WS_HI = 212 * MiB;
constexpr size_t WS_HG = 228 * MiB;
constexpr size_t WS_WD = 244 * MiB;
constexpr size_t WS_END = 276 * MiB;
constexpr int CW_BAR = 1024;
constexpr int CW_CNT = 8192;

constexpr int RING_BYTES = 131072;
constexpr int MISC_OFF = RING_BYTES + 320;
constexpr int LDS_BYTES = 147456;

__device__ __forceinline__ unsigned char* q8_base(const unsigned char* ws) { return (unsigned char*)ws + WS_ROUTE; }
__device__ __forceinline__ unsigned char* k8_base(const float* out) { return (unsigned char*)out + (size_t)49 * MiB; }
__device__ __forceinline__ unsigned char* v8_base(const float* out) { return (unsigned char*)out + (size_t)53 * MiB; }
struct Args {
  const float* in[17]; float* out; unsigned char* ws; int ph_lo, ph_hi;
};

struct Frame {
  LAS unsigned char* lds;
  volatile LAS unsigned* MISC;
  int tid, lane, wave, vcu, G;
};

__device__ __forceinline__ void transpose_item(const float* W, int ldw, int k0, int n0, bf16_t* WT, int Kdst, int dst_row0, LAS float* scr, int lane) {
#pragma unroll 8
  for (int i = 0; i < 32; ++i) { const int kk = 2 * i + (lane >> 5); scr[kk * 33 + (lane & 31)] = __builtin_nontemporal_load(W + (size_t)(k0 + kk) * ldw + n0 + (lane & 31)); }
  LDS_WAIT(); asm volatile("" ::: "memory");
  const int c = lane & 7;
#pragma unroll
  for (int j = 0; j < 4; ++j) { const int n = (lane >> 3) + 8 * j; const LAS float* s = scr + (8 * c) * 33 + n;
    u32x4 o; o.x = cvt_pk_bf16(s[0 * 33], s[1 * 33]); o.y = cvt_pk_bf16(s[2 * 33], s[3 * 33]); o.z = cvt_pk_bf16(s[4 * 33], s[5 * 33]); o.w = cvt_pk_bf16(s[6 * 33], s[7 * 33]);
    *(GAS u32x4*)(WT + (size_t)(dst_row0 + n) * Kdst + k0 + 8 * c) = o; }
  LDS_WAIT(); asm volatile("" ::: "memory");
}
__device__ __forceinline__ int inproj_dst_col(int n0) {
  if (n0 >= 1024) return n0;
  const int R = n0 >> 9, rem = n0 & 511, hc = rem >> 6, bj = (rem >> 5) & 1;
  return R * 512 + (hc >> 2) * 256 + bj * 128 + (hc & 3) * 32;
}
__device__ __forceinline__ void rms_row_to_bf16(const float* xrow, const float* g, bf16_t* orow, int lane) {
  const GAS f32x4* xr = (const GAS f32x4*)xrow + lane;
  f32x4 v[4]; float s = 0.f;
#pragma unroll
  for (int j = 0; j < 4; ++j) { v[j] = __builtin_nontemporal_load(xr + 64 * j); s += (v[j].x * v[j].x + v[j].y * v[j].y) + (v[j].z * v[j].z + v[j].w * v[j].w); }
  const float rstd = 1.f / sqrtf(wave_sum(s) * (1.f / DM) + 1e-6f);
  GAS u32x2* o8 = (GAS u32x2*)orow + lane;
#pragma unroll
  for (int j = 0; j < 4; ++j) { const f32x4 gg = ((const GAS f32x4*)g)[lane + 64 * j]; u32x2 w; w.x = cvt_pk_bf16(v[j].x * rstd * gg.x, v[j].y * rstd * gg.y); w.y = cvt_pk_bf16(v[j].z * rstd * gg.z, v[j].w * rstd * gg.w); o8[64 * j] = w; }
}

template <bool MOE_W>
__device__ __forceinline__ void p0_prologue(Frame& F, const Args& a) {
  LAS float* scr = (LAS float*)(F.lds + F.wave * 16384);
  const int gw = F.vcu * NWAVES + F.wave, NGW = F.G * NWAVES;
  const float* w_in = a.in[1]; const float* w_out = a.in[2];
  bf16_t* WinT = (bf16_t*)(a.ws + WS_WIN); bf16_t* WoutT = (bf16_t*)(a.ws + WS_WOUT);
  constexpr int I_IN = 16 * 128, I_OUT = 16 * 32, I_G = 32 * 16 * 16, I_D = 32 * 8 * 32;
  const int NITEMS = I_IN + I_OUT + (MOE_W ? (2 * I_G + I_D) : 0);
  for (int it = gw; it < NITEMS; it += NGW) {
    int r = it;
    if (r < I_IN) { const int kb = r / 128, nb = r % 128; transpose_item(w_in, NCOL, 64 * kb, 32 * nb, WinT, DM, inproj_dst_col(32 * nb), scr, F.lane); continue; } r -= I_IN;
    if (r < I_OUT) { const int kb = r / 32, nb = r % 32; transpose_item(w_out, DM, 64 * kb, 32 * nb, WoutT, DM, 32 * nb, scr, F.lane); continue; } r -= I_OUT;
    if (MOE_W) {
      bf16_t* WguT = (bf16_t*)(a.ws + WS_WGU); bf16_t* WdT = (bf16_t*)(a.ws + WS_WD);
      if (r < 2 * I_G) { const int which = r / I_G; r -= which * I_G; const int e = r / 256, q = r % 256, kb = q / 16, nb = q % 16;
        const float* W = (which ? a.in[14] : a.in[13]) + (size_t)e * DM * FE; const int f0 = 32 * nb;
        transpose_item(W, FE, 64 * kb, f0, WguT + (size_t)e * 1024 * DM, DM, (f0 >> 7) * 256 + which * 128 + (f0 & 127), scr, F.lane); continue; } r -= 2 * I_G;
      { const int e = r / 256, q = r % 256, kb = q / 32, nb = q % 32;
        transpose_item(a.in[15] + (size_t)e * FE * DM, DM, 64 * kb, 32 * nb, WdT + (size_t)e * DM * FE, FE, 32 * nb, scr, F.lane); }
    }
  }
  { const float* x = a.in[0]; bf16_t* XN = (bf16_t*)(a.ws + WS_XN);
    for (int m = gw; m < T; m += NGW) rms_row_to_bf16(x + (size_t)m * DM, a.in[3], XN + (size_t)m * DM, F.lane); }
  { float* cs = (float*)(a.ws + WS_ROPE); float* sn = cs + (size_t)T * 32;
    const int gt = F.vcu * NTHR + F.tid, NGT = F.G * NTHR;
    for (int idx = gt; idx < T * 32; idx += NGT) { const int j = idx & 31, t = idx >> 5;
      const float inv = __builtin_amdgcn_exp2f((float)j * (-13.287712379549449f / 32.0f)); const float ang = (float)t * inv;
      const double rev = (double)ang * 0.15915494309189535; const float fr = (float)(rev - rint(rev));
      cs[idx] = __builtin_amdgcn_cosf(fr); sn[idx] = __builtin_amdgcn_sinf(fr); } }
  if (F.vcu == 0 && F.wave == 0) {
    float* sm = (float*)(a.ws + WS_SMALL); const float* lp = a.in[4];
    float d1 = lp[F.lane] * lp[64 + F.lane], d2 = lp[128 + F.lane] * lp[192 + F.lane];
    d1 = wave_sum(d1); d2 = wave_sum(d2);
    if (F.lane == 0) sm[0] = expf(d1) - expf(d2) + 0.2f;
    const float* lbl = a.in[7];
    for (int i = F.lane; i < 1024; i += 64) { const int dir = i >> 9, c = i & 511; const float a0 = lbl[(dir * 2 + 0) * 512 + c], a1 = lbl[(dir * 2 + 1) * 512 + c];
      const float mx = fmaxf(a0, a1); const float e0 = expf(a0 - mx), e1 = expf(a1 - mx); sm[64 + i] = e0 / (e0 + e1); }
  }
}

struct ProbPlain {
  static constexpr bool TAILS = false, FP8 = false; static constexpr int scale_w = 0, scale_x = 0;
  int K; const char* Abase; const char* Bt; int nM, nN, nwg, G, c;
  __device__ __forceinline__ void init(const void* A, const void* B, int M, int N, int K_, int G_, int c_) { Abase = (const char*)A; Bt = (const char*)B; K = K_; nM = M / BM; nN = N / BM; nwg = nM * nN; G = G_; c = c_; }
  __device__ __forceinline__ bool next(int i, Unit& u) const {
    const long L = (long)i * G + c; if (L >= nwg) return false;
    int wgid = (int)L; { const int q = nwg / NXCD, r = nwg % NXCD, xcd = wgid % NXCD, off = wgid / NXCD; wgid = (xcd < r ? xcd * (q + 1) : r * (q + 1) + (xcd - r) * q) + off; }
    const int nig = WGM * nN, gid = wgid / nig, fm = gid * WGM, gsz = (nM - fm) < WGM ? (nM - fm) : WGM;
    u.pm = fm + ((wgid % nig) % gsz); u.pn = (wgid % nig) / gsz; u.e = 0; u.nrows = 256; u.row0 = u.pm * 256; return true;
  }
  __device__ __forceinline__ unsigned a_row_off(const Unit& u, int r) const { return (unsigned)(u.pm * BM + r) * (unsigned)K * 2u; }
  __device__ __forceinline__ const char* b_rows(const Unit& u) const { return Bt + (size_t)u.pn * BM * K * 2; }
};

struct EpiInProj { static constexpr int ID = 1; static constexpr bool XPF = false;
  unsigned char* ws; const float* cs; const float* sn; const float* out;
  __device__ __forceinline__ void operator()(const f32x4 (&acc)[2][2][4][2], const Unit& u, int wr, int wc, int fr, int fq) const {
    const int row0 = u.pm * BM + wr * 64 + fr, pn = u.pn;
    if (pn < 4) {
      bf16_t* base = (bf16_t*)(ws + (pn < 2 ? WS_Q : WS_K)) + (size_t)(4 * (pn & 1) + wc) * T * 64;
#pragma unroll
      for (int ai = 0; ai < 2; ++ai) {
        f32x4 tc0[4], tc1[4], ts0[4], ts1[4];
#pragma unroll
        for (int m = 0; m < 4; ++m) { const int t = row0 + ai * HALF + m * 16;
          tc0[m] = *(const f32x4*)(cs + (size_t)t * 32 + 8 * fq); tc1[m] = *(const f32x4*)(cs + (size_t)t * 32 + 8 * fq + 4);
          ts0[m] = *(const f32x4*)(sn + (size_t)t * 32 + 8 * fq); ts1[m] = *(const f32x4*)(sn + (size_t)t * 32 + 8 * fq + 4); }
        asm volatile("s_waitcnt vmcnt(0)" ::: "memory");
#pragma unroll
        for (int m = 0; m < 4; ++m) { const int t = row0 + ai * HALF + m * 16;
          const f32x4 c0 = tc0[m], c1 = tc1[m], s0 = ts0[m], s1 = ts1[m];
          const f32x4 x1a = acc[ai][0][m][0], x1b = acc[ai][0][m][1], x2a = acc[ai][1][m][0], x2b = acc[ai][1][m][1];
          const float qs = pn < 2 ? 0.125f * LOG2E : 1.f;
          const f32x4 o1a = (x1a * c0 - x2a * s0) * qs, o1b = (x1b * c1 - x2b * s1) * qs, o2a = (x1a * s0 + x2a * c0) * qs, o2b = (x1b * s1 + x2b * c1) * qs;
          u32x4 w1, w2; w1.x = cvt_pk_bf16(o1a[0], o1a[1]); w1.y = cvt_pk_bf16(o1a[2], o1a[3]); w1.z = cvt_pk_bf16(o1b[0], o1b[1]); w1.w = cvt_pk_bf16(o1b[2], o1b[3]);
          w2.x = cvt_pk_bf16(o2a[0], o2a[1]); w2.y = cvt_pk_bf16(o2a[2], o2a[3]); w2.z = cvt_pk_bf16(o2b[0], o2b[1]); w2.w = cvt_pk_bf16(o2b[2], o2b[3]);
          bf16_t* rp = base + (size_t)t * 64 + 8 * fq;
          if (!(wc & 1)) { st16_wt(rp, w1); st16_wt(rp + 32, w2); }
          if (wc & 1) {
            const float f8s = pn < 2 ? 4.f : 0.25f;
            unsigned char* p8 = (pn < 2 ? q8_base(ws) : k8_base(out)) + ((size_t)(2 * (pn & 1) + (wc >> 1)) * T + t) * 64 + 8 * fq;
            u32x2 e1, e2; e1.x = pk4_fp8(o1a[0] * f8s, o1a[1] * f8s, o1a[2] * f8s, o1a[3] * f8s); e1.y = pk4_fp8(o1b[0] * f8s, o1b[1] * f8s, o1b[2] * f8s, o1b[3] * f8s);
            e2.x = pk4_fp8(o2a[0] * f8s, o2a[1] * f8s, o2a[2] * f8s, o2a[3] * f8s); e2.y = pk4_fp8(o2b[0] * f8s, o2b[1] * f8s, o2b[2] * f8s, o2b[3] * f8s);
            *(GAS u32x2*)p8 = e1; *(GAS u32x2*)(p8 + 32) = e2; } } }
    } else if (pn < 6) {
      int fr_ = fr, fq_ = fq; asm volatile("" : "+v"(fr_), "+v"(fq_));
      const unsigned dd = (unsigned)((fr_ & 3) + 4 * (fr_ >> 3));
      const unsigned v8lane = (unsigned)((fr_ >> 2) & 1) * 4096u + (dd >> 2) * 2048u + (dd & 3) * 4u + (unsigned)(wc * 32 + 8 * fq_) * 16u;
#pragma unroll
      for (int bj = 0; bj < 2; ++bj) { bf16_t* base = (bf16_t*)(ws + WS_V) + (size_t)(2 * (pn - 4) + bj) * T * 128 + wc * 32 + 8 * fq;
#pragma unroll
        for (int ai = 0; ai < 2; ++ai) {
#pragma unroll
          for (int m = 0; m < 4; ++m) { asm volatile("" ::: "memory"); const int t = row0 + ai * HALF + m * 16; const f32x4 v0 = acc[ai][bj][m][0], v1 = acc[ai][bj][m][1];
            u32x4 w; w.x = cvt_pk_bf16(v0[0], v0[1]); w.y = cvt_pk_bf16(v0[2], v0[3]); w.z = cvt_pk_bf16(v1[0], v1[1]); w.w = cvt_pk_bf16(v1[2], v1[3]);
            st16_wt(base + (size_t)t * 128, w); }
          { unsigned char* v8 = v8_base(out) + (size_t)(2 * (pn - 4) + bj) * (256 * 8192) + (size_t)(u.pm * 4 + ai * 2 + wr) * 8192u + v8lane;
#pragma unroll
            for (int n = 0; n < 2; ++n)
#pragma unroll
              for (int i = 0; i < 4; ++i)
                *(GAS unsigned*)(v8 + (4 * n + i) * 16) = pk4_fp8(acc[ai][bj][0][n][i], acc[ai][bj][1][n][i], acc[ai][bj][2][n][i], acc[ai][bj][3][n][i]); } } }
    } else {
      const int reg = (pn - 6) >> 1; const bool act = (reg == 0) || (reg == 4);
      bf16_t* base = (bf16_t*)(ws + WS_HQ + (size_t)reg * 16 * MiB) + ((pn - 6) & 1) * 256 + wc * 32 + 8 * fq;
#pragma unroll
      for (int bj = 0; bj < 2; ++bj)
#pragma unroll
        for (int ai = 0; ai < 2; ++ai)
#pragma unroll
          for (int m = 0; m < 4; ++m) { const int t = row0 + ai * HALF + m * 16; f32x4 v0 = acc[ai][bj][m][0], v1 = acc[ai][bj][m][1];
            if (act) {
#pragma unroll
              for (int i = 0; i < 4; ++i) { v0[i] = fsilu(v0[i]); v1[i] = fsilu(v1[i]); } }
            u32x4 w; w.x = cvt_pk_bf16(v0[0], v0[1]); w.y = cvt_pk_bf16(v0[2], v0[3]); w.z = cvt_pk_bf16(v1[0], v1[1]); w.w = cvt_pk_bf16(v1[2], v1[3]);
            st16_wt(base + (size_t)t * 512 + bj * 128, w); }
    }
  }
};
}
namespace mk {
namespace att {
constexpr int NW = 8, QBLK = 32, KVBLK = 64, DV = 128, DQK = 64;
constexpr float SCALE = 1.0f / LOG2E;
constexpr float THR = 8.f;
constexpr int SHM_V = KVBLK * DV * 2, SHM_K = KVBLK * DQK * 2;
constexpr int SHM_ATTN = 2 * SHM_V + 2 * SHM_K + NW * 64 * 4;
#define KSWZ(row, colB) ((row) * 128 + ((colB) ^ ((((row) >> 1) & 7) << 4)))
#define SBAR() __builtin_amdgcn_sched_barrier(0)
__device__ __forceinline__ int crow(int r, int hi) { return (r & 3) + 8 * (r >> 2) + 4 * hi; }

__device__ __forceinline__ void partialSM(f32x16& p0, f32x16& p1, float& m_reg, float& mn, float& alpha) {
  constexpr float C = SCALE * LOG2E;
  float pmax = p0[0];
#pragma unroll
  for (int r = 1; r < 16; ++r) pmax = fmaxf(pmax, p0[r]);
#pragma unroll
  for (int r = 0; r < 16; ++r) pmax = fmaxf(pmax, p1[r]);
  { auto rr = __builtin_amdgcn_permlane32_swap(__float_as_uint(pmax), __float_as_uint(pmax), false, false);
    pmax = fmaxf(__uint_as_float(rr[0]), __uint_as_float(rr[1])); }
  if (__builtin_expect(__all(pmax - m_reg <= THR / SCALE), 1)) { mn = m_reg; alpha = 1.f; }
  else { mn = fmaxf(m_reg, pmax); alpha = __builtin_amdgcn_exp2f((m_reg - mn) * C); m_reg = mn; }
  const float mnC = -mn * C;
#pragma unroll
  for (int r = 0; r < 16; ++r) p0[r] = fmaf(p0[r], C, mnC);
#pragma unroll
  for (int r = 0; r < 16; ++r) p1[r] = fmaf(p1[r], C, mnC);
#pragma unroll
  for (int r = 0; r < 16; ++r) p0[r] = __builtin_amdgcn_exp2f(p0[r]);
}
__device__ __forceinline__ void finishSM(f32x16& p0, f32x16& p1, float alpha, float& l_reg, bf16x8& pa0, bf16x8& pa1, bf16x8& pa2, bf16x8& pa3) {
#pragma unroll
  for (int r = 0; r < 16; ++r) p1[r] = __builtin_amdgcn_exp2f(p1[r]);
  float ps = 0;
#pragma unroll
  for (int r = 0; r < 16; ++r) ps += p0[r];
#pragma unroll
  for (int r = 0; r < 16; ++r) ps += p1[r];
  { auto rr = __builtin_amdgcn_permlane32_swap(__float_as_uint(ps), __float_as_uint(ps), false, false);
    ps = __uint_as_float(rr[0]) + __uint_as_float(rr[1]); }
  l_reg = l_reg * alpha + ps;
#define PK4(P, BASE, OUT) do { unsigned a0 = cvt_pk_bf16(P[BASE + 0], P[BASE + 1]), a1 = cvt_pk_bf16(P[BASE + 2], P[BASE + 3]);   \
    unsigned b0 = cvt_pk_bf16(P[BASE + 4], P[BASE + 5]), b1 = cvt_pk_bf16(P[BASE + 6], P[BASE + 7]);                              \
    auto r0 = __builtin_amdgcn_permlane32_swap(a0, b0, false, false); auto r1 = __builtin_amdgcn_permlane32_swap(a1, b1, false, false); \
    u32x4 w = {r0[0], r1[0], r0[1], r1[1]}; OUT = __builtin_bit_cast(bf16x8, w); } while (0)
  PK4(p0, 0, pa0); PK4(p0, 8, pa1); PK4(p1, 0, pa2); PK4(p1, 8, pa3);
#undef PK4
}
__device__ __forceinline__ void qkt(f32x16& p0, f32x16& p1, const LAS char* Ks, const bf16x8* qr, int r32, int hi) {
  p0 = f32x16{}; p1 = f32x16{};
#pragma unroll
  for (int d0 = 0; d0 < 4; ++d0) { const int cb = (d0 * 16 + hi * 8) * 2;
    const bf16x8 b0 = *(const LAS bf16x8*)(Ks + KSWZ(r32, cb));
    const bf16x8 b1 = *(const LAS bf16x8*)(Ks + KSWZ(32 + r32, cb));
    p0 = __builtin_amdgcn_mfma_f32_32x32x16_bf16(b0, qr[d0], p0, 0, 0, 0);
    p1 = __builtin_amdgcn_mfma_f32_32x32x16_bf16(b1, qr[d0], p1, 0, 0, 0); }
}
__device__ __forceinline__ int v_st(int k, int c) { const int kk = (k & ~0xC) | ((k & 4) << 1) | ((k & 8) >> 1); return ((kk >> 3) * 4 + (c >> 5)) * 512 + ((kk & 7) * 32 + (c & 31)) * 2; }
__device__ __forceinline__ int v_rd_base(int lane) { return ((lane & 3) << 3) | (((lane >> 2) & 3) << 6) | (((lane >> 4) & 1) << 5) | (((lane >> 5) & 1) << 8); }
constexpr int v_rd_off(int d0, int ks, int half) { return d0 * 512 + ks * 4096 + half * 2048; }
template <int OFF> __device__ __forceinline__ s16x4 tr_read(int vb) {
  s16x4 r; asm volatile("ds_read_b64_tr_b16 %0, %1 offset:%2" : "=&v"(r) : "v"(vb), "i"(OFF) : "memory"); return r;
}
template <int D0> __device__ __forceinline__ void pv_one(f32x16& od, int vb, bf16x8 pa0, bf16x8 pa1, bf16x8 pa2, bf16x8 pa3) {
  const s16x4 l0 = tr_read<v_rd_off(D0, 0, 0)>(vb), h0 = tr_read<v_rd_off(D0, 0, 1)>(vb), l1 = tr_read<v_rd_off(D0, 1, 0)>(vb), h1 = tr_read<v_rd_off(D0, 1, 1)>(vb);
  const s16x4 l2 = tr_read<v_rd_off(D0, 2, 0)>(vb), h2 = tr_read<v_rd_off(D0, 2, 1)>(vb), l3 = tr_read<v_rd_off(D0, 3, 0)>(vb), h3 = tr_read<v_rd_off(D0, 3, 1)>(vb);
  asm volatile("s_waitcnt lgkmcnt(0)" ::: "memory"); SBAR();
#define PK(L, H) (bf16x8){L[0], L[1], L[2], L[3], H[0], H[1], H[2], H[3]}
  od = __builtin_amdgcn_mfma_f32_32x32x16_bf16(pa0, PK(l0, h0), od, 0, 0, 0);
  od = __builtin_amdgcn_mfma_f32_32x32x16_bf16(pa1, PK(l1, h1), od, 0, 0, 0);
  od = __builtin_amdgcn_mfma_f32_32x32x16_bf16(pa2, PK(l2, h2), od, 0, 0, 0);
  od = __builtin_amdgcn_mfma_f32_32x32x16_bf16(pa3, PK(l3, h3), od, 0, 0, 0);
#undef PK
}
__device__ __forceinline__ void pv_d0(f32x16* o, int vb, bf16x8 pa0, bf16x8 pa1, bf16x8 pa2, bf16x8 pa3) {
  pv_one<0>(o[0], vb, pa0, pa1, pa2, pa3); pv_one<1>(o[1], vb, pa0, pa1, pa2, pa3); pv_one<2>(o[2], vb, pa0, pa1, pa2, pa3); pv_one<3>(o[3], vb, pa0, pa1, pa2, pa3);
}

typedef float f32x2_c __attribute__((ext_vector_type(2)));
__device__ __forceinline__ bf16x8 fp8x8_to_bf16(u32x2 raw) {
  const f32x2_c a = __builtin_amdgcn_cvt_pk_f32_fp8((int)raw.x, false), b = __builtin_amdgcn_cvt_pk_f32_fp8((int)raw.x, true), c = __builtin_amdgcn_cvt_pk_f32_fp8((int)raw.y, false), d = __builtin_amdgcn_cvt_pk_f32_fp8((int)raw.y, true);
  u32x4 w; w.x = cvt_pk_bf16(a[0], a[1]); w.y = cvt_pk_bf16(b[0], b[1]); w.z = cvt_pk_bf16(c[0], c[1]); w.w = cvt_pk_bf16(d[0], d[1]); return __builtin_bit_cast(bf16x8, w);
}
template <bool F8QK>
__device__ __forceinline__ void attn_pass(int tid, const void* __restrict__ Qb_, const void* __restrict__ Kh_, const bf16_t* __restrict__ Vh, int seq, LAS char* lds, f32x16 (&o)[4], float (&rli)[16]) {
  const bf16_t* Qb = (const bf16_t*)Qb_; const bf16_t* Kh = (const bf16_t*)Kh_; const unsigned char* Q8 = (const unsigned char*)Qb_; const unsigned char* K8 = (const unsigned char*)Kh_;
  const int wid = tid >> 6, lane = tid & 63, r32 = lane & 31, hi = lane >> 5;
  LAS char* V_lds = lds; LAS char* K_lds = lds + 2 * SHM_V;
  LAS float* ws = (LAS float*)(lds + 2 * SHM_V + 2 * SHM_K) + wid * 64; LAS float* li_l = ws; LAS float* al_l = ws + 32;
  float m_reg = -1e30f, l_reg = 0;
#pragma unroll
  for (int d = 0; d < 4; ++d) o[d] = f32x16{};
  bf16x8 qr[4];
  const long qoff = (long)(wid * QBLK + r32) * DQK + hi * 8;
#pragma unroll
  for (int d0 = 0; d0 < 4; ++d0) { if (F8QK) qr[d0] = fp8x8_to_bf16(*(const u32x2*)(Q8 + qoff + d0 * 16)); else qr[d0] = *(const bf16x8*)(Qb + qoff + d0 * 16); }
  const int sr = tid >> 4, sc = (tid & 15) * 8, vst0 = v_st(sr, sc), vst1 = v_st(32 + sr, sc);
  const int kr = tid >> 3, kc = (tid & 7) * 8, kst = KSWZ(kr, kc * 2);
  const int vb0 = (int)(uintptr_t)V_lds + v_rd_base(lane);
  struct { bf16x8 vs0, vs1, ks0; } sr_[2];
#define SLOAD(i, k0) do { sr_[i].vs0 = *(const bf16x8*)(&Vh[(long)((k0) + sr) * DV + sc]); sr_[i].vs1 = *(const bf16x8*)(&Vh[(long)((k0) + 32 + sr) * DV + sc]); \
    if (F8QK) sr_[i].ks0 = fp8x8_to_bf16(*(const u32x2*)(K8 + (long)((k0) + kr) * DQK + kc)); else sr_[i].ks0 = *(const bf16x8*)(&Kh[(long)((k0) + kr) * DQK + kc]); } while (0)
#define SWRITE(b, i) do { *(LAS bf16x8*)(V_lds + (b) * SHM_V + vst0) = sr_[i].vs0; *(LAS bf16x8*)(V_lds + (b) * SHM_V + vst1) = sr_[i].vs1; \
    *(LAS bf16x8*)(K_lds + (b) * SHM_K + kst) = sr_[i].ks0; } while (0)
#define SWAIT() asm volatile("s_waitcnt vmcnt(3)" ::: "memory")
#define RESC(a) do { if (__any((a) < 1.f)) { if (hi == 0) al_l[r32] = (a); asm volatile("s_waitcnt lgkmcnt(0)" ::: "memory"); \
    _Pragma("unroll") for (int d = 0; d < 4; ++d) _Pragma("unroll") for (int r = 0; r < 16; ++r) o[d][r] *= al_l[crow(r, hi)]; } } while (0)
  f32x16 pA0, pA1, pB0, pB1; float mnA, mnB, alA, alB; bf16x8 pa0, pa1, pa2, pa3; const int NT = seq / KVBLK;
  constexpr int SE = 0, SO = 1;
  SLOAD(SE, 0); asm volatile("s_waitcnt vmcnt(0)" ::: "memory"); SWRITE(0, SE); __syncthreads();
  qkt(pA0, pA1, K_lds, qr, r32, hi); partialSM(pA0, pA1, m_reg, mnA, alA);
  SLOAD(SO, KVBLK); if (2 < NT) SLOAD(SE, 2 * KVBLK);
  SWAIT(); SWRITE(1, SO); __syncthreads();
  for (int j = 1; j + 1 < NT; j += 2) {
    SBAR(); qkt(pB0, pB1, K_lds + SHM_K, qr, r32, hi);
    finishSM(pA0, pA1, alA, l_reg, pa0, pa1, pa2, pa3); SBAR();
    SLOAD(SO, (j + 2) * KVBLK); SBAR();
    pv_d0(o, vb0, pa0, pa1, pa2, pa3); partialSM(pB0, pB1, m_reg, mnB, alB);
    __syncthreads(); SWAIT(); SWRITE(0, SE);
    RESC(alB); __syncthreads();
    SBAR(); qkt(pA0, pA1, K_lds, qr, r32, hi);
    finishSM(pB0, pB1, alB, l_reg, pa0, pa1, pa2, pa3); SBAR();
    if (j + 3 < NT) SLOAD(SE, (j + 3) * KVBLK); SBAR();
    pv_d0(o, vb0 + SHM_V, pa0, pa1, pa2, pa3); partialSM(pA0, pA1, m_reg, mnA, alA);
    __syncthreads(); SWAIT(); SWRITE(1, SO);
    RESC(alA); __syncthreads();
  }
  SBAR(); qkt(pB0, pB1, K_lds + SHM_K, qr, r32, hi);
  finishSM(pA0, pA1, alA, l_reg, pa0, pa1, pa2, pa3); SBAR();
  pv_d0(o, vb0, pa0, pa1, pa2, pa3); partialSM(pB0, pB1, m_reg, mnB, alB);
  __syncthreads(); RESC(alB);
  finishSM(pB0, pB1, alB, l_reg, pa0, pa1, pa2, pa3); SBAR();
  pv_d0(o, vb0 + SHM_V, pa0, pa1, pa2, pa3);
  if (hi == 0) li_l[r32] = l_reg; asm volatile("s_waitcnt lgkmcnt(0)" ::: "memory");
#pragma unroll
  for (int r = 0; r < 16; ++r) rli[r] = __builtin_amdgcn_rcpf(li_l[crow(r, hi)]);
  __syncthreads();
#undef SLOAD
#undef SWRITE
#undef SWAIT
#undef RESC
}

#undef KSWZ
#undef SBAR
}
}
namespace mk {
namespace atf {
constexpr int NW = 8, KSLOT = 8192, VSLOT = 16384, NKS = 6, NVS = 5;
constexpr int LDS_K = 0, LDS_V = NKS * KSLOT, LDS_WS = 133120, LDS_FLAG = LDS_WS + NW * 64 * 4, LDS_BYTES_ATT = LDS_FLAG + 64;
#define SBAR() __builtin_amdgcn_sched_barrier(0)
#define WAIT_BAR(N) asm volatile("s_waitcnt vmcnt(" #N ") lgkmcnt(0)\n\ts_barrier" ::: "memory")
__device__ __forceinline__ int crow(int r, int hi) { return (r & 3) + 8 * (r >> 2) + 4 * hi; }
__device__ __forceinline__ void glds16(const void* gsrc, unsigned lds_dst) { unsigned keep;
  asm volatile("s_mov_b32 %0, m0\n\ts_mov_b32 m0, %2\n\ts_nop 0\n\tglobal_load_lds_dwordx4 %1, off\n\ts_mov_b32 m0, %0" : "=&s"(keep) : "v"(gsrc), "s"(lds_dst) : "memory"); }
typedef float f32x2_t __attribute__((ext_vector_type(2))); typedef __bf16 bf16x2_t __attribute__((ext_vector_type(2)));
__device__ __forceinline__ unsigned cvtpk_s(float lo, float hi) { f32x2_t v = {lo, hi}; bf16x2_t b = __builtin_convertvector(v, bf16x2_t); return __builtin_bit_cast(unsigned, b); }
typedef LAS const char* lds_cptr;
typedef short v4i16_t __attribute__((ext_vector_type(4)));
__device__ __forceinline__ s16x4 vtr(lds_cptr p) { return __builtin_bit_cast(s16x4, __builtin_amdgcn_ds_read_tr16_b64_v4i16((LAS v4i16_t*)p)); }
__device__ __forceinline__ bf16x8 kld(lds_cptr p) { return *(const LAS bf16x8*)p; }

__device__ __forceinline__ bool attn_pass_fast(unsigned long long* stamp_out, int tid, const bf16_t* __restrict__ Qb, const bf16_t* __restrict__ Kh, const bf16_t* __restrict__ Vh, int seq, LAS char* lds, f32x16 (&o)[4], float (&rli)[16]) {
  const int lane = tid & 63, r32 = lane & 31, hi = lane >> 5; const int wid = __builtin_amdgcn_readfirstlane(tid >> 6);
  const unsigned lds0 = (unsigned)(uintptr_t)lds;
  LAS float* wsf = (LAS float*)(lds + LDS_WS) + wid * 64;
  const bf16_t* ksrc = Kh + (long)lane * 64 + wid * 8;
  const bf16_t* vsrc = Vh + (long)(16 * (wid & 3) + (lane >> 2)) * 128 + (wid >> 2) * 32 + (lane & 3) * 8;
  const unsigned kdst = lds0 + LDS_K + wid * 1024, vdst = lds0 + LDS_V + wid * 1024;
#define DMA_K(t, slot) glds16(ksrc + (long)(t) * 4096, (unsigned)__builtin_amdgcn_readfirstlane(kdst + (slot)))
#define DMA_V0(t, slot) glds16(vsrc + (long)(t) * 8192, (unsigned)__builtin_amdgcn_readfirstlane(vdst + (slot)))
#define DMA_V1(t, slot) glds16(vsrc + (long)(t) * 8192 + 64, (unsigned)__builtin_amdgcn_readfirstlane(vdst + (slot) + 8192))
#define DMA_V(t, slot) do { glds16(vsrc + (long)(t) * 8192, (unsigned)__builtin_amdgcn_readfirstlane(vdst + (slot))); glds16(vsrc + (long)(t) * 8192 + 64, (unsigned)__builtin_amdgcn_readfirstlane(vdst + (slot) + 8192)); } while (0)
  const lds_cptr shm3 = (lds_cptr)lds; const lds_cptr kp0 = shm3 + LDS_K + hi * 1024 + r32 * 16;
  const lds_cptr vp0 = shm3 + LDS_V + ((lane >> 4) & 1) * 32 + (lane & 3) * 8 + (4 * hi + ((lane & 15) >> 2)) * 64;
  const int NT = seq / 64;
  DMA_K(0, 0); DMA_V(0, 0); DMA_K(1, KSLOT); DMA_K(2, 2 * KSLOT); DMA_K(3, 3 * KSLOT); DMA_V(1, VSLOT);
  bf16x8 qr[4];
  { const bf16_t* Qw = Qb + (long)(wid * 32 + r32) * 64 + hi * 8;
#pragma unroll
    for (int d0 = 0; d0 < 4; ++d0) qr[d0] = *(const bf16x8*)(Qw + d0 * 16); }
#pragma unroll
  for (int d = 0; d < 4; ++d) o[d] = f32x16{};
  float l_reg = 0.f; f32x16 negm = f32x16{};
  asm volatile("s_waitcnt vmcnt(0)" ::: "memory");
  WAIT_BAR(0);
  f32x16 pA0, pA1, pB0, pB1;
  bf16x8 kfA[4], kfB[4];
  { f32x16 c0 = f32x16{}, c1 = f32x16{};
#pragma unroll
    for (int d0 = 0; d0 < 4; ++d0) { c0 = __builtin_amdgcn_mfma_f32_32x32x16_bf16(kld(kp0 + d0 * 2048), qr[d0], c0, 0, 0, 0); c1 = __builtin_amdgcn_mfma_f32_32x32x16_bf16(kld(kp0 + d0 * 2048 + 512), qr[d0], c1, 0, 0, 0); }
    float m = c0[0];
#pragma unroll
    for (int r = 1; r < 16; ++r) m = fmaxf(m, c0[r]);
#pragma unroll
    for (int r = 0; r < 16; ++r) m = fmaxf(m, c1[r]);
    { auto rr = __builtin_amdgcn_permlane32_swap(__float_as_uint(m), __float_as_uint(m), false, false); m = fmaxf(__uint_as_float(rr[0]), __uint_as_float(rr[1])); }
#pragma unroll
    for (int r = 0; r < 16; ++r) negm[r] = -m;
    asm volatile("" : "+v"(negm)); }
#pragma unroll
  for (int d0 = 0; d0 < 4; ++d0) { pA0 = __builtin_amdgcn_mfma_f32_32x32x16_bf16(kld(kp0 + d0 * 2048), qr[d0], d0 == 0 ? negm : pA0, 0, 0, 0); pA1 = __builtin_amdgcn_mfma_f32_32x32x16_bf16(kld(kp0 + d0 * 2048 + 512), qr[d0], d0 == 0 ? negm : pA1, 0, 0, 0); }
#pragma unroll
  for (int r = 0; r < 16; ++r) { pA0[r] = __builtin_amdgcn_exp2f(pA0[r]); pA1[r] = __builtin_amdgcn_exp2f(pA1[r]); }
  if (4 < NT) DMA_K(4, 4 * KSLOT);
  if (2 < NT) DMA_V(2, 2 * VSLOT);
#pragma unroll
  for (int d0 = 0; d0 < 4; ++d0) kfA[d0] = kld(kp0 + KSLOT + d0 * 2048);
  WAIT_BAR(0);
  u32x4 pw0, pw1, pw2, pw3; s16x4 vl[4], vh[4];
#define PKW(P, B) cvtpk_s(P[B], P[B + 1])
#define PAF(k) __builtin_bit_cast(bf16x8, pw##k)
#define VFR(i) (bf16x8){vl[i][0], vl[i][1], vl[i][2], vl[i][3], vh[i][0], vh[i][1], vh[i][2], vh[i][3]}
#define PIN(x) asm volatile("" : "+v"(x))
#define GAPA(MF, A0, A1, A2, A3, W0, W1, PW) do { MF; sacc += A0; sacc += A1; sacc += A2; sacc += A3; PIN(sacc); W0; W1; PIN(PW); SBAR(); } while (0)
#define EX(v) __builtin_amdgcn_exp2f(v)
#define GAPB(MF, X, B) do { MF; X[B] = EX(X[B]); X[B + 1] = EX(X[B + 1]); PIN(X); SBAR(); } while (0)
#define VRD(i, f) do { vl[i] = vtr(vp_ + (f) * 1024); vh[i] = vtr(vp_ + (f) * 1024 + 512); } while (0)
#define STEP(C0, C1, P0, P1, t, svp, svn, GK, GV, GL) do { SBAR(); \
    const lds_cptr kq_ = kp0 + k_0; const lds_cptr kn_ = kp0 + k_1; const lds_cptr vp_ = vp0 + (svp); \
    kfB[0] = kld(kq_ + 512); kfB[1] = kld(kq_ + 2048 + 512); SBAR(); float sacc = (P0[0] + P0[1]); \
    GAPA(C0 = __builtin_amdgcn_mfma_f32_32x32x16_bf16(kfA[0], qr[0], negm, 0, 0, 0), P0[2], P0[3], P0[4], P0[5],     pw0[0] = PKW(P0, 0), pw0[1] = PKW(P0, 2), pw0); \
    kfB[2] = kld(kq_ + 4096 + 512); kfB[3] = kld(kq_ + 6144 + 512); SBAR(); \
    GAPA(C0 = __builtin_amdgcn_mfma_f32_32x32x16_bf16(kfA[1], qr[1], C0, 0, 0, 0),   P0[6], P0[7], P0[8], P0[9],     pw0[2] = PKW(P0, 4), pw0[3] = PKW(P0, 6), pw0); \
    VRD(0, 0); SBAR(); \
    GAPA(C0 = __builtin_amdgcn_mfma_f32_32x32x16_bf16(kfA[2], qr[2], C0, 0, 0, 0),   P0[10], P0[11], P0[12], P0[13], pw1[0] = PKW(P0, 8), pw1[1] = PKW(P0, 10), pw1); \
    VRD(1, 1); SBAR(); \
    GAPA(C0 = __builtin_amdgcn_mfma_f32_32x32x16_bf16(kfA[3], qr[3], C0, 0, 0, 0),   P0[14], P0[15], P1[0], P1[1],   pw1[2] = PKW(P0, 12), pw1[3] = PKW(P0, 14), pw1); \
    VRD(2, 2); SBAR(); \
    GAPA(C1 = __builtin_amdgcn_mfma_f32_32x32x16_bf16(kfB[0], qr[0], negm, 0, 0, 0), P1[2], P1[3], P1[4], P1[5],     pw2[0] = PKW(P1, 0), pw2[1] = PKW(P1, 2), pw2); \
    VRD(3, 3); SBAR(); \
    GAPA(C1 = __builtin_amdgcn_mfma_f32_32x32x16_bf16(kfB[1], qr[1], C1, 0, 0, 0),   P1[6], P1[7], P1[8], P1[9],     pw2[2] = PKW(P1, 4), pw2[3] = PKW(P1, 6), pw2); \
    GAPA(C1 = __builtin_amdgcn_mfma_f32_32x32x16_bf16(kfB[2], qr[2], C1, 0, 0, 0),   P1[10], P1[11], P1[12], P1[13], pw3[0] = PKW(P1, 8), pw3[1] = PKW(P1, 10), pw3); \
    GAPA(C1 = __builtin_amdgcn_mfma_f32_32x32x16_bf16(kfB[3], qr[3], C1, 0, 0, 0),   P1[14], P1[15], 0.f, 0.f,       pw3[2] = PKW(P1, 12), pw3[3] = PKW(P1, 14), pw3); \
    l_reg += sacc; \
    if (GK) { DMA_K((t) + 4, k_m2); } if (GV) { DMA_V((t) + 2, (svn)); } \
    SBAR(); \
    GAPB(o[0] = __builtin_amdgcn_mfma_f32_32x32x16_bf16(PAF(0), VFR(0), o[0], 0, 0, 0), C0, 0);  VRD(0, 4); SBAR(); \
    GAPB(o[0] = __builtin_amdgcn_mfma_f32_32x32x16_bf16(PAF(1), VFR(1), o[0], 0, 0, 0), C0, 2);  VRD(1, 5); SBAR(); \
    GAPB(o[0] = __builtin_amdgcn_mfma_f32_32x32x16_bf16(PAF(2), VFR(2), o[0], 0, 0, 0), C0, 4);  VRD(2, 6); SBAR(); \
    GAPB(o[0] = __builtin_amdgcn_mfma_f32_32x32x16_bf16(PAF(3), VFR(3), o[0], 0, 0, 0), C0, 6);  VRD(3, 7); SBAR(); \
    GAPB(o[1] = __builtin_amdgcn_mfma_f32_32x32x16_bf16(PAF(0), VFR(0), o[1], 0, 0, 0), C0, 8);  VRD(0, 8); SBAR(); \
    GAPB(o[1] = __builtin_amdgcn_mfma_f32_32x32x16_bf16(PAF(1), VFR(1), o[1], 0, 0, 0), C0, 10); VRD(1, 9); SBAR(); \
    GAPB(o[1] = __builtin_amdgcn_mfma_f32_32x32x16_bf16(PAF(2), VFR(2), o[1], 0, 0, 0), C0, 12); VRD(2, 10); SBAR(); \
    GAPB(o[1] = __builtin_amdgcn_mfma_f32_32x32x16_bf16(PAF(3), VFR(3), o[1], 0, 0, 0), C0, 14); VRD(3, 11); SBAR(); \
    GAPB(o[2] = __builtin_amdgcn_mfma_f32_32x32x16_bf16(PAF(0), VFR(0), o[2], 0, 0, 0), C1, 0);  VRD(0, 12); SBAR(); \
    GAPB(o[2] = __builtin_amdgcn_mfma_f32_32x32x16_bf16(PAF(1), VFR(1), o[2], 0, 0, 0), C1, 2);  VRD(1, 13); SBAR(); \
    GAPB(o[2] = __builtin_amdgcn_mfma_f32_32x32x16_bf16(PAF(2), VFR(2), o[2], 0, 0, 0), C1, 4);  VRD(2, 14); SBAR(); \
    GAPB(o[2] = __builtin_amdgcn_mfma_f32_32x32x16_bf16(PAF(3), VFR(3), o[2], 0, 0, 0), C1, 6);  VRD(3, 15); SBAR(); \
    if (GL) { kfA[0] = kld(kn_); kfA[1] = kld(kn_ + 2048); SBAR(); } \
    GAPB(o[3] = __builtin_amdgcn_mfma_f32_32x32x16_bf16(PAF(0), VFR(0), o[3], 0, 0, 0), C1, 8); \
    GAPB(o[3] = __builtin_amdgcn_mfma_f32_32x32x16_bf16(PAF(1), VFR(1), o[3], 0, 0, 0), C1, 10); \
    if (GL) { kfA[2] = kld(kn_ + 4096); kfA[3] = kld(kn_ + 6144); SBAR(); } \
    GAPB(o[3] = __builtin_amdgcn_mfma_f32_32x32x16_bf16(PAF(2), VFR(2), o[3], 0, 0, 0), C1, 12); \
    GAPB(o[3] = __builtin_amdgcn_mfma_f32_32x32x16_bf16(PAF(3), VFR(3), o[3], 0, 0, 0), C1, 14); \
  } while (0)
  int svn = 4 * VSLOT, sv_m2 = 3 * VSLOT, svp = 0, svc = VSLOT, svc1 = 2 * VSLOT;
  int k_m2 = 5 * KSLOT, k_m1 = 0, k_0 = KSLOT, k_1 = 2 * KSLOT, k_2 = 3 * KSLOT, k_3 = 4 * KSLOT;
#define ROT() do { const int tmp_ = svn; svn = sv_m2; sv_m2 = svp; svp = svc; svc = svc1; svc1 = tmp_; const int tk_ = k_m2; k_m2 = k_m1; k_m1 = k_0; k_0 = k_1; k_1 = k_2; k_2 = k_3; k_3 = tk_; } while (0)
  int t = 1;
#ifdef MK_STAMP
  unsigned long long st_c0 = 0, st_r0 = 0; if (stamp_out) { st_c0 = __builtin_amdgcn_s_memtime(); st_r0 = __builtin_amdgcn_s_memrealtime(); }
#endif
#if defined(MK_STAMP) && MK_STAMP == 4
  unsigned long long st_bar = 0;
#define TWAIT_BAR3() do { const unsigned long long b0_ = __builtin_amdgcn_s_memtime(); WAIT_BAR(3); const unsigned long long b1_ = __builtin_amdgcn_s_memtime(); asm volatile("s_waitcnt lgkmcnt(0)" ::: "memory"); st_bar += b1_ - b0_; } while (0)
#else
#define TWAIT_BAR3() WAIT_BAR(3)
#endif
  for (; t + 5 < NT; t += 2) {
    STEP(pB0, pB1, pA0, pA1, t, svp, svn, true, true, true);     ROT();
    STEP(pA0, pA1, pB0, pB1, t + 1, svp, svn, true, true, true); TWAIT_BAR3(); ROT();
  }
#if defined(MK_STAMP) && MK_STAMP == 4
  if (stamp_out) stamp_out[4] = st_bar;
#endif
#ifdef MK_STAMP
  if (stamp_out) { const unsigned long long c1 = __builtin_amdgcn_s_memtime(), r1 = __builtin_amdgcn_s_memrealtime(); stamp_out[0] = c1 - st_c0; stamp_out[1] = r1 - st_r0; stamp_out[2] = (unsigned long long)(t - 1); }
#endif
  for (; t + 1 < NT; t += 2) {
    STEP(pB0, pB1, pA0, pA1, t, svp, svn, (t + 4 < NT), (t + 2 < NT), (t + 1 < NT));       WAIT_BAR(0); ROT();
    STEP(pA0, pA1, pB0, pB1, t + 1, svp, svn, (t + 5 < NT), (t + 3 < NT), (t + 2 < NT));   WAIT_BAR(0); ROT();
  }
  STEP(pB0, pB1, pA0, pA1, NT - 1, svp, svn, false, false, false); ROT();
  { float sacc = pB0[0] + pB0[1];
#pragma unroll
    for (int r = 2; r < 16; ++r) sacc += pB0[r];
#pragma unroll
    for (int r = 0; r < 16; ++r) sacc += pB1[r];
    l_reg += sacc;
    pw0 = (u32x4){PKW(pB0, 0), PKW(pB0, 2), PKW(pB0, 4), PKW(pB0, 6)}; pw1 = (u32x4){PKW(pB0, 8), PKW(pB0, 10), PKW(pB0, 12), PKW(pB0, 14)};
    pw2 = (u32x4){PKW(pB1, 0), PKW(pB1, 2), PKW(pB1, 4), PKW(pB1, 6)}; pw3 = (u32x4){PKW(pB1, 8), PKW(pB1, 10), PKW(pB1, 12), PKW(pB1, 14)};
    WAIT_BAR(0);
    const lds_cptr vp_ = vp0 + svp;
#pragma unroll
    for (int d0 = 0; d0 < 4; ++d0) { VRD(0, 4 * d0); VRD(1, 4 * d0 + 1); VRD(2, 4 * d0 + 2); VRD(3, 4 * d0 + 3);
      o[d0] = __builtin_amdgcn_mfma_f32_32x32x16_bf16(PAF(0), VFR(0), o[d0], 0, 0, 0); o[d0] = __builtin_amdgcn_mfma_f32_32x32x16_bf16(PAF(1), VFR(1), o[d0], 0, 0, 0);
      o[d0] = __builtin_amdgcn_mfma_f32_32x32x16_bf16(PAF(2), VFR(2), o[d0], 0, 0, 0); o[d0] = __builtin_amdgcn_mfma_f32_32x32x16_bf16(PAF(3), VFR(3), o[d0], 0, 0, 0); } }
  { auto rr = __builtin_amdgcn_permlane32_swap(__float_as_uint(l_reg), __float_as_uint(l_reg), false, false); l_reg = __uint_as_float(rr[0]) + __uint_as_float(rr[1]); }
  const bool bad = __any(!(l_reg > 1e-30f && l_reg < 1e30f));
  LAS int* flag = (LAS int*)(lds + LDS_FLAG);
  if (hi == 0) wsf[32 + r32] = l_reg;
  if (lane == 0) flag[wid] = bad ? 1 : 0;
  WAIT_BAR(0);
#pragma unroll
  for (int r = 0; r < 16; ++r) rli[r] = __builtin_amdgcn_rcpf(wsf[32 + crow(r, hi)]);
  int anybad = 0;
#pragma unroll
  for (int w = 0; w < 8; ++w) anybad |= flag[w];
  WAIT_BAR(0);
#ifdef MK_FORCE_FALLBACK
  return false;
#else
  return anybad == 0;
#endif
#undef DMA_K
#undef DMA_V
#undef DMA_V0
#undef DMA_V1
#undef PKW
#undef PAF
#undef VFR
#undef PIN
#undef GAPA
#undef EX
#undef GAPB
#undef VRD
#undef STEP
#undef ROT
}
#undef SBAR
#undef WAIT_BAR
}
}

namespace mk {
namespace at8 {
constexpr int KS8 = 4096, VS8 = 8192, NKS = 8, NVS = 8, LDS_K = 0, LDS_V = NKS * KS8;
constexpr int DK = 6, DV = 4;
constexpr float P_OFF = 2.f;
#define SBAR() __builtin_amdgcn_sched_barrier(0)
#define WAIT_BAR(N) asm volatile("s_waitcnt vmcnt(" #N ") lgkmcnt(0)\n\ts_barrier" ::: "memory")
typedef LAS const char* lds_cptr;
__device__ __forceinline__ v4i_t ld16(lds_cptr p) { return *(const LAS v4i_t*)p; }
__device__ __forceinline__ v8i_t cat8(v4i_t a, v4i_t b) { return __builtin_shufflevector(a, b, 0, 1, 2, 3, 4, 5, 6, 7); }
#define MF8(A, B, C, SA, SB) __builtin_amdgcn_mfma_scale_f32_32x32x64_f8f6f4(A, B, C, 0, 0, 0, SA, 0, SB)

template <class Pre>
__device__ __forceinline__ bool attn_pass_fp8(int tid, const unsigned char* __restrict__ Q8b, const unsigned char* __restrict__ K8h, const unsigned char* __restrict__ V8h, int seq, LAS char* lds, f32x16 (&o)[4], float (&rli)[16], Pre&& pre) {
  const int lane = tid & 63, r32 = lane & 31, hi = lane >> 5; const int wid = __builtin_amdgcn_readfirstlane(tid >> 6);
  const unsigned lds0 = (unsigned)(uintptr_t)lds;
  const unsigned char* ksrc = K8h + (long)lane * 64 + (wid & 3) * 16;
  const unsigned char* vsrc = V8h + wid * 1024 + lane * 16;
  const unsigned kdst = lds0 + LDS_K + (wid & 3) * 1024, vdst = lds0 + LDS_V + wid * 1024;
#define DMA_K(t, slot) atf::glds16(ksrc + (long)(t) * 4096, (unsigned)__builtin_amdgcn_readfirstlane(kdst + (slot)))
#define DMA_V(t, slot) atf::glds16(vsrc + (long)(t) * 8192, (unsigned)__builtin_amdgcn_readfirstlane(vdst + (slot)))
  const lds_cptr shm3 = (lds_cptr)lds; const lds_cptr kp0 = shm3 + LDS_K + hi * 2048 + r32 * 16; const lds_cptr vp0 = shm3 + LDS_V + hi * 4096 + r32 * 16;
  const int NT = seq / 64;
  DMA_K(0, 0); DMA_V(0, 0); DMA_K(1, KS8); DMA_V(1, VS8); DMA_K(2, 2 * KS8); DMA_K(3, 3 * KS8); DMA_V(2, 2 * VS8); DMA_K(4, 4 * KS8); DMA_V(3, 3 * VS8); DMA_K(5, 5 * KS8);
  v8i_t qf;
  { const unsigned char* Qw = Q8b + (long)(wid * 32 + r32) * 64 + hi * 32; qf = cat8(*(const v4i_t*)Qw, *(const v4i_t*)(Qw + 16)); }
  pre();
#pragma unroll
  for (int d = 0; d < 4; ++d) o[d] = f32x16{};
  f32x16 lacc = f32x16{}, negm = f32x16{};
  int one_ = 0x38383838; asm volatile("" : "+v"(one_));
  const v8i_t ones = {one_, one_, one_, one_, one_, one_, one_, one_};
  constexpr int SK = 0, SQ = 0, S1 = 0;
  asm volatile("s_waitcnt vmcnt(0)" ::: "memory");
  WAIT_BAR(0);
  f32x16 pA0, pA1, pB0, pB1;
  v8i_t kfA, kfB;
#define KLD(p) cat8(ld16(p), ld16((p) + 1024))
  { kfA = KLD(kp0); kfB = KLD(kp0 + 512);
    const f32x16 c0 = MF8(kfA, qf, f32x16{}, SK, SQ), c1 = MF8(kfB, qf, f32x16{}, SK, SQ);
    float m = c0[0];
#pragma unroll
    for (int r = 1; r < 16; ++r) m = fmaxf(m, c0[r]);
#pragma unroll
    for (int r = 0; r < 16; ++r) m = fmaxf(m, c1[r]);
    { auto rr = __builtin_amdgcn_permlane32_swap(__float_as_uint(m), __float_as_uint(m), false, false); m = fmaxf(__uint_as_float(rr[0]), __uint_as_float(rr[1])); }
#pragma unroll
    for (int r = 0; r < 16; ++r) negm[r] = P_OFF - m;
    asm volatile("" : "+v"(negm));
    pA0 = MF8(kfA, qf, negm, SK, SQ); pA1 = MF8(kfB, qf, negm, SK, SQ); }
#pragma unroll
  for (int r = 0; r < 16; ++r) { pA0[r] = __builtin_amdgcn_exp2f(pA0[r]); pA1[r] = __builtin_amdgcn_exp2f(pA1[r]); }
  if (DK < NT) DMA_K(DK, DK * KS8);
  if (DV < NT) DMA_V(DV, DV * VS8);
  kfA = KLD(kp0 + KS8);
  WAIT_BAR(0);
  v8i_t pw = {0, 0, 0, 0, 0, 0, 0, 0}, vf0, vf1, vf2, vf3;
#define PIN(x) asm volatile("" : "+v"(x))
#define PK4D(W, P0_, P1_, D) do { W = __builtin_amdgcn_cvt_pk_fp8_f32(P0_[D], P0_[(D) + 8], W, false); W = __builtin_amdgcn_cvt_pk_fp8_f32(P1_[D], P1_[(D) + 8], W, true); } while (0)
#define EX(v) __builtin_amdgcn_exp2f(v)
#define EX8(X, B) do { X[B] = EX(X[B]); X[B + 1] = EX(X[B + 1]); X[B + 2] = EX(X[B + 2]); X[B + 3] = EX(X[B + 3]); X[B + 4] = EX(X[B + 4]); X[B + 5] = EX(X[B + 5]); X[B + 6] = EX(X[B + 6]); X[B + 7] = EX(X[B + 7]); PIN(X); } while (0)
#define VLD(d0) cat8(ld16(vp_ + (d0) * 512), ld16(vp_ + (d0) * 512 + 2048))
#ifdef AT8_LSUM_VALU
  float l_reg = 0.f;
#define LSUM_STEP(P0, P1) do { float s0_ = (P0[0] + P0[1]) + (P0[2] + P0[3]), s1_ = (P1[0] + P1[1]) + (P1[2] + P1[3]); \
    s0_ += (P0[4] + P0[5]) + (P0[6] + P0[7]); s1_ += (P1[4] + P1[5]) + (P1[6] + P1[7]); s0_ += (P0[8] + P0[9]) + (P0[10] + P0[11]); s1_ += (P1[8] + P1[9]) + (P1[10] + P1[11]); \
    s0_ += (P0[12] + P0[13]) + (P0[14] + P0[15]); s1_ += (P1[12] + P1[13]) + (P1[14] + P1[15]); l_reg += s0_ + s1_; } while (0)
#else
#define LSUM_STEP(P0, P1) lacc = MF8(pw, ones, lacc, S1, S1)
#endif
#define KSL(x) ((((x)) & 7) * KS8)
#define VSL(x) ((((x)) & 7) * VS8)
#define STEP(C0, C1, P0, P1, t, GK, GV, GL) do { SBAR(); \
    const lds_cptr kq_ = kp0 + KSL(t); const lds_cptr kn_ = kp0 + KSL((t) + 1); const lds_cptr vp_ = vp0 + VSL((t) - 1); \
    kfB = KLD(kq_ + 512); vf0 = VLD(0); SBAR(); \
    C0 = MF8(kfA, qf, negm, SK, SQ); \
    PK4D(pw[0], P0, P1, 0); PK4D(pw[1], P0, P1, 1); PK4D(pw[2], P0, P1, 2); PK4D(pw[3], P0, P1, 3); PIN(pw); vf1 = VLD(1); SBAR(); \
    C1 = MF8(kfB, qf, negm, SK, SQ); \
    PK4D(pw[4], P0, P1, 4); PK4D(pw[5], P0, P1, 5); PK4D(pw[6], P0, P1, 6); PK4D(pw[7], P0, P1, 7); PIN(pw); vf2 = VLD(2); vf3 = VLD(3); \
    if (GK) { DMA_K((t) + DK, KSL((t) + DK)); } if (GV) { DMA_V((t) + DV, VSL((t) + DV)); } \
    SBAR(); \
    o[0] = MF8(pw, vf0, o[0], S1, S1); EX8(C0, 0); SBAR(); \
    o[1] = MF8(pw, vf1, o[1], S1, S1); EX8(C0, 8); SBAR(); \
    o[2] = MF8(pw, vf2, o[2], S1, S1); EX8(C1, 0); SBAR(); \
    if (GL) { kfA = KLD(kn_); SBAR(); } \
    o[3] = MF8(pw, vf3, o[3], S1, S1); EX8(C1, 8); SBAR(); \
    LSUM_STEP(P0, P1); \
  } while (0)
  int t = 1;
  for (; t + 1 + DK < NT; t += 2) {
    STEP(pB0, pB1, pA0, pA1, t, true, true, true);
    STEP(pA0, pA1, pB0, pB1, t + 1, true, true, true); WAIT_BAR(6);
  }
  for (; t + 1 < NT; t += 2) {
    STEP(pB0, pB1, pA0, pA1, t, (t + DK < NT), (t + DV < NT), (t + 1 < NT));           WAIT_BAR(0);
    STEP(pA0, pA1, pB0, pB1, t + 1, (t + 1 + DK < NT), (t + 1 + DV < NT), (t + 2 < NT));   WAIT_BAR(0);
  }
  STEP(pB0, pB1, pA0, pA1, NT - 1, false, false, false);
  { PK4D(pw[0], pB0, pB1, 0); PK4D(pw[1], pB0, pB1, 1); PK4D(pw[2], pB0, pB1, 2); PK4D(pw[3], pB0, pB1, 3); PK4D(pw[4], pB0, pB1, 4); PK4D(pw[5], pB0, pB1, 5); PK4D(pw[6], pB0, pB1, 6); PK4D(pw[7], pB0, pB1, 7);
    WAIT_BAR(0);
    const lds_cptr vp_ = vp0 + VSL(NT - 1);
    vf0 = VLD(0); vf1 = VLD(1); vf2 = VLD(2); vf3 = VLD(3);
    o[0] = MF8(pw, vf0, o[0], S1, S1); o[1] = MF8(pw, vf1, o[1], S1, S1); o[2] = MF8(pw, vf2, o[2], S1, S1); o[3] = MF8(pw, vf3, o[3], S1, S1); LSUM_STEP(pB0, pB1); }
  float chk = 0.f; bool bad = false;
#ifdef AT8_LSUM_VALU
  { auto rr = __builtin_amdgcn_permlane32_swap(__float_as_uint(l_reg), __float_as_uint(l_reg), false, false); l_reg = __uint_as_float(rr[0]) + __uint_as_float(rr[1]);
    LAS float* wsf = (LAS float*)(lds + atf::LDS_WS) + wid * 64; if (hi == 0) wsf[32 + r32] = l_reg; asm volatile("s_waitcnt lgkmcnt(0)" ::: "memory");
#pragma unroll
    for (int r = 0; r < 16; ++r) lacc[r] = wsf[32 + atf::crow(r, hi)]; }
#endif
#pragma unroll
  for (int r = 0; r < 16; ++r) { bad |= !(lacc[r] > 1e-30f && lacc[r] < 1e30f); rli[r] = __builtin_amdgcn_rcpf(lacc[r]); chk += (fabsf(o[0][r]) + fabsf(o[1][r])) + (fabsf(o[2][r]) + fabsf(o[3][r])); }
  bad |= !(chk < 1e30f);
  LAS int* flag = (LAS int*)(lds + atf::LDS_FLAG);
  if (lane == 0) flag[wid] = __any(bad) ? 1 : 0;
  else (void)__any(bad);
  WAIT_BAR(0);
  int anybad = 0;
#pragma unroll
  for (int w = 0; w < 8; ++w) anybad |= flag[w];
  WAIT_BAR(0);
#ifdef MK_FORCE_FALLBACK
  return false;
#else
  return anybad == 0;
#endif
#undef DMA_K
#undef DMA_V
#undef KLD
#undef PIN
#undef PK4D
#undef EX
#undef EX8
#undef VLD
#undef STEP
#undef KSL
#undef VSL
#undef LSUM_STEP
}
#undef MF8
#undef SBAR
#undef WAIT_BAR
}
}

namespace mk {
namespace att2 {
__device__ __forceinline__ void attn_unit(int h, int qb, const unsigned char* ws, const float* __restrict__ subg, float* stash, const unsigned char* q8, const unsigned char* k8, const unsigned char* v8, LAS char* lds) {
  const bf16_t* Q = (const bf16_t*)(ws + WS_Q); const bf16_t* K = (const bf16_t*)(ws + WS_K); const bf16_t* V = (const bf16_t*)(ws + WS_V);
  f32x16 o[4]; float rli[16];
#ifdef MK_STAMP
  unsigned long long u_c0 = __builtin_amdgcn_s_memtime();
#endif
  { int tid = threadIdx.x; asm volatile("" : "+v"(tid));
    if (!atf::attn_pass_fast((blockIdx.x == 0 && tid == 0) ? (unsigned long long*)(ws + WS_SMALL + 16384) : nullptr, tid, Q + ((size_t)(2 * h) * T + (size_t)qb * 256) * 64, K + (size_t)(2 * h) * T * 64, V + (size_t)h * T * 128, T, lds, o, rli))
      att::attn_pass<false>(tid, Q + ((size_t)(2 * h) * T + (size_t)qb * 256) * 64, K + (size_t)(2 * h) * T * 64, V + (size_t)h * T * 128, T, lds, o, rli); }
  { int tid = threadIdx.x; asm volatile("" : "+v"(tid));
    auto stash_o1 = [&]() { int tid2 = threadIdx.x; asm volatile("" : "+v"(tid2));
      float* st = stash + (size_t)(tid2 >> 6) * 4096 + (tid2 & 63);
      asm volatile("" : "+v"(st) :: "memory");
#pragma unroll
      for (int d = 0; d < 4; ++d)
#pragma unroll
        for (int r = 0; r < 16; ++r) st[(d * 16 + r) * 64] = o[d][r] * rli[r];
      asm volatile("" ::: "memory"); __builtin_amdgcn_sched_barrier(0); };
    if (!at8::attn_pass_fp8(tid, q8 + ((size_t)h * T + (size_t)qb * 256) * 64, k8 + (size_t)h * T * 64, v8 + (size_t)h * (256 * 8192), T, lds, o, rli, stash_o1))
      att::attn_pass<true>(tid, q8 + ((size_t)h * T + (size_t)qb * 256) * 64, k8 + (size_t)h * T * 64, V + (size_t)h * T * 128, T, lds, o, rli); }
  int tid = threadIdx.x; asm volatile("" : "+v"(tid));
  const int wid = tid >> 6, lane = tid & 63, r32 = lane & 31, hi = lane >> 5;
  const float lam = *(const float*)(ws + WS_SMALL);
  float* st = stash + (size_t)wid * 4096 + lane;
  asm volatile("" : "+v"(st) :: "memory");
  float ss[16];
#pragma unroll
  for (int r = 0; r < 16; ++r) ss[r] = 0.f;
#pragma unroll
  for (int d = 0; d < 4; ++d) {
#pragma unroll
    for (int r = 0; r < 16; ++r) { const float a = st[(d * 16 + r) * 64] - lam * (o[d][r] * rli[r]); o[d][r] = a; ss[r] += a * a; }
    asm volatile("" ::: "memory"); __builtin_amdgcn_sched_barrier(0); }
#pragma unroll
  for (int r = 0; r < 16; ++r) { float s = ss[r]; s += __shfl_xor(s, 1); s += __shfl_xor(s, 2); s += __shfl_xor(s, 4); s += __shfl_xor(s, 8); s += __shfl_xor(s, 16);
    ss[r] = 0.8f / sqrtf(s * (1.f / 128.f) + 1e-5f); }
  bf16_t* mix = (bf16_t*)(ws + WS_XN);
#pragma unroll
  for (int d = 0; d < 4; ++d) { const float g = subg[d * 32 + r32];
#pragma unroll
    for (int r = 0; r < 16; ++r) { const int t = qb * 256 + wid * 32 + att::crow(r, hi);
      mix[(size_t)t * DM + h * 128 + d * 32 + r32] = (bf16_t)(cvt_pk_bf16(o[d][r] * ss[r] * g, 0.f) & 0xffffu); } }
#ifdef MK_STAMP
  asm volatile("s_waitcnt vmcnt(0)" ::: "memory");
  if (blockIdx.x == 0 && tid == 0) ((unsigned long long*)(ws + WS_SMALL + 16384))[3] = __builtin_amdgcn_s_memtime() - u_c0;
#endif
}
}
}
namespace mk {
namespace hg {
constexpr int C = 64, LSC = 512, NCH = LSC / C, NSC = T / LSC;
constexpr int L_QT = 0, L_KT = 16384, L_KH = 32768, L_VT = 49152, L_GB = 65536  , L_AT = 98304  ,
              L_SEG = 106496  , L_DL = 108544  , L_END = 109056;
__device__ __forceinline__ int crow(int r, int hi) { return (r & 3) + 8 * (r >> 2) + 4 * hi; }
__device__ __forceinline__ unsigned off_b(unsigned row, unsigned ch) { return 256u * row + 16u * (ch ^ (((row & 3) << 2) | ((row >> 2) & 3))); }
__device__ __forceinline__ unsigned row_read_addr(unsigned lane, unsigned s) { return off_b(lane & 31, 2 * s + (lane >> 5)); }
__device__ __forceinline__ unsigned tr_read_addr(unsigned lane, unsigned c, unsigned ks, unsigned t) {
  const unsigned h = lane >> 5, blk = (lane >> 4) & 1, q = (lane & 15) >> 2, p = lane & 3;
  return off_b(16 * ks + 8 * h + 4 * t + q, 4 * c + 2 * blk + (p >> 1)) + 8 * (p & 1);
}
__device__ __forceinline__ s16x4 trd(const LAS unsigned char* p) { typedef short v4i16_t __attribute__((ext_vector_type(4))); return __builtin_bit_cast(s16x4, __builtin_amdgcn_ds_read_tr16_b64_v4i16((LAS v4i16_t*)p)); }
__device__ __forceinline__ bf16x8 tr_frag(const LAS unsigned char* img, unsigned lane, unsigned c, unsigned kk) {
  const LAS unsigned char* base = img + 8192u * (kk >> 1);
  const s16x4 lo = trd(base + tr_read_addr(lane, c, kk & 1, 0)), hi = trd(base + tr_read_addr(lane, c, kk & 1, 1));
  return (bf16x8){lo[0], lo[1], lo[2], lo[3], hi[0], hi[1], hi[2], hi[3]};
}
__device__ __forceinline__ bf16x8 row_frag(const LAS unsigned char* img, unsigned lane, unsigned rt, unsigned s) {
  return *(const LAS bf16x8*)(img + 8192u * rt + row_read_addr(lane, s));
}
__device__ __forceinline__ unsigned at_off(unsigned row, unsigned chunk) { return row * 128u + ((chunk ^ ((row >> 1) & 7u)) << 4); }


constexpr int BG_ITEMS = 3 * 16384;
struct BgItem { const float* src; unsigned char* dst; int ldw, kdst; };
__device__ __forceinline__ BgItem bg_decode(int id, const float* wg, const float* wu, const float* wd, unsigned char* ws) {
  BgItem it;
  if (id < 32768) { const int which = id >> 14, r = id & 16383, e = r >> 9, rem = r & 511, kb = rem >> 4, nb = rem & 15, f0 = 32 * nb;
    it.src = (which ? wu : wg) + (size_t)e * DM * FE + (size_t)(32 * kb) * FE + f0; it.ldw = FE;
    it.dst = ws + WS_WGU + (size_t)e * 1024 * DM + (size_t)((f0 >> 7) * 256 + which * 128 + (f0 & 127)) * DM + 32 * kb; it.kdst = DM;
  } else { const int r = id - 32768, e = r >> 9, rem = r & 511, kb = rem >> 5, nb = rem & 31;
    it.src = wd + (size_t)e * FE * DM + (size_t)(32 * kb) * DM + 32 * nb; it.ldw = DM;
    it.dst = ws + WS_WD + (size_t)e * DM * FE + (size_t)(32 * nb) * FE + 32 * kb; it.kdst = FE; }
  return it;
}
struct BgRegs { float v[16]; };
__device__ __forceinline__ void bg_load(BgRegs& R, const BgItem& it, int lane) {
#pragma unroll
  for (int i = 0; i < 16; ++i) R.v[i] = __builtin_nontemporal_load(it.src + (size_t)(2 * i + (lane >> 5)) * it.ldw + (lane & 31));
}
__device__ __forceinline__ void bg_store(const BgRegs& R, const BgItem& it, LAS float* scr, int lane) {
#pragma unroll
  for (int i = 0; i < 16; ++i) scr[(2 * i + (lane >> 5)) * 33 + (lane & 31)] = R.v[i];
  LDS_WAIT(); asm volatile("" ::: "memory");
  { const int c = lane & 1, n = lane >> 1; const LAS float* s = scr + (16 * c) * 33 + n;
    u32x4 o; o.x = pk4_fp8(s[0 * 33] * 32.f, s[1 * 33] * 32.f, s[2 * 33] * 32.f, s[3 * 33] * 32.f); o.y = pk4_fp8(s[4 * 33] * 32.f, s[5 * 33] * 32.f, s[6 * 33] * 32.f, s[7 * 33] * 32.f);
    o.z = pk4_fp8(s[8 * 33] * 32.f, s[9 * 33] * 32.f, s[10 * 33] * 32.f, s[11 * 33] * 32.f); o.w = pk4_fp8(s[12 * 33] * 32.f, s[13 * 33] * 32.f, s[14 * 33] * 32.f, s[15 * 33] * 32.f);
    __builtin_nontemporal_store(o, (GAS u32x4*)(it.dst + (size_t)n * it.kdst + 16 * c)); }
  LDS_WAIT(); asm volatile("" ::: "memory");
}

template <bool OUT, int NBG>
__device__ __forceinline__ void hgrn_item(int tid, int h, int dir, int p, unsigned char* ws, float* Sbuf, float* Dbuf, LAS unsigned char* lds, int bg_first, int bg_stride, const float* wg, const float* wu, const float* wd) {
  const int wid = __builtin_amdgcn_readfirstlane(tid >> 6), lane = tid & 63, r32 = lane & 31, hi = lane >> 5;
  const bf16_t* HQ = (const bf16_t*)(ws + WS_HQ); const bf16_t* Z = (const bf16_t*)(ws + (dir ? WS_ZB : WS_ZF)); const bf16_t* HI = (const bf16_t*)(ws + WS_HI);
  const float* lbp = (const float*)(ws + WS_SMALL) + 64 + dir * 512 + h * 128;
  bf16_t* Od = (bf16_t*)(ws + WS_Q) + ((size_t)(dir * 4 + h) * T) * 128;
  const int sc = dir ? (NSC - 1 - p) : p, tok0 = sc * LSC;
  float* Sg = Sbuf + ((size_t)((h * 2 + dir) * NSC + p)) * 16384;
  float* Dg = Dbuf + ((size_t)((h * 2 + dir) * NSC + p)) * 128;
  const int sr = tid >> 4, c8 = (tid & 15) * 8;
  float lb8[8];
#pragma unroll
  for (int i = 0; i < 8; ++i) lb8[i] = lbp[c8 + i];
  const int vj = wid & 3, kt0 = 2 * (wid >> 2);
  f32x16 S0, S1;
  if (OUT) {
#pragma unroll
    for (int r = 0; r < 16; ++r) { S0[r] = Sg[(size_t)(32 * kt0 + crow(r, hi)) * 128 + 32 * vj + r32]; S1[r] = Sg[(size_t)(32 * (kt0 + 1) + crow(r, hi)) * 128 + 32 * vj + r32]; }
  } else { S0 = f32x16{}; S1 = f32x16{}; }
  float bsum[8];
#pragma unroll
  for (int i = 0; i < 8; ++i) bsum[i] = 1.f;
  LAS float* Gb = (LAS float*)(lds + L_GB); LAS float* Seg = (LAS float*)(lds + L_SEG); LAS float* Dl = (LAS float*)(lds + L_DL);
  LAS float* bscr = (LAS float*)(lds + (wid < 5 ? L_END + wid * 4224 : 133120 + (wid - 5) * 4224));
  BgRegs bgr0, bgr1, bgr2, bgr3, bgr4, bgr5;
#define BG_ONE(j, R) do { \
    const int idp_ = bg_first + bg_stride * (NBG * (step - 1) + (j)), idn_ = bg_first + bg_stride * (NBG * step + (j)); \
    if (step > 0 && idp_ < BG_ITEMS) { const BgItem it_ = bg_decode(idp_, wg, wu, wd, ws); bg_store(R, it_, bscr, lane); } \
    if (step < NCH && idn_ < BG_ITEMS) { const BgItem it_ = bg_decode(idn_, wg, wu, wd, ws); bg_load(R, it_, lane); } } while (0)
#define BG_POINT(i, R, R2) do { if (NBG > 0 && bg_first >= 0) { if (NBG > (i)) BG_ONE((i), R); if (NBG > 3 + (i)) BG_ONE(3 + (i), R2); } } while (0)
  u32x4 z0, z1, v0, v1, q0 = {0, 0, 0, 0}, q1 = {0, 0, 0, 0};
#define HG_LOAD(step_) do { const int ci_ = dir ? (NCH - 1 - (step_)) : (step_), ctok_ = tok0 + ci_ * C; \
    const int t0_ = ctok_ + (dir ? (63 - sr) : sr), t1_ = ctok_ + (dir ? (31 - sr) : (sr + 32)); \
    const size_t g0_ = (size_t)t0_ * 512 + h * 128 + c8, g1_ = (size_t)t1_ * 512 + h * 128 + c8; \
    z0 = *(const u32x4*)(Z + g0_); z1 = *(const u32x4*)(Z + g1_); v0 = *(const u32x4*)(HI + g0_); v1 = *(const u32x4*)(HI + g1_); \
    if (OUT) { q0 = *(const u32x4*)(HQ + g0_); q1 = *(const u32x4*)(HQ + g1_); } } while (0)
#define HG_LOAD_Z(step_) do { const int ci_ = dir ? (NCH - 1 - (step_)) : (step_), ctok_ = tok0 + ci_ * C; \
    const int t0_ = ctok_ + (dir ? (63 - sr) : sr), t1_ = ctok_ + (dir ? (31 - sr) : (sr + 32)); \
    z0 = *(const u32x4*)(Z + (size_t)t0_ * 512 + h * 128 + c8); z1 = *(const u32x4*)(Z + (size_t)t1_ * 512 + h * 128 + c8); } while (0)
#define HG_LOAD_VQ(step_) do { const int ci_ = dir ? (NCH - 1 - (step_)) : (step_), ctok_ = tok0 + ci_ * C; \
    const int t0_ = ctok_ + (dir ? (63 - sr) : sr), t1_ = ctok_ + (dir ? (31 - sr) : (sr + 32)); \
    const size_t g0_ = (size_t)t0_ * 512 + h * 128 + c8, g1_ = (size_t)t1_ * 512 + h * 128 + c8; \
    v0 = *(const u32x4*)(HI + g0_); v1 = *(const u32x4*)(HI + g1_); q0 = *(const u32x4*)(HQ + g0_); q1 = *(const u32x4*)(HQ + g1_); } while (0)
  if (!OUT) HG_LOAD(0); else HG_LOAD_Z(0);
  for (int step = 0; step < NCH; ++step) {
    const int ci = dir ? (NCH - 1 - step) : step, ctok = tok0 + ci * C;
    if (OUT) HG_LOAD_VQ(step);
    BG_POINT(0, bgr0, bgr3);
    float k0[8], k1[8];
#pragma unroll
    for (int i = 0; i < 4; ++i) {
      { const float za = bflo(z0[i]), zb = bfhi(z0[i]); const float sa = fsigm(za), sb = fsigm(zb); const float fa = lb8[2 * i] + (1.f - lb8[2 * i]) * sa, fb = lb8[2 * i + 1] + (1.f - lb8[2 * i + 1]) * sb;
        k0[2 * i] = 1.f - fa; k0[2 * i + 1] = 1.f - fb; Gb[sr * 128 + c8 + 2 * i] = fa; Gb[sr * 128 + c8 + 2 * i + 1] = fb; }
      { const float za = bflo(z1[i]), zb = bfhi(z1[i]); const float sa = fsigm(za), sb = fsigm(zb); const float fa = lb8[2 * i] + (1.f - lb8[2 * i]) * sa, fb = lb8[2 * i + 1] + (1.f - lb8[2 * i + 1]) * sb;
        k1[2 * i] = 1.f - fa; k1[2 * i + 1] = 1.f - fb; Gb[(sr + 32) * 128 + c8 + 2 * i] = fa; Gb[(sr + 32) * 128 + c8 + 2 * i + 1] = fb; }
    }
    BG_POINT(1, bgr1, bgr4);
    __syncthreads();
    { const int ch = tid & 127, seg = tid >> 7; float run = 1.f;
#pragma unroll
      for (int r = 0; r < 16; ++r) { run *= Gb[(16 * seg + r) * 128 + ch]; Gb[(16 * seg + r) * 128 + ch] = run; }
      Seg[seg * 128 + ch] = run; }
    __syncthreads();
    float bl[8], o0[8], o1[8];
    { const int sg0 = sr >> 4, sg1 = (sr + 32) >> 4;
#pragma unroll
      for (int i = 0; i < 8; ++i) { const float s0 = Seg[c8 + i], s1 = Seg[128 + c8 + i], s2 = Seg[256 + c8 + i], s3 = Seg[384 + c8 + i];
        bl[i] = (s0 * s1) * (s2 * s3); o0[i] = sg0 == 0 ? 1.f : s0; o1[i] = sg1 == 2 ? (s0 * s1) : ((s0 * s1) * s2); } }
    float b0[8], b1[8];
#pragma unroll
    for (int i = 0; i < 8; ++i) { b0[i] = Gb[sr * 128 + c8 + i] * o0[i]; b1[i] = Gb[(sr + 32) * 128 + c8 + i] * o1[i]; }
    float r0[8], r1[8];
#pragma unroll
    for (int i = 0; i < 8; ++i) { r0[i] = __builtin_amdgcn_rcpf(b0[i]); r1[i] = __builtin_amdgcn_rcpf(b1[i]); }
    if (sr == 0) {
#pragma unroll
      for (int i = 0; i < 8; ++i) { Dl[c8 + i] = bl[i]; bsum[i] *= bl[i]; } }
    { u32x4 kh0, kh1;
#pragma unroll
      for (int i = 0; i < 4; ++i) { kh0[i] = cvt_pk_bf16(k0[2 * i] * (bl[2 * i] * r0[2 * i]), k0[2 * i + 1] * (bl[2 * i + 1] * r0[2 * i + 1]));
        kh1[i] = cvt_pk_bf16(k1[2 * i] * (bl[2 * i] * r1[2 * i]), k1[2 * i + 1] * (bl[2 * i + 1] * r1[2 * i + 1])); }
      const unsigned a0 = off_b(sr, tid & 15), a1 = 8192u + off_b(sr, tid & 15);
      *(LAS u32x4*)(lds + L_KH + a0) = kh0; *(LAS u32x4*)(lds + L_KH + a1) = kh1;
      *(LAS u32x4*)(lds + L_VT + a0) = v0; *(LAS u32x4*)(lds + L_VT + a1) = v1;
      if (OUT) { u32x4 qt0, qt1, kt0_, kt1_;
#pragma unroll
        for (int i = 0; i < 4; ++i) { qt0[i] = cvt_pk_bf16(bflo(q0[i]) * b0[2 * i], bfhi(q0[i]) * b0[2 * i + 1]); qt1[i] = cvt_pk_bf16(bflo(q1[i]) * b1[2 * i], bfhi(q1[i]) * b1[2 * i + 1]);
          kt0_[i] = cvt_pk_bf16(k0[2 * i] * r0[2 * i], k0[2 * i + 1] * r0[2 * i + 1]); kt1_[i] = cvt_pk_bf16(k1[2 * i] * r1[2 * i], k1[2 * i + 1] * r1[2 * i + 1]); }
        *(LAS u32x4*)(lds + L_QT + a0) = qt0; *(LAS u32x4*)(lds + L_QT + a1) = qt1; *(LAS u32x4*)(lds + L_KT + a0) = kt0_; *(LAS u32x4*)(lds + L_KT + a1) = kt1_; } }
    BG_POINT(2, bgr2, bgr5);
    __syncthreads();
    if (!OUT && step + 1 < NCH) HG_LOAD(step + 1);
    if (OUT && step + 1 < NCH) HG_LOAD_Z(step + 1);
    if (OUT) {
      { LAS unsigned char* sb = lds + L_GB + 8192u * vj;
#pragma unroll
        for (int g = 0; g < 4; ++g) { u32x2 w0, w1; w0.x = cvt_pk_bf16(S0[4 * g], S0[4 * g + 1]); w0.y = cvt_pk_bf16(S0[4 * g + 2], S0[4 * g + 3]); w1.x = cvt_pk_bf16(S1[4 * g], S1[4 * g + 1]); w1.y = cvt_pk_bf16(S1[4 * g + 2], S1[4 * g + 3]);
          *(LAS u32x2*)(sb + off_b(r32, 4 * kt0 + g) + 8 * hi) = w0;
          *(LAS u32x2*)(sb + off_b(r32, 4 * (kt0 + 1) + g) + 8 * hi) = w1; } }
      if (wid < 4 && !(wid == 1)) { const int ti = wid >> 1, si = wid & 1; f32x16 a = f32x16{};
#pragma unroll
        for (int s = 0; s < 8; ++s) a = __builtin_amdgcn_mfma_f32_32x32x16_bf16(row_frag(lds + L_KT, lane, si, s), row_frag(lds + L_QT, lane, ti, s), a, 0, 0, 0);
        const int tcol = 32 * ti + r32;
#pragma unroll
        for (int g = 0; g < 4; ++g) { const int s0 = 32 * si + 8 * g + 4 * hi; float x[4];
#pragma unroll
          for (int e = 0; e < 4; ++e) x[e] = (s0 + e <= tcol) ? a[4 * g + e] : 0.f;
          u32x2 w; w.x = cvt_pk_bf16(x[0], x[1]); w.y = cvt_pk_bf16(x[2], x[3]);
          *(LAS u32x2*)(lds + L_AT + at_off(tcol, 4 * si + g) + 8 * hi) = w; } }
      __syncthreads();
      { const int ti = wid >> 2; f32x16 o = f32x16{};
#pragma unroll
        for (int kk = 0; kk < 8; ++kk) o = __builtin_amdgcn_mfma_f32_32x32x16_bf16(row_frag(lds + L_QT, lane, ti, kk), row_frag(lds + L_GB, lane, vj, kk), o, 0, 0, 0);
        const int nks = ti == 0 ? 2 : 4;
        for (int kk = 0; kk < nks; ++kk) { const bf16x8 af = *(const LAS bf16x8*)(lds + L_AT + at_off(32 * ti + r32, 2 * kk + hi));
          o = __builtin_amdgcn_mfma_f32_32x32x16_bf16(af, tr_frag(lds + L_VT, lane, vj, kk), o, 0, 0, 0); }
#pragma unroll
        for (int r = 0; r < 16; ++r) { const int rr = 32 * ti + crow(r, hi); const int t = ctok + (dir ? (63 - rr) : rr);
          Od[(size_t)t * 128 + 32 * vj + r32] = (bf16_t)(cvt_pk_bf16(o[r], 0.f) & 0xffffu); } }
    }
    { float d0[16], d1[16];
#pragma unroll
      for (int r = 0; r < 16; ++r) { d0[r] = Dl[32 * kt0 + crow(r, hi)]; d1[r] = Dl[32 * (kt0 + 1) + crow(r, hi)]; }
#pragma unroll
      for (int r = 0; r < 16; ++r) { S0[r] *= d0[r]; S1[r] *= d1[r]; }
#pragma unroll
      for (int kk = 0; kk < 4; ++kk) { const bf16x8 vf = tr_frag(lds + L_VT, lane, vj, kk);
        S0 = __builtin_amdgcn_mfma_f32_32x32x16_bf16(tr_frag(lds + L_KH, lane, kt0, kk), vf, S0, 0, 0, 0);
        S1 = __builtin_amdgcn_mfma_f32_32x32x16_bf16(tr_frag(lds + L_KH, lane, kt0 + 1, kk), vf, S1, 0, 0, 0); } }
    __syncthreads();
  }
  { const int step = NCH; BG_POINT(0, bgr0, bgr3); BG_POINT(1, bgr1, bgr4); BG_POINT(2, bgr2, bgr5); }
#undef BG_POINT
#undef BG_ONE
#undef HG_LOAD
#undef HG_LOAD_Z
#undef HG_LOAD_VQ
  if (!OUT) {
#pragma unroll
    for (int r = 0; r < 16; ++r) { Sg[(size_t)(32 * kt0 + crow(r, hi)) * 128 + 32 * vj + r32] = S0[r]; Sg[(size_t)(32 * (kt0 + 1) + crow(r, hi)) * 128 + 32 * vj + r32] = S1[r]; }
    if (sr == 0) {
#pragma unroll
      for (int i = 0; i < 8; ++i) Dg[c8 + i] = bsum[i]; }
  }
}

__device__ __forceinline__ void hgrn_scan(int gthread, int nthreads, float* Sbuf, const float* Dbuf) {
  for (int e = gthread; e < 8 * 16384; e += nthreads) { const int hd = e >> 14, kv = e & 16383, k = kv >> 7;
    float* Sp = Sbuf + (size_t)hd * NSC * 16384 + kv; const float* Dp = Dbuf + (size_t)hd * NSC * 128 + k;
    float run = 0.f;
#pragma unroll 8
    for (int p = 0; p < NSC; ++p) { const float s = Sp[(size_t)p * 16384], d = Dp[p * 128]; Sp[(size_t)p * 16384] = run; run = d * run + s; } }
}
__device__ __forceinline__ void hgrn_combine(int gwave, int nwaves, int lane, const unsigned char* ws, const float* __restrict__ gg) {
  const bf16_t* Of = (const bf16_t*)(ws + WS_Q); const bf16_t* Ob = Of + (size_t)4 * T * 128; const bf16_t* HG = (const bf16_t*)(ws + WS_HG); bf16_t* mix = (bf16_t*)(ws + WS_XN);
  const int sub = lane >> 4, c8 = (lane & 15) * 8;
  float g8[8];
#pragma unroll
  for (int i = 0; i < 8; ++i) g8[i] = gg[c8 + i];
  for (int w4 = gwave; w4 < T; w4 += 4 * nwaves) { const int h = sub;
    u32x4 f[4], b[4], gt[4];
#pragma unroll
    for (int u = 0; u < 4; ++u) { const int t = w4 + u * nwaves; if (t < T) {
      f[u] = __builtin_nontemporal_load((const GAS u32x4*)(Of + ((size_t)h * T + t) * 128 + c8)); b[u] = __builtin_nontemporal_load((const GAS u32x4*)(Ob + ((size_t)h * T + t) * 128 + c8));
      gt[u] = __builtin_nontemporal_load((const GAS u32x4*)(HG + (size_t)t * 512 + h * 128 + c8)); } }
#pragma unroll
    for (int u = 0; u < 4; ++u) { const int t = w4 + u * nwaves; if (t < T) {
      float a[8]; float ss = 0.f;
#pragma unroll
      for (int i = 0; i < 4; ++i) { a[2 * i] = bflo(f[u][i]) + bflo(b[u][i]); a[2 * i + 1] = bfhi(f[u][i]) + bfhi(b[u][i]); ss += a[2 * i] * a[2 * i] + a[2 * i + 1] * a[2 * i + 1]; }
      ss += __shfl_xor(ss, 1); ss += __shfl_xor(ss, 2); ss += __shfl_xor(ss, 4); ss += __shfl_xor(ss, 8);
      const float r = 1.f / sqrtf(ss * (1.f / 128.f) + 1e-6f);
      u32x4 o;
#pragma unroll
      for (int i = 0; i < 4; ++i) o[i] = cvt_pk_bf16(a[2 * i] * r * g8[2 * i] * bflo(gt[u][i]), a[2 * i + 1] * r * g8[2 * i + 1] * bfhi(gt[u][i]));
      *(GAS u32x4*)(mix + (size_t)t * DM + 512 + h * 128 + c8) = o; } } }
}
}
}
namespace mk {
struct EpiOutProj { static constexpr int ID = 2; static constexpr bool XPF = true;
  const float* x; bf16_t* hb;
  __device__ __forceinline__ const float* xpf_src(const Unit& u, int p, int wr, int wc, int fr, int fq) const {
    const int n = p & 1, bj = (p >> 1) & 1, m = (p >> 2) & 3, ai = p >> 4;
    return x + (size_t)(u.pm * BM + wr * 64 + fr + ai * HALF + m * 16) * DM + u.pn * BM + wc * 32 + 8 * fq + bj * HALF + 4 * n;
  }
  template <bool PF>
  __device__ __forceinline__ void run(const f32x4 (&acc)[2][2][4][2], const Unit& u, int wr, int wc, int fr, int fq, const LAS unsigned char* lp, const unsigned* xb) const {
    const int row0 = u.pm * BM + wr * 64 + fr, col0 = u.pn * BM + wc * 32 + 8 * fq;
#pragma unroll
    for (int ai = 0; ai < 2; ++ai)
#pragma unroll
      for (int m = 0; m < 4; ++m) { const size_t ro = (size_t)(row0 + ai * HALF + m * 16) * DM + col0;
#pragma unroll
        for (int bj = 0; bj < 2; ++bj) { const GAS f32x4* xp = (const GAS f32x4*)(x + ro + bj * HALF);
          const int p0 = ((ai * 4 + m) * 2 + bj) * 2;
          f32x4 x0, x1;
          if (PF && p0 < 14) { x0 = *(const LAS f32x4*)(lp + xb[p0 >> 1]); x1 = *(const LAS f32x4*)(lp + xb[p0 >> 1] + 8192); }
          else { x0 = __builtin_nontemporal_load(xp); x1 = __builtin_nontemporal_load(xp + 1); }
          x0 += acc[ai][bj][m][0]; x1 += acc[ai][bj][m][1];
          u32x4 w; w.x = cvt_pk_bf16(x0.x, x0.y); w.y = cvt_pk_bf16(x0.z, x0.w); w.z = cvt_pk_bf16(x1.x, x1.y); w.w = cvt_pk_bf16(x1.z, x1.w);
          *(GAS u32x4*)(hb + ro + bj * HALF) = w; } }
  }
  __device__ __forceinline__ void operator()(const f32x4 (&acc)[2][2][4][2], const Unit& u, int wr, int wc, int fr, int fq) const { run<false>(acc, u, wr, wc, fr, fq, nullptr, nullptr); }
  __device__ __forceinline__ void run_pf(const f32x4 (&acc)[2][2][4][2], const Unit& u, int wr, int wc, int fr, int fq, const LAS unsigned char* lp, const unsigned* xb) const { run<true>(acc, u, wr, wc, fr, fq, lp, xb); }
};

namespace rt {
constexpr size_t WS_WR = WS_SMALL + 64 * 1024;
constexpr size_t R_LIST = WS_ROUTE, R_CWL = WS_ROUTE + 2 * MiB, R_TINFO = WS_ROUTE + 4 * MiB;
__device__ __forceinline__ void build_wr(int gthread, int nthreads, const Args& a) {
  bf16_t* WR = (bf16_t*)(a.ws + WS_WR); const float* g = a.in[8]; const float* wgr = a.in[9]; const float* wer = a.in[11];
  for (int idx = gthread; idx < 1024 * 48; idx += nthreads) { const int k = idx & 1023, j = idx >> 10; float w = 0.f;
    if (j < 4) w = wgr[k * 4 + j]; else if (j < 36) { const int gi = (j - 4) >> 3, e = (j - 4) & 7; w = wer[((size_t)gi * 1024 + k) * 8 + e]; }
    w *= g[k];
    const unsigned hi = cvt_pk_bf16(w, 0.f) & 0xffffu; const float lo = w - __uint_as_float(hi << 16);
    WR[idx] = (bf16_t)hi; WR[48 * 1024 + idx] = (bf16_t)(cvt_pk_bf16(lo, 0.f) & 0xffffu); }
}
__device__ __forceinline__ void router_phase(Frame& F, const Args& a, gu32* gcnt, bool dry = false) {
  const bf16_t* hres = (const bf16_t*)(a.ws + WS_HI); const float* g = a.in[8]; const bf16_t* WR = (const bf16_t*)(a.ws + WS_WR);
  const float* bgr = a.in[10]; const float* ber = a.in[12];
  bf16_t* XT = (bf16_t*)(a.ws + WS_XN); int* list = (int*)(a.ws + R_LIST); float* cwl = (float*)(a.ws + R_CWL); int* tinfo = (int*)(a.ws + R_TINFO);
  constexpr int WROW = 528, TERM_B = 48 * WROW, HALF_B = 2 * TERM_B;
  LAS unsigned char* wl = F.lds; LAS float* lgx = (LAS float*)(F.lds + 110592); LAS float* ssx = lgx + 4 * 16 * 48; LAS int* lcnt = (LAS int*)(F.lds + 124416); LAS int* lbase = lcnt + 32;
  const int lane = F.lane, j = lane & 15, q = lane >> 4, tl = F.wave & 3, kh = F.wave >> 2;
  const int ntile = T / 16, tpb = (ntile + F.G - 1) / F.G;
  if (F.tid < 64) lcnt[F.tid] = 0;
  const int tile = F.vcu * tpb + tl; const bool active = (tl < tpb) && (tile < ntile);
  const int t0 = (active ? tile : 0) * 16;
  const bf16_t* xr = hres + (size_t)(t0 + j) * DM + 512 * kh + 8 * q;
  f32x4 acc0 = {0.f, 0.f, 0.f, 0.f}, acc1 = acc0, acc2 = acc0; float ssq = 0.f;
  u32x4 xh[16];
#pragma unroll
  for (int s = 0; s < 16; ++s) xh[s] = *(const GAS u32x4*)(xr + 32 * s);
  for (int c = 0; c < 2; ++c) {
    u32x4 wv[12];
#pragma unroll
    for (int it = 0; it < 12; ++it) { const int idx = F.tid + it * NTHR; const int hh = idx / 3072, rem = idx % 3072, term = rem / 1536, r2 = rem % 1536, col = r2 >> 5, pc = r2 & 31;
      wv[it] = *(const GAS u32x4*)(WR + (size_t)term * 48 * 1024 + (size_t)col * 1024 + 512 * hh + 256 * c + 8 * pc); }
    __syncthreads();
#pragma unroll
    for (int it = 0; it < 12; ++it) { const int idx = F.tid + it * NTHR; const int hh = idx / 3072, rem = idx % 3072, term = rem / 1536, r2 = rem % 1536, col = r2 >> 5, pc = r2 & 31;
      *(LAS u32x4*)(wl + hh * HALF_B + term * TERM_B + col * WROW + 16 * pc) = wv[it]; }
    __syncthreads();
    const LAS unsigned char* wk = wl + kh * HALF_B + j * WROW + 16 * q;
#pragma unroll
    for (int s = 0; s < 8; ++s) { const u32x4 xb = xh[8 * c + s]; const bf16x8 xa = __builtin_bit_cast(bf16x8, xb);
#pragma unroll
      for (int e = 0; e < 4; ++e) { const float a0 = bflo(xb[e]), a1 = bfhi(xb[e]); ssq += a0 * a0 + a1 * a1; }
#pragma unroll
      for (int term = 0; term < 2; ++term) { const LAS unsigned char* wp = wk + term * TERM_B + 64 * s;
        acc0 = __builtin_amdgcn_mfma_f32_16x16x32_bf16(xa, *(const LAS bf16x8*)(wp), acc0, 0, 0, 0);
        acc1 = __builtin_amdgcn_mfma_f32_16x16x32_bf16(xa, *(const LAS bf16x8*)(wp + 16 * WROW), acc1, 0, 0, 0);
        acc2 = __builtin_amdgcn_mfma_f32_16x16x32_bf16(xa, *(const LAS bf16x8*)(wp + 32 * WROW), acc2, 0, 0, 0); } }
  }
  ssq += __shfl_xor(ssq, 16); ssq += __shfl_xor(ssq, 32);
  if (lane < 16) ssx[(tl * 2 + kh) * 16 + lane] = ssq;
  if (kh == 1) {
#pragma unroll
    for (int r = 0; r < 4; ++r) { lgx[(tl * 16 + 4 * q + r) * 48 + j] = acc0[r]; lgx[(tl * 16 + 4 * q + r) * 48 + 16 + j] = acc1[r]; lgx[(tl * 16 + 4 * q + r) * 48 + 32 + j] = acc2[r]; } }
  __syncthreads();
  const float rstd = 1.f / sqrtf((ssx[(tl * 2) * 16 + j] + ssx[(tl * 2 + 1) * 16 + j]) * (1.f / DM) + 1e-6f);
  if (kh == 0) {
#pragma unroll
    for (int r = 0; r < 4; ++r) { lgx[(tl * 16 + 4 * q + r) * 48 + j] += acc0[r]; lgx[(tl * 16 + 4 * q + r) * 48 + 16 + j] += acc1[r]; lgx[(tl * 16 + 4 * q + r) * 48 + 32 + j] += acc2[r]; } }
  if (active) {
#pragma unroll
    for (int u = 0; u < 16; ++u) { const u32x4 xb = xh[u]; const GAS f32x4* gp = (const GAS f32x4*)(g + 512 * kh + 32 * u + 8 * q); const f32x4 g0 = gp[0], g1 = gp[1];
      u32x2 w; w.x = pk4_fp8(bflo(xb.x) * rstd * g0.x, bfhi(xb.x) * rstd * g0.y, bflo(xb.y) * rstd * g0.z, bfhi(xb.y) * rstd * g0.w);
      w.y = pk4_fp8(bflo(xb.z) * rstd * g1.x, bfhi(xb.z) * rstd * g1.y, bflo(xb.w) * rstd * g1.z, bfhi(xb.w) * rstd * g1.w);
      *(GAS u32x2*)((unsigned char*)XT + (size_t)(t0 + j) * DM + 512 * kh + 32 * u + 8 * q) = w; } }
  LDS_WAIT();
  int e1 = 0, e2 = 0, lr1 = 0, lr2 = 0; float c1 = 0.f, c2 = 0.f; int tok = 0;
  if (active && kh == 0 && lane < 16) {
    tok = t0 + lane; const LAS float* lg = lgx + (tl * 16 + lane) * 48;
    float gl[4];
#pragma unroll
    for (int i = 0; i < 4; ++i) gl[i] = lg[i] * rstd + bgr[i];
    int gi = 0; float gm = gl[0];
#pragma unroll
    for (int i = 1; i < 4; ++i) if (gl[i] > gm) { gm = gl[i]; gi = i; }
    float den = 0.f;
#pragma unroll
    for (int i = 0; i < 4; ++i) den += __expf(gl[i] - gm);
    const float pg = 1.f / den;
    float el[8];
#pragma unroll
    for (int i = 0; i < 8; ++i) el[i] = lg[4 + 8 * gi + i] * rstd + ber[gi * 8 + i];
    int i1 = 0; float m1 = el[0];
#pragma unroll
    for (int i = 1; i < 8; ++i) if (el[i] > m1) { m1 = el[i]; i1 = i; }
    int i2 = 0; float m2 = -3.0e38f;
#pragma unroll
    for (int i = 0; i < 8; ++i) if (i != i1 && el[i] > m2) { m2 = el[i]; i2 = i; }
    const float ex = __expf(m2 - m1); const float w1 = 1.f / (1.f + ex), w2 = ex / (1.f + ex);
    e1 = gi * 8 + i1; e2 = gi * 8 + i2; c1 = w1 * pg; c2 = w2 * pg;
    if (!dry) { lr1 = __hip_atomic_fetch_add(lcnt + e1, 1, __ATOMIC_RELAXED, __HIP_MEMORY_SCOPE_WORKGROUP); lr2 = __hip_atomic_fetch_add(lcnt + e2, 1, __ATOMIC_RELAXED, __HIP_MEMORY_SCOPE_WORKGROUP); }
  }
  __syncthreads();
  if (dry) return;
  if (F.tid < 32) { const int n = lcnt[F.tid]; lbase[F.tid] = n ? (int)__hip_atomic_fetch_add(gcnt + F.tid, (unsigned)n, __ATOMIC_RELAXED, __HIP_MEMORY_SCOPE_AGENT) : 0; }
  __syncthreads();
  if (active && kh == 0 && lane < 16) { const int p1 = lbase[e1] + lr1, p2 = lbase[e2] + lr2;
    list[(size_t)e1 * T + p1] = tok; list[(size_t)e2 * T + p2] = tok; cwl[(size_t)e1 * T + p1] = c1; cwl[(size_t)e2 * T + p2] = c2;
    typedef int i32x4 __attribute__((ext_vector_type(4))); *(GAS i32x4*)(tinfo + (size_t)tok * 4) = (i32x4){e1, p1, e2, p2}; }
}
}

constexpr int MOE_TAB = RING_BYTES + 512;
__device__ __forceinline__ void moe_tables(Frame& F, gu32* gcnt) {
  LAS int* tab = (LAS int*)(F.lds + MOE_TAB);
  if (F.tid < 64) {
    const int e = F.tid; const int n = e < NEXP ? (int)__hip_atomic_load(gcnt + e, __ATOMIC_RELAXED, __HIP_MEMORY_SCOPE_AGENT) : 0;
    const int te = (n + 255) >> 8, rem = n - 256 * (te - 1), sm = (te > 0 && rem <= 128) ? 1 : 0, big = te - sm;
    int so = n, sb = big, ss = sm;
#pragma unroll
    for (int d = 1; d < 32; d <<= 1) { const int a = __shfl_up(so, d), b = __shfl_up(sb, d), c = __shfl_up(ss, d); if (e >= d) { so += a; sb += b; ss += c; } }
    if (e < NEXP) { tab[e] = n; tab[32 + e] = so - n; tab[66 + e] = sb - big; tab[100 + e] = ss - sm; }
    if (e == NEXP - 1) { tab[64] = so; tab[98] = sb; tab[132] = ss; } }
  __syncthreads();
}
template <bool DOWN>
struct ProbMoE {
  int K; const char* Abase; const char* Wt; const int* list; const LAS int* tab; int G, c;
  static constexpr bool TAILS = true, FP8 = true;
  int scale_w, scale_x;
  __device__ __forceinline__ bool next(int i, Unit& u) const {
    int L = i * G + c; const int nB = tab[98] * 4, nS = tab[132] * 4; if (L >= nB + nS) return false;
    const bool small = L >= nB; if (small) L -= nB;
    const int tile = L >> 2, base = small ? 100 : 66; u.pn = L & 3;
    int e = 0;
#pragma unroll 1
    for (int s = 16; s >= 1; s >>= 1) if (e + s < NEXP && tab[base + e + s] <= tile) e += s;
    u.e = e; const int nbig = tab[66 + e + 1] - tab[66 + e];
    u.pm = small ? nbig : tile - tab[66 + e]; u.nrows = tab[e] - u.pm * 256; if (u.nrows > 256) u.nrows = 256; u.row0 = tab[32 + e] + u.pm * 256; return true;
  }
  __device__ __forceinline__ unsigned a_row_off(const Unit& u, int r) const {
    const int rr = r < u.nrows ? r : (u.nrows - 1);
    if (DOWN) return (unsigned)(u.row0 + rr) * (unsigned)K * 2u;
    const int tok = list[(size_t)u.e * T + u.pm * 256 + rr]; return (unsigned)tok * (unsigned)K * 2u;
  }
  __device__ __forceinline__ const char* b_rows(const Unit& u) const { return Wt + ((size_t)u.e * 1024 + (size_t)u.pn * 256) * K * 2; }
};
struct EpiGateUp { static constexpr int ID = 3; static constexpr bool XPF = false;
  bf16_t* hid; const float* cwl;
  __device__ __forceinline__ void operator()(const f32x4 (&acc)[2][2][4][2], const Unit& u, int wr, int wc, int fr, int fq) const {
    const int f0 = u.pn * 128 + wc * 32 + 8 * fq;
#pragma unroll
    for (int ai = 0; ai < 2; ++ai)
#pragma unroll
      for (int m = 0; m < 4; ++m) { const int r = ai * HALF + wr * 64 + m * 16 + fr;
        if (r < u.nrows) { const float cw = cwl[(size_t)u.e * T + u.pm * 256 + r];
          const f32x4 a0 = acc[ai][0][m][0], a1 = acc[ai][0][m][1], u0 = acc[ai][1][m][0], u1 = acc[ai][1][m][1]; float hv[8];
#pragma unroll
          for (int i = 0; i < 4; ++i) { hv[i] = fsilu(a0[i] * 0.03125f) * (u0[i] * 0.03125f) * cw; hv[4 + i] = fsilu(a1[i] * 0.03125f) * (u1[i] * 0.03125f) * cw; }
          u32x2 w; w.x = pk4_fp8(hv[0] * 16.f, hv[1] * 16.f, hv[2] * 16.f, hv[3] * 16.f); w.y = pk4_fp8(hv[4] * 16.f, hv[5] * 16.f, hv[6] * 16.f, hv[7] * 16.f);
          *(GAS u32x2*)((unsigned char*)hid + (size_t)(u.row0 + r) * FE + f0) = w; } }
  }
};
struct EpiDown { static constexpr int ID = 4; static constexpr bool XPF = false;
  bf16_t* y;
  __device__ __forceinline__ void operator()(const f32x4 (&acc)[2][2][4][2], const Unit& u, int wr, int wc, int fr, int fq) const {
    const int col0 = u.pn * BM + wc * 32 + 8 * fq;
#pragma unroll
    for (int ai = 0; ai < 2; ++ai)
#pragma unroll
      for (int m = 0; m < 4; ++m) { const int r = ai * HALF + wr * 64 + m * 16 + fr;
        if (r < u.nrows) {
#pragma unroll
          for (int bj = 0; bj < 2; ++bj) { const f32x4 v0 = acc[ai][bj][m][0] * 0.001953125f, v1 = acc[ai][bj][m][1] * 0.001953125f;
            u32x4 w; w.x = cvt_pk_bf16(v0[0], v0[1]); w.y = cvt_pk_bf16(v0[2], v0[3]); w.z = cvt_pk_bf16(v1[0], v1[1]); w.w = cvt_pk_bf16(v1[2], v1[3]);
            *(GAS u32x4*)(y + (size_t)(u.row0 + r) * DM + col0 + bj * HALF) = w; } } }
  }
};
__device__ __forceinline__ void final_phase(Frame& F, const Args& a, const bf16_t* y, float* outp) {
  const LAS int* tab = (const LAS int*)(F.lds + MOE_TAB); const int* tinfo = (const int*)(a.ws + rt::R_TINFO); const float* gf = a.in[16];
  const int gw = F.vcu * NWAVES + F.wave, NGW = F.G * NWAVES, lane = F.lane;
  typedef int i32x4 __attribute__((ext_vector_type(4)));
  f32x4 gg[4];
#pragma unroll
  for (int jj = 0; jj < 4; ++jj) gg[jj] = ((const GAS f32x4*)gf)[lane + 64 * jj];
  for (int t0 = gw; t0 < T; t0 += 2 * NGW) {
    i32x4 ti[2]; u32x2 hb_[2][4], p[2][4], q2[2][4];
#pragma unroll
    for (int u = 0; u < 2; ++u) { const int t = t0 + u * NGW; if (t < T) ti[u] = *(const GAS i32x4*)(tinfo + (size_t)t * 4); }
#pragma unroll
    for (int u = 0; u < 2; ++u) { const int t = t0 + u * NGW; if (t < T) {
      const int s1 = tab[32 + ti[u][0]] + ti[u][1], s2 = tab[32 + ti[u][2]] + ti[u][3];
      const GAS u32x2* hp = (const GAS u32x2*)((const bf16_t*)(a.ws + WS_HI) + (size_t)t * DM) + lane; const GAS u32x2* y1 = (const GAS u32x2*)(y + (size_t)s1 * DM) + lane; const GAS u32x2* y2 = (const GAS u32x2*)(y + (size_t)s2 * DM) + lane;
#pragma unroll
      for (int jj = 0; jj < 4; ++jj) { hb_[u][jj] = __builtin_nontemporal_load(hp + 64 * jj); p[u][jj] = __builtin_nontemporal_load(y1 + 64 * jj); q2[u][jj] = __builtin_nontemporal_load(y2 + 64 * jj); } } }
#pragma unroll
    for (int u = 0; u < 2; ++u) { const int t = t0 + u * NGW; if (t < T) {
      GAS f32x4* op = (GAS f32x4*)(outp + (size_t)t * DM) + lane;
      f32x4 v[4]; float s = 0.f;
#pragma unroll
      for (int jj = 0; jj < 4; ++jj) { const u32x2 hh = hb_[u][jj], pp = p[u][jj], qq = q2[u][jj];
        v[jj].x = bflo(hh.x) + bflo(pp.x) + bflo(qq.x); v[jj].y = bfhi(hh.x) + bfhi(pp.x) + bfhi(qq.x); v[jj].z = bflo(hh.y) + bflo(pp.y) + bflo(qq.y); v[jj].w = bfhi(hh.y) + bfhi(pp.y) + bfhi(qq.y);
        s += (v[jj].x * v[jj].x + v[jj].y * v[jj].y) + (v[jj].z * v[jj].z + v[jj].w * v[jj].w); }
      const float rstd = 1.f / sqrtf(wave_sum(s) * (1.f / DM) + 1e-6f);
#pragma unroll
      for (int jj = 0; jj < 4; ++jj) __builtin_nontemporal_store(v[jj] * rstd * gg[jj], op + 64 * jj); } } }
}
}
namespace mk {
#ifndef MK_STAGE
#define MK_STAGE 1
#endif
constexpr int N_PHASES = 11;

__global__ void __launch_bounds__(NTHR, 2) mk_fwd(Args args) {
  extern __shared__ __attribute__((aligned(16))) unsigned char lds_raw[];
  Frame F;
  F.lds = (LAS unsigned char*)lds_raw;
  F.MISC = (volatile LAS unsigned*)(F.lds + MISC_OFF);
  F.tid = threadIdx.x; F.lane = F.tid & 63; F.wave = __builtin_amdgcn_readfirstlane(F.tid >> 6);
  F.G = gridDim.x; { const int bx = blockIdx.x; F.vcu = (F.G % 8 == 0) ? (bx % 8) * (F.G / 8) + bx / 8 : bx; }
  unsigned char* ws = args.ws;
  gu32* ctl = (gu32*)(ws + WS_CTL);
  for (int u = F.tid; u < (LDS_BYTES - RING_BYTES) / 4; u += NTHR) ((LAS unsigned*)(F.lds + RING_BYTES))[u] = 0u;
  __syncthreads();
  constexpr unsigned CW_READY = 16, READY_MAGIC = 0x600DCAFEu;
  XcdBarrier bar; bar.bar = (unsigned*)(ctl + CW_BAR); bar.x = xb_xcc_id(); bar.st = F.MISC + 8;
  if (blockIdx.x == 0 && F.wave == 0) {
    if (F.lane < 16) { __hip_atomic_store(ctl + CW_BAR + XB_XCNT(F.lane), 0u, __ATOMIC_RELAXED, __HIP_MEMORY_SCOPE_AGENT); __hip_atomic_store(ctl + CW_BAR + XB_XSUB(F.lane), 0u, __ATOMIC_RELAXED, __HIP_MEMORY_SCOPE_AGENT);
      __hip_atomic_store(ctl + CW_BAR + XB_XGEN(F.lane), 0u, __ATOMIC_RELAXED, __HIP_MEMORY_SCOPE_AGENT); }
    if (F.lane < 32) __hip_atomic_store(ctl + CW_CNT + F.lane, 0u, __ATOMIC_RELAXED, __HIP_MEMORY_SCOPE_AGENT);
    if (F.lane == 32) __hip_atomic_store(ctl + CW_BAR + XB_TMO, 0u, __ATOMIC_RELAXED, __HIP_MEMORY_SCOPE_AGENT);
    if (F.lane == 33) __hip_atomic_store(ctl + CW_BAR + XB_TOP, 0u, __ATOMIC_RELAXED, __HIP_MEMORY_SCOPE_AGENT);
    if (F.lane == 34) __hip_atomic_store(ctl + CW_BAR + XB_TOPGEN, 0u, __ATOMIC_RELAXED, __HIP_MEMORY_SCOPE_AGENT);
    asm volatile("s_waitcnt vmcnt(0)" ::: "memory");
    if (F.lane == 0) __hip_atomic_store(ctl + CW_READY, READY_MAGIC, __ATOMIC_RELAXED, __HIP_MEMORY_SCOPE_AGENT);
  }
  const int lo = args.ph_lo, hi = args.ph_hi;
#ifndef MK_REPEAT_MASK
#define MK_REPEAT_MASK 0
#endif
#define REP(k) for (int rep_ = 0; rep_ < (((MK_REPEAT_MASK) >> (k)) & 1) + 1; ++rep_)
#define REP2(k, stmt) do { stmt; if (((MK_REPEAT_MASK) >> (k)) & 1) { asm volatile("" ::: "memory"); stmt; } } while (0)
#ifndef MK_PHASE_MASK
#define MK_PHASE_MASK 0xfff
#endif
#define IN(k) ((((MK_PHASE_MASK) >> (k)) & 1) && lo <= (k) && (k) < hi)
#define BOTH(k) (IN(k) && IN((k) + 1))
#define GRID_BAR() xcd_barrier(bar)

  if (IN(0)) { REP2(0, (p0_prologue<false>(F, args))); if (MK_STAGE >= 5) rt::build_wr(F.vcu * NTHR + F.tid, F.G * NTHR, args); }
  {
    if (F.tid == 0) { unsigned sp = 0; while (__hip_atomic_load(ctl + CW_READY, __ATOMIC_RELAXED, __HIP_MEMORY_SCOPE_AGENT) != READY_MAGIC) { __builtin_amdgcn_s_sleep(2); if (++sp > (1u << 24)) break; }
      (void)xb_add(&bar.bar[XB_XCNT(bar.x)], 1u); }
    __syncthreads(); }
  if (BOTH(0)) GRID_BAR();

  if (IN(1)) {
    ProbPlain P; P.init(ws + WS_XN, ws + WS_WIN, T, NCOL, DM, F.G, (int)blockIdx.x);
    EpiInProj E{ws, (const float*)(ws + WS_ROPE), (const float*)(ws + WS_ROPE) + (size_t)T * 32, args.out};
    REP2(1, (gemm_phase<ProbPlain, EpiInProj, true>(F.lds, P, E)));
    if (BOTH(1)) GRID_BAR();
  }
  if (IN(2)) {
    for (int sub = 0; sub < 2; ++sub) {
      const bool do_attn = (sub == 0) == ((F.vcu & 1) != 0);
      if (!do_attn) {
        if (MK_STAGE >= 3) REP(11) {
          for (int it = F.vcu; it < 256; it += F.G) { int tid_ = threadIdx.x; asm volatile("" : "+v"(tid_));
            const int bg_gw = F.vcu * NWAVES + F.wave, bg_ngw = F.G * NWAVES;
            hg::hgrn_item<false, 3>(tid_, it >> 6, (it >> 5) & 1, it & 31, ws, args.out + 8 * 1048576, args.out + 12 * 1048576, F.lds, (it == F.vcu) ? bg_gw : -1, bg_ngw, args.in[13], args.in[14], args.in[15]); }
        }
      } else {
        REP(2) for (int u = F.vcu; u < 256; u += F.G) att2::attn_unit(u >> 6, u & 63, ws, args.in[5], args.out + (size_t)blockIdx.x * 32768, q8_base(ws), k8_base(args.out), v8_base(args.out), (LAS char*)F.lds);
      }
      __syncthreads();
    }
    if (BOTH(2)) GRID_BAR();
  }
#ifdef MK_EXTRA_BARS
  if (IN(3)) { for (int xb_ = 0; xb_ < MK_EXTRA_BARS; ++xb_) GRID_BAR(); }
#endif
  if (IN(3)) { hg::hgrn_scan(F.vcu * NTHR + F.tid, F.G * NTHR, args.out + 8 * 1048576, args.out + 12 * 1048576); if (BOTH(3)) GRID_BAR(); }
  if (IN(4)) {
    REP(4) for (int it = F.vcu; it < 256; it += F.G) { int tid_ = threadIdx.x; asm volatile("" : "+v"(tid_));
      hg::hgrn_item<true, 0>(tid_, it >> 6, (it >> 5) & 1, it & 31, ws, args.out + 8 * 1048576, args.out + 12 * 1048576, F.lds, -1, 0, nullptr, nullptr, nullptr); }
    if (BOTH(4)) GRID_BAR();
  }
  if (IN(5)) { REP(5) hg::hgrn_combine(F.vcu * NWAVES + F.wave, F.G * NWAVES, F.lane, ws, args.in[6]); if (BOTH(5)) GRID_BAR(); }
  if (IN(6)) {
    ProbPlain P; P.init(ws + WS_XN, ws + WS_WOUT, T, DM, DM, F.G, (int)blockIdx.x);
    EpiOutProj E{args.in[0], (bf16_t*)(ws + WS_HI)};
    REP2(6, (gemm_phase<ProbPlain, EpiOutProj, true>(F.lds, P, E)));
    if (BOTH(6)) GRID_BAR();
  }
  if (IN(7)) { if ((MK_REPEAT_MASK >> 7) & 1) { rt::router_phase(F, args, ctl + CW_CNT, true); __syncthreads(); } rt::router_phase(F, args, ctl + CW_CNT); if (BOTH(7)) GRID_BAR(); }
  if (IN(8)) {
    moe_tables(F, ctl + CW_CNT);
    ProbMoE<false> P{DM / 2, (const char*)(ws + WS_XN), (const char*)(ws + WS_WGU), (const int*)(ws + rt::R_LIST), (const LAS int*)(F.lds + MOE_TAB), F.G, F.vcu, 0, 0};
    EpiGateUp E{(bf16_t*)(ws + WS_Q), (const float*)(ws + rt::R_CWL)};
    REP2(8, (gemm_phase<ProbMoE<false>, EpiGateUp, true>(F.lds, P, E)));
    if (BOTH(8)) GRID_BAR();
  }
  if (IN(9)) {
    if (!IN(8)) moe_tables(F, ctl + CW_CNT);
    ProbMoE<true> P{FE / 2, (const char*)(ws + WS_Q), (const char*)(ws + WS_WD), (const int*)(ws + rt::R_LIST), (const LAS int*)(F.lds + MOE_TAB), F.G, F.vcu, 0, 0};
    EpiDown E{(bf16_t*)(ws + WS_V)};
    REP2(9, (gemm_phase<ProbMoE<true>, EpiDown, true>(F.lds, P, E)));
    if (BOTH(9)) GRID_BAR();
  }
  if (IN(10)) { if (!IN(8) && !IN(9)) moe_tables(F, ctl + CW_CNT); if ((MK_REPEAT_MASK >> 10) & 1) { final_phase(F, args, (const bf16_t*)(ws + WS_V), (float*)(ws + WS_XN)); __syncthreads(); } final_phase(F, args, (const bf16_t*)(ws + WS_V), args.out); }
  if (blockIdx.x == 0 && F.tid == 0) __hip_atomic_store(ctl + CW_READY, 0u, __ATOMIC_RELAXED, __HIP_MEMORY_SCOPE_AGENT);
#undef IN
#undef BOTH
#undef GRID_BAR
}
}

extern "C" void kernel_launch(void* const* d_in, const int* in_sizes, int n_in, void* d_out, int out_size, void* d_ws, size_t ws_size, hipStream_t stream) {
  using namespace mk;
  static int grid = 0;
  if (grid == 0) {
    if (n_in != 17 || in_sizes[0] != T * DM || out_size != T * DM || ws_size < WS_END) { fprintf(stderr, "kernel_launch: unexpected shapes n_in %d out %d ws %zu (need %zu)\n", n_in, out_size, ws_size, (size_t)WS_END); grid = -1; return; }
    int dev = 0, cus = 0, per_cu = 0;
    if (hipGetDevice(&dev) != hipSuccess || hipDeviceGetAttribute(&cus, hipDeviceAttributeMultiprocessorCount, dev) != hipSuccess) { grid = -1; return; }
    if (hipFuncSetAttribute((const void*)mk_fwd, hipFuncAttributeMaxDynamicSharedMemorySize, LDS_BYTES) != hipSuccess) { fprintf(stderr, "kernel_launch: hipFuncSetAttribute failed\n"); grid = -1; return; }
    if (hipOccupancyMaxActiveBlocksPerMultiprocessor(&per_cu, (const void*)mk_fwd, NTHR, LDS_BYTES) != hipSuccess || per_cu < 1) { fprintf(stderr, "kernel_launch: occupancy query says %d blocks/CU\n", per_cu); per_cu = 1; }
    (void)hipGetLastError();
    if (cus != 256) { fprintf(stderr, "kernel_launch: built for a 256-CU device (work distribution of the fused phases), found %d CUs; nothing launched\n", cus); grid = -1; return; }
    grid = cus;
  }
  if (grid < 0) return;
  Args a{};
  for (int i = 0; i < 17; ++i) a.in[i] = (const float*)d_in[i];
  a.out = (float*)d_out; a.ws = (unsigned char*)d_ws;
  const int stage_hi[6] = {0, 2, 3, 6, 7, N_PHASES};
  a.ph_lo = 0; a.ph_hi = stage_hi[MK_STAGE];
  hipLaunchKernelGGL(mk_fwd, dim3(grid), dim3(NTHR), LDS_BYTES, stream, a);
#if MK_STAGE < 5
  { unsigned char* ws = (unsigned char*)d_ws; nv::Bufs b{};
    int* rt = (int*)(ws + WS_ROUTE);
    b.cnt = rt; b.off = rt + 64; b.tpos = rt + 1024; b.tcw = (float*)(rt + 1024 + 4 * T); b.cw = (float*)(rt + 1024 + 6 * T); b.list = rt + 1024 + 8 * T;
    b.scratch = (float*)d_out;
    b.Qb = (const unsigned short*)(ws + WS_Q); b.Kb = (const unsigned short*)(ws + WS_K); b.Vb = (const unsigned short*)(ws + WS_V);
    b.HQ = (const unsigned short*)(ws + WS_HQ); b.ZF = (const unsigned short*)(ws + WS_ZF); b.ZB = (const unsigned short*)(ws + WS_ZB); b.HI = (const unsigned short*)(ws + WS_HI); b.HG = (const unsigned short*)(ws + WS_HG);
    b.mixb = (unsigned short*)(ws + WS_XN);
    b.xt = (float*)(ws + WS_Q); b.hid = (float*)(ws + WS_Q + 64 * MiB);
    nv::run(d_in, (float*)d_out, b, MK_STAGE, stream); }
#endif
}
```

```cpp
#define MK_STAGE 5

#define MK_REPEAT_MASK 0

#include <hip/hip_runtime.h>
#include <cstdio>
#include <cstdint>
#include <cmath>
namespace mk {
#define LAS __attribute__((address_space(3)))
#define GAS __attribute__((address_space(1)))
typedef unsigned short bf16_t;
typedef short bf16x8 __attribute__((ext_vector_type(8)));
typedef short s16x4 __attribute__((ext_vector_type(4)));
typedef float f32x4 __attribute__((ext_vector_type(4)));
typedef float f32x2 __attribute__((ext_vector_type(2)));
typedef float f32x16 __attribute__((ext_vector_type(16)));
typedef unsigned u32x4 __attribute__((ext_vector_type(4)));
typedef unsigned u32x2 __attribute__((ext_vector_type(2)));
typedef GAS unsigned gu32;
typedef int v4i_t __attribute__((ext_vector_type(4)));
typedef int v8i_t __attribute__((ext_vector_type(8)));

constexpr int T = 16384, DM = 1024, NCOL = 4096, NEXP = 32, FE = 512;
constexpr int NWAVES = 8, NTHR = 512;
constexpr float LOG2E = 1.4426950408889634f;

__device__ __forceinline__ unsigned cvt_pk_bf16(float lo, float hi) { unsigned r; asm volatile("v_cvt_pk_bf16_f32 %0, %1, %2" : "=v"(r) : "v"(lo), "v"(hi)); return r; }
__device__ __forceinline__ float bf2f(unsigned short h) { return __uint_as_float((unsigned)h << 16); }
__device__ __forceinline__ float bflo(unsigned w) { return __uint_as_float(w << 16); }
__device__ __forceinline__ float bfhi(unsigned w) { return __uint_as_float(w & 0xffff0000u); }
__device__ __forceinline__ float wave_sum(float v) {
#pragma unroll
  for (int o = 1; o < 64; o <<= 1) v += __shfl_xor(v, o);
  return v;
}
__device__ __forceinline__ float fexp2(float x) { return __builtin_amdgcn_exp2f(x); }
__device__ __forceinline__ float flog2(float x) { return __builtin_amdgcn_logf(x); }
__device__ __forceinline__ float fsigm(float z) { return __builtin_amdgcn_rcpf(1.f + fexp2(-LOG2E * z)); }
__device__ __forceinline__ float fsilu(float z) { return z * fsigm(z); }
__device__ __forceinline__ void st16_wt(void* p, u32x4 v) { asm volatile("global_store_dwordx4 %0, %1, off sc1\n\ts_nop 1" :: "v"(p), "v"(v) : "memory"); }
__device__ __forceinline__ unsigned pk4_fp8(float a, float b, float c_, float d) { int w = 0; w = __builtin_amdgcn_cvt_pk_fp8_f32(a, b, w, false); w = __builtin_amdgcn_cvt_pk_fp8_f32(c_, d, w, true); return (unsigned)w; }
#define LDS_WAIT() asm volatile("s_waitcnt lgkmcnt(0)" ::: "memory")
#define VM_WAIT() asm volatile("s_waitcnt vmcnt(0)" ::: "memory")

#define XB_TMO      128
#define XB_XCNT(j)  (256  + 64 * (j))
#define XB_XSUB(j)  (1280 + 64 * (j))
#define XB_XGEN(j)  (2304 + 64 * (j))
#define XB_TOP      3328
#define XB_TOPGEN   3392
#define XCD_BAR_WORDS 3456
#define XB_SPIN_CAP (1u << 22)
__device__ __forceinline__ unsigned xb_ld(unsigned* p)              { return __hip_atomic_load(p, __ATOMIC_RELAXED, __HIP_MEMORY_SCOPE_AGENT); }
__device__ __forceinline__ unsigned xb_add(unsigned* p, unsigned v) { return __hip_atomic_fetch_add(p, v, __ATOMIC_RELAXED, __HIP_MEMORY_SCOPE_AGENT); }
__device__ __forceinline__ unsigned xb_xcc_id() { return (unsigned)__builtin_amdgcn_s_getreg((3 << 11) | 20) & 0xFu; }
#define XB_SPIN(cond, bar) do { unsigned _sp = 0; while (cond) { __builtin_amdgcn_s_sleep(1); \
    if ((++_sp & 255u) == 0u) { if (xb_ld(&(bar)[XB_TMO])) break; if (_sp > XB_SPIN_CAP) { atomicAdd(&(bar)[XB_TMO], 1u); break; } } } } while (0)
__device__ __forceinline__ void xb_poll4(unsigned* p, unsigned tgt, unsigned* bar) {
  unsigned v0, v1, v2, v3, sp = 0u;
#define XB_ISSUE(v) asm volatile("global_load_dword %0, %1, off sc1" : "=v"(v) : "v"(p) : "memory")
#define XB_WAIT3(v) asm volatile("s_waitcnt vmcnt(3)" : "+v"(v) :: "memory")
  XB_ISSUE(v0); __builtin_amdgcn_s_sleep(12); XB_ISSUE(v1); __builtin_amdgcn_s_sleep(12); XB_ISSUE(v2); __builtin_amdgcn_s_sleep(12); XB_ISSUE(v3);
  for (;;) {
    XB_WAIT3(v0); if (v0 >= tgt) break; XB_ISSUE(v0);
    XB_WAIT3(v1); if (v1 >= tgt) break; XB_ISSUE(v1);
    XB_WAIT3(v2); if (v2 >= tgt) break; XB_ISSUE(v2);
    XB_WAIT3(v3); if (v3 >= tgt) break; XB_ISSUE(v3);
    if ((++sp & 63u) == 0u) { if (xb_ld(&bar[XB_TMO])) break; if (sp > (XB_SPIN_CAP >> 2)) { atomicAdd(&bar[XB_TMO], 1u); break; } }
  }
  asm volatile("s_waitcnt vmcnt(0)" : "+v"(v0), "+v"(v1), "+v"(v2), "+v"(v3) :: "memory");
#undef XB_ISSUE
#undef XB_WAIT3
}
struct XcdBarrier { unsigned* bar; unsigned x; volatile LAS unsigned* st; };
__device__ __forceinline__ XcdBarrier xcd_barrier_post(unsigned* bar, volatile LAS unsigned* st) {
  XcdBarrier b; b.bar = bar; b.x = xb_xcc_id(); b.st = st;
  if (threadIdx.x == 0) (void)xb_add(&bar[XB_XCNT(b.x)], 1u);
  return b;
}
__device__ __forceinline__ void xcd_barrier_complete(unsigned* bar, unsigned x, unsigned& nloc, unsigned& nx) {
  const unsigned G = gridDim.x * gridDim.y * gridDim.z;
  unsigned sum, cnt, mine, sp = 0u;
  for (;;) {
    sum = 0u; cnt = 0u; mine = 0u;
#pragma unroll
    for (unsigned j = 0; j < 16; ++j) { const unsigned c = xb_ld(&bar[XB_XCNT(j)]); sum += c; cnt += (c > 0u) ? 1u : 0u; mine = (j == x) ? c : mine; }
    if (sum == G) break;
    __builtin_amdgcn_s_sleep(1);
    if ((++sp & 255u) == 0u) { if (xb_ld(&bar[XB_TMO])) break; if (sp > XB_SPIN_CAP) { atomicAdd(&bar[XB_TMO], 1u); break; } }
  }
  nloc = mine > 0u ? mine : 1u; nx = cnt > 0u ? cnt : 1u;
}
__device__ __forceinline__ unsigned xb_add_l2(unsigned* p, unsigned v) { return __hip_atomic_fetch_add(p, v, __ATOMIC_RELAXED, __HIP_MEMORY_SCOPE_WORKGROUP); }
template <bool ACQ = true>
__device__ __forceinline__ void xcd_barrier(const XcdBarrier& b) {
  asm volatile("s_waitcnt vmcnt(0)" ::: "memory");
  __syncthreads();
  if (threadIdx.x == 0) {
    unsigned* bar = b.bar;
    __builtin_amdgcn_s_waitcnt(0);
    unsigned nloc = b.st[0], nx = b.st[1];
    if (nloc == 0u) { xcd_barrier_complete(bar, b.x, nloc, nx); b.st[0] = nloc; b.st[1] = nx; }
    const unsigned old = xb_add_l2(&bar[XB_XSUB(b.x)], 1u);
    const unsigned gen = old / nloc;
    if (old + 1u == (gen + 1u) * nloc) {
      __builtin_amdgcn_fence(__ATOMIC_RELEASE, "agent");
      asm volatile("s_waitcnt vmcnt(0)" ::: "memory");
      const unsigned og = xb_add(&bar[XB_TOP], 1u);
      const unsigned tgt = (og / nx + 1u) * nx;
      if (og + 1u != tgt) xb_poll4(&bar[XB_TOP], tgt, bar);
      if (ACQ) __builtin_amdgcn_fence(__ATOMIC_ACQUIRE, "agent"); else asm volatile("" ::: "memory");
      (void)xb_add_l2(&bar[XB_XGEN(b.x)], 1u);
      asm volatile("s_waitcnt vmcnt(0)" ::: "memory");
    } else {
      unsigned zero_ = 0u; asm volatile("" : "+s"(zero_));
      XB_SPIN(xb_add_l2(&bar[XB_XGEN(b.x)], zero_) == gen, bar);
      if (ACQ) __builtin_amdgcn_fence(__ATOMIC_ACQUIRE, "agent"); else asm volatile("" ::: "memory");
      asm volatile("s_waitcnt vmcnt(0)" ::: "memory");
    }
  }
  __syncthreads();
}

constexpr int BM = 256, BK = 64, HALF = 128, HTB = HALF * BK * 2, STAGE_BYTES = 8 * HTB, NXCD = 8, WGM = 8;
__device__ __forceinline__ int lds_byte(int r, int c) { const int st = (r >> 4) * 2 + (c >> 5), rr = r & 15, cc = c & 31, ob = rr * 64 + cc * 2; return st * 1024 + (ob ^ (((ob >> 9) & 1) << 5)); }
__device__ __forceinline__ void stage_rc(int b, int& R, int& C) { const int st = b / 1024, sb = b % 1024, swz = sb ^ (((sb >> 9) & 1) << 5); R = (st >> 1) * 16 + swz / 64; C = (st & 1) * 32 + (swz % 64) / 2; }
__device__ __forceinline__ int perm32(int rho) { const int n = rho >> 4, i = rho & 15; return 8 * (i >> 2) + 4 * n + (i & 3); }

struct Unit { int pm, pn, e, nrows, row0; };

template <class Prob, class Epi, bool ALIGN_EPI>
__device__ __forceinline__ void gemm_phase(LAS unsigned char* lds, const Prob& P, const Epi& E) {
  const int tid = threadIdx.x, wid = __builtin_amdgcn_readfirstlane(tid >> 6), lane = tid & 63, wr = wid >> 2, wc = wid & 3, fr = lane & 15, fq = lane >> 4;
  const int K = P.K, nt = K / BK;
  int Rr[2], Cc[2]; unsigned voffB[2];
#pragma unroll
  for (int i = 0; i < 2; ++i) { int R, C; stage_rc(tid * 16 + i * 8192, R, C); Rr[i] = R; Cc[i] = C; const int Rb = (R & ~31) + perm32(R & 31); voffB[i] = (unsigned)(Rb * K + C) * 2u; }
  const size_t kstep = (size_t)(BK * 2);
  const size_t hstep = (size_t)HALF * K * 2;
  const unsigned ldsw = (unsigned)wid * 1024u;
  const int aoff = lds_byte(wr * 64 + fr, fq * 8), boff = lds_byte(wc * 32 + fr, fq * 8);
#define PG8_SA(b, h) (((b) * 2 + (h)) * HTB)
#define PG8_SB(b, h) ((4 + (b) * 2 + (h)) * HTB)
#define PG8_STAGE(bufoff, gbase, voff) do { _Pragma("unroll") for (int _i = 0; _i < 2; ++_i) \
        __builtin_amdgcn_global_load_lds((const unsigned*)((const char*)(gbase) + (voff)[_i]), (LAS unsigned*)(lds + (bufoff) + ldsw + _i * 8192), 16, 0, 0); } while (0)
#define PG8_STAGE_X(bufoff, k_) do { int fr_ = fr, fq_ = fq; asm volatile("" : "+v"(fr_), "+v"(fq_));     \
        _Pragma("unroll") for (int _i = 0; _i < 2; ++_i) \
        __builtin_amdgcn_global_load_lds((const unsigned*)(E.xpf_src(cur, 2 * (k_) + _i, wr, wc, fr_, fq_)), (LAS unsigned*)(lds + (bufoff) + ldsw + _i * 8192), 16, 0, 0); } while (0)
#define PG8_LDA(dst, b, h) do { _Pragma("unroll") for (int m = 0; m < 4; ++m) _Pragma("unroll") for (int k = 0; k < 2; ++k) dst[m][k] = *(const LAS bf16x8*)(lds + PG8_SA(b, h) + aoff + m * 2048 + k * 1024); } while (0)
#define PG8_LDB(dst, b, h) do { _Pragma("unroll") for (int n = 0; n < 2; ++n) _Pragma("unroll") for (int k = 0; k < 2; ++k) dst[n][k] = *(const LAS bf16x8*)(lds + PG8_SB(b, h) + boff + n * 2048 + k * 1024); } while (0)
#define PG8_MMA(ai, bj, At, Bt) do { if (Prob::TAILS && ((ai) ? sk1 : skw)) break; __builtin_amdgcn_s_setprio(1); \
        if constexpr (Prob::FP8) {   \
          _Pragma("unroll") for (int m = 0; m < 4; ++m) _Pragma("unroll") for (int n = 0; n < 2; ++n) { \
            const v8i_t wa = __builtin_shufflevector(__builtin_bit_cast(v4i_t, Bt[n][0]), __builtin_bit_cast(v4i_t, Bt[n][1]), 0, 1, 2, 3, 4, 5, 6, 7); \
            const v8i_t xa = __builtin_shufflevector(__builtin_bit_cast(v4i_t, At[m][0]), __builtin_bit_cast(v4i_t, At[m][1]), 0, 1, 2, 3, 4, 5, 6, 7); \
            acc[ai][bj][m][n] = __builtin_amdgcn_mfma_scale_f32_16x16x128_f8f6f4(wa, xa, acc[ai][bj][m][n], 0, 0, 0, P.scale_w, 0, P.scale_x); } \
        } else { \
          _Pragma("unroll") for (int m = 0; m < 4; ++m) _Pragma("unroll") for (int n = 0; n < 2; ++n) _Pragma("unroll") for (int k = 0; k < 2; ++k) \
            acc[ai][bj][m][n] = __builtin_amdgcn_mfma_f32_16x16x32_bf16(Bt[n][k], At[m][k], acc[ai][bj][m][n], 0, 0, 0); } \
        __builtin_amdgcn_s_setprio(0); } while (0)
#define PG8_WAIT_V(n) asm volatile("s_waitcnt vmcnt(" #n ")" ::: "memory")
#define PG8_WAIT_L(n) asm volatile("s_waitcnt lgkmcnt(" #n ")" ::: "memory")
#define PG8_BAR __builtin_amdgcn_s_barrier()
#define PG8_SCHED __builtin_amdgcn_sched_barrier(0)
  Unit cur, nxt; int ui = 0;
  if (!P.next(0, cur)) return;
  f32x4 acc[2][2][4][2];
#pragma unroll
  for (int a = 0; a < 2; ++a)
#pragma unroll
    for (int b = 0; b < 2; ++b)
#pragma unroll
      for (int m = 0; m < 4; ++m)
#pragma unroll
        for (int n = 0; n < 2; ++n) acc[a][b][m][n] = (f32x4){0.f, 0.f, 0.f, 0.f};
  bf16x8 At[4][2], B0[2][2], B1[2][2];
  unsigned aC0[2], aC1[2], aN0[2], aN1[2];
#pragma unroll
  for (int i = 0; i < 2; ++i) { aC0[i] = P.a_row_off(cur, Rr[i]) + (unsigned)Cc[i] * 2u; aC1[i] = P.a_row_off(cur, HALF + Rr[i]) + (unsigned)Cc[i] * 2u; aN0[i] = aC0[i]; aN1[i] = aC1[i]; }
  const char* const cAb = P.Abase;
  const char* cB = P.b_rows(cur);
  PG8_STAGE(PG8_SB(0, 0), cB, voffB); PG8_STAGE(PG8_SB(0, 1), cB + hstep, voffB); PG8_STAGE(PG8_SA(0, 0), cAb, aC0); PG8_STAGE(PG8_SA(0, 1), cAb, aC1);
  if (wr == 1) PG8_BAR;
  PG8_WAIT_V(2); PG8_BAR;
  PG8_STAGE(PG8_SB(1, 0), cB + kstep, voffB); PG8_STAGE(PG8_SA(1, 0), cAb + kstep, aC0); PG8_STAGE(PG8_SB(1, 1), cB + hstep + kstep, voffB);
  PG8_WAIT_V(6); PG8_BAR;
  for (;;) {
    const bool sk1 = Prob::TAILS && (cur.nrows <= 128 || (cur.nrows <= 192 && wr == 1)), skw = Prob::TAILS && cur.nrows <= 64 && wr == 1;
    const bool has_next = P.next(ui + 1, nxt);
    const char* nB = cB;
    if (has_next) { nB = P.b_rows(nxt);
#pragma unroll
      for (int i = 0; i < 2; ++i) { aN0[i] = P.a_row_off(nxt, Rr[i]) + (unsigned)Cc[i] * 2u; aN1[i] = P.a_row_off(nxt, HALF + Rr[i]) + (unsigned)Cc[i] * 2u; }
    } else {
#pragma unroll
      for (int i = 0; i < 2; ++i) { aN0[i] = aC0[i]; aN1[i] = aC1[i]; }
    }
    for (int t = 0; t < nt; t += 2) {
      const bool last = (t == nt - 2);
      const char* a1 = cAb + (size_t)(t + 1) * kstep;
      const char* a2 = last ? cAb : cAb + (size_t)(t + 2) * kstep; const char* b2 = last ? nB : cB + (size_t)(t + 2) * kstep;
      const char* a3 = a2 + kstep; const char* b3 = b2 + kstep;
      unsigned s0[2], s1[2];
#pragma unroll
      for (int i = 0; i < 2; ++i) { s0[i] = last ? aN0[i] : aC0[i]; s1[i] = last ? aN1[i] : aC1[i]; }
      PG8_LDB(B0, 0, 0); PG8_LDB(B1, 0, 1); PG8_SCHED; PG8_LDA(At, 0, 0); PG8_STAGE(PG8_SA(1, 1), a1, aC1);
      PG8_WAIT_V(8); PG8_WAIT_L(0); PG8_BAR; PG8_MMA(0, 0, At, B0); PG8_MMA(0, 1, At, B1); PG8_BAR; PG8_SCHED;
      bool xpf = false; if constexpr (Epi::XPF) xpf = last && !has_next;
      PG8_LDA(At, 0, 1);
      if (xpf) { if constexpr (Epi::XPF) { PG8_STAGE_X(PG8_SB(0, 0), 0); PG8_STAGE_X(PG8_SB(0, 1), 1); PG8_STAGE_X(PG8_SA(0, 0), 2); } }
      else { PG8_STAGE(PG8_SB(0, 0), b2, voffB); PG8_STAGE(PG8_SB(0, 1), b2 + hstep, voffB); PG8_STAGE(PG8_SA(0, 0), a2, s0); }
      PG8_WAIT_V(8); PG8_WAIT_L(0); PG8_BAR; PG8_MMA(1, 0, At, B0); PG8_MMA(1, 1, At, B1); PG8_BAR; PG8_SCHED;
      PG8_LDB(B0, 1, 0); PG8_LDB(B1, 1, 1); PG8_SCHED; PG8_LDA(At, 1, 0);
      if (xpf) { if constexpr (Epi::XPF) { PG8_STAGE_X(PG8_SA(0, 1), 3); } } else { PG8_STAGE(PG8_SA(0, 1), a2, s1); }
      PG8_WAIT_V(8); PG8_WAIT_L(0); PG8_BAR; PG8_MMA(0, 0, At, B0); PG8_MMA(0, 1, At, B1); PG8_BAR; PG8_SCHED;
      PG8_LDA(At, 1, 1);
      if (xpf) { if constexpr (Epi::XPF) { PG8_STAGE_X(PG8_SB(1, 0), 4); PG8_STAGE_X(PG8_SB(1, 1), 5); PG8_STAGE_X(PG8_SA(1, 0), 6); } }
      else { PG8_STAGE(PG8_SB(1, 0), b3, voffB); PG8_STAGE(PG8_SB(1, 1), b3 + hstep, voffB); PG8_STAGE(PG8_SA(1, 0), a3, s0); }
      PG8_WAIT_V(8); PG8_WAIT_L(0); PG8_BAR; PG8_MMA(1, 0, At, B0); PG8_MMA(1, 1, At, B1); PG8_BAR; PG8_SCHED;
    }
    if constexpr (ALIGN_EPI) { if (wr == 0) PG8_BAR; }
    if constexpr (Epi::XPF) { if (!has_next) { PG8_WAIT_V(0);
        const unsigned xb_[7] = {PG8_SB(0, 0), PG8_SB(0, 1), PG8_SA(0, 0), PG8_SA(0, 1), PG8_SB(1, 0), PG8_SB(1, 1), PG8_SA(1, 0)};
        E.run_pf(acc, cur, wr, wc, fr, fq, lds + ldsw + (unsigned)lane * 16u, xb_); } else E(acc, cur, wr, wc, fr, fq); }
    else E(acc, cur, wr, wc, fr, fq);
#ifdef MK_DOUBLE_EPI
    if (MK_DOUBLE_EPI == Epi::ID) { asm volatile("" ::: "memory"); E(acc, cur, wr, wc, fr, fq); }
#endif
    if (!has_next) break;
#pragma unroll
    for (int a = 0; a < 2; ++a)
#pragma unroll
      for (int b = 0; b < 2; ++b)
#pragma unroll
        for (int m = 0; m < 4; ++m)
#pragma unroll
          for (int n = 0; n < 2; ++n) acc[a][b][m][n] = (f32x4){0.f, 0.f, 0.f, 0.f};
    cur = nxt; cB = nB; ++ui;
#pragma unroll
    for (int i = 0; i < 2; ++i) { aC0[i] = aN0[i]; aC1[i] = aN1[i]; }
    if constexpr (ALIGN_EPI) { if (wr == 1) PG8_BAR; }
  }
  PG8_WAIT_V(0);
  if constexpr (!ALIGN_EPI) { if (wr == 0) PG8_BAR; }
  PG8_BAR;
#undef PG8_SA
#undef PG8_SB
#undef PG8_STAGE
#undef PG8_STAGE_X
#undef PG8_LDA
#undef PG8_LDB
#undef PG8_MMA
#undef PG8_WAIT_V
#undef PG8_WAIT_L
#undef PG8_BAR
#undef PG8_SCHED
}
}
namespace mk {
constexpr size_t MiB = 1u << 20;
constexpr size_t WS_CTL = 0, CTL_ZERO_BYTES = 256 * 1024;
constexpr size_t WS_SMALL = 512 * 1024;
constexpr size_t WS_WIN = 1 * MiB;
constexpr size_t WS_WOUT = 9 * MiB;
constexpr size_t WS_ROPE = 11 * MiB;
constexpr size_t WS_ROUTE = 15 * MiB;
constexpr size_t WS_WGU = 20 * MiB;
constexpr size_t WS_XN = 84 * MiB;
constexpr size_t WS_Q = 116 * MiB;
constexpr size_t WS_K = 132 * MiB;
constexpr size_t WS_V = 148 * MiB;
constexpr size_t WS_HQ = 164 * MiB;
constexpr size_t WS_ZF = 180 * MiB;
constexpr size_t WS_ZB = 196 * MiB;
constexpr size_t WS_HI = 212 * MiB;
constexpr size_t WS_HG = 228 * MiB;
constexpr size_t WS_WD = 244 * MiB;
constexpr size_t WS_END = 276 * MiB;
constexpr int CW_BAR = 1024;
constexpr int CW_CNT = 8192;

constexpr int RING_BYTES = 131072;
constexpr int MISC_OFF = RING_BYTES + 320;
constexpr int LDS_BYTES = 147456;

__device__ __forceinline__ unsigned char* q8_base(const unsigned char* ws) { return (unsigned char*)ws + WS_ROUTE; }
__device__ __forceinline__ unsigned char* k8_base(const float* out) { return (unsigned char*)out + (size_t)49 * MiB; }
__device__ __forceinline__ unsigned char* v8_base(const float* out) { return (unsigned char*)out + (size_t)53 * MiB; }
struct Args {
  const float* in[17]; float* out; unsigned char* ws; int ph_lo, ph_hi;
};

struct Frame {
  LAS unsigned char* lds;
  volatile LAS unsigned* MISC;
  int tid, lane, wave, vcu, G;
};

__device__ __forceinline__ void transpose_item(const float* W, int ldw, int k0, int n0, bf16_t* WT, int Kdst, int dst_row0, LAS float* scr, int lane) {
  float wv_[32];
#pragma unroll
  for (int i = 0; i < 32; ++i) { const int kk = 2 * i + (lane >> 5); wv_[i] = __builtin_nontemporal_load(W + (size_t)(k0 + kk) * ldw + n0 + (lane & 31)); }
#pragma unroll
  for (int i = 0; i < 32; ++i) { const int kk = 2 * i + (lane >> 5); scr[kk * 33 + (lane & 31)] = wv_[i]; }
  LDS_WAIT(); asm volatile("" ::: "memory");
  const int c = lane & 7;
#pragma unroll
  for (int j = 0; j < 4; ++j) { const int n = (lane >> 3) + 8 * j; const LAS float* s = scr + (8 * c) * 33 + n;
    u32x4 o; o.x = cvt_pk_bf16(s[0 * 33], s[1 * 33]); o.y = cvt_pk_bf16(s[2 * 33], s[3 * 33]); o.z = cvt_pk_bf16(s[4 * 33], s[5 * 33]); o.w = cvt_pk_bf16(s[6 * 33], s[7 * 33]);
    *(GAS u32x4*)(WT + (size_t)(dst_row0 + n) * Kdst + k0 + 8 * c) = o; }
  LDS_WAIT(); asm volatile("" ::: "memory");
}
__device__ __forceinline__ int inproj_dst_col(int n0) {
  if (n0 >= 1536) { const int o = n0 & 255; return (n0 & ~255) + 128 * ((o >> 5) & 1) + 32 * (o >> 6); }
  if (n0 >= 1024) return n0;
  const int R = n0 >> 9, rem = n0 & 511, hc = rem >> 6, bj = (rem >> 5) & 1;
  return R * 512 + (hc >> 2) * 256 + bj * 128 + (hc & 3) * 32;
}
__device__ __forceinline__ void rms_row_to_bf16(const float* xrow, const float* g, bf16_t* orow, int lane) {
  const GAS f32x4* xr = (const GAS f32x4*)xrow + lane;
  f32x4 v[4]; float s = 0.f;
#pragma unroll
  for (int j = 0; j < 4; ++j) { v[j] = __builtin_nontemporal_load(xr + 64 * j); s += (v[j].x * v[j].x + v[j].y * v[j].y) + (v[j].z * v[j].z + v[j].w * v[j].w); }
  const float rstd = 1.f / sqrtf(wave_sum(s) * (1.f / DM) + 1e-6f);
  GAS u32x2* o8 = (GAS u32x2*)orow + lane;
#pragma unroll
  for (int j = 0; j < 4; ++j) { const f32x4 gg = ((const GAS f32x4*)g)[lane + 64 * j]; u32x2 w; w.x = cvt_pk_bf16(v[j].x * rstd * gg.x, v[j].y * rstd * gg.y); w.y = cvt_pk_bf16(v[j].z * rstd * gg.z, v[j].w * rstd * gg.w); o8[64 * j] = w; }
}

template <bool MOE_W>
__device__ __forceinline__ void p0_prologue(Frame& F, const Args& a) {
  LAS float* scr = (LAS float*)(F.lds + F.wave * 16384);
  const int gw = F.vcu * NWAVES + F.wave, NGW = F.G * NWAVES;
  const float* w_in = a.in[1]; const float* w_out = a.in[2];
  bf16_t* WinT = (bf16_t*)(a.ws + WS_WIN); bf16_t* WoutT = (bf16_t*)(a.ws + WS_WOUT);
  constexpr int I_IN = 16 * 128, I_OUT = 16 * 32, I_G = 32 * 16 * 16, I_D = 32 * 8 * 32;
  const int NITEMS = I_IN + I_OUT + (MOE_W ? (2 * I_G + I_D) : 0);
  for (int it = gw; it < NITEMS; it += NGW) {
    int r = it;
    if (r < I_IN) { const int kb = r / 128, nb = r % 128; transpose_item(w_in, NCOL, 64 * kb, 32 * nb, WinT, DM, inproj_dst_col(32 * nb), scr, F.lane); continue; } r -= I_IN;
    if (r < I_OUT) { const int kb = r / 32, nb = r % 32; transpose_item(w_out, DM, 64 * kb, 32 * nb, WoutT, DM, 32 * nb, scr, F.lane); continue; } r -= I_OUT;
    if (MOE_W) {
      bf16_t* WguT = (bf16_t*)(a.ws + WS_WGU); bf16_t* WdT = (bf16_t*)(a.ws + WS_WD);
      if (r < 2 * I_G) { const int which = r / I_G; r -= which * I_G; const int e = r / 256, q = r % 256, kb = q / 16, nb = q % 16;
        const float* W = (which ? a.in[14] : a.in[13]) + (size_t)e * DM * FE; const int f0 = 32 * nb;
        transpose_item(W, FE, 64 * kb, f0, WguT + (size_t)e * 1024 * DM, DM, (f0 >> 7) * 256 + which * 128 + (f0 & 127), scr, F.lane); continue; } r -= 2 * I_G;
      { const int e = r / 256, q = r % 256, kb = q / 32, nb = q % 32;
        transpose_item(a.in[15] + (size_t)e * FE * DM, DM, 64 * kb, 32 * nb, WdT + (size_t)e * DM * FE, FE, 32 * nb, scr, F.lane); }
    }
  }
  { const float* x = a.in[0]; bf16_t* XN = (bf16_t*)(a.ws + WS_XN);
    for (int m = gw; m < T; m += NGW) rms_row_to_bf16(x + (size_t)m * DM, a.in[3], XN + (size_t)m * DM, F.lane); }
  { float* cs = (float*)(a.ws + WS_ROPE); float* sn = cs + (size_t)T * 32;
    const int gt = F.vcu * NTHR + F.tid, NGT = F.G * NTHR;
    for (int idx = gt; idx < T * 32; idx += NGT) { const int j = idx & 31, t = idx >> 5;
      const float inv = powf(10000.0f, -(float)(2 * j) / 64.0f); const float ang = (float)t * inv;
      const double ad = (double)ang; const double kq = rint(ad * 0.15915494309189535); const float rr = (float)(ad - kq * 6.283185307179586);
      cs[idx] = cosf(rr); sn[idx] = sinf(rr); } }
  if (F.vcu == 0 && F.wave == 0) {
    float* sm = (float*)(a.ws + WS_SMALL); const float* lp = a.in[4];
    float d1 = lp[F.lane] * lp[64 + F.lane], d2 = lp[128 + F.lane] * lp[192 + F.lane];
    d1 = wave_sum(d1); d2 = wave_sum(d2);
    if (F.lane == 0) sm[0] = expf(d1) - expf(d2) + 0.2f;
    const float* lbl = a.in[7];
    for (int i = F.lane; i < 1024; i += 64) { const int dir = i >> 9, c = i & 511; const float a0 = lbl[(dir * 2 + 0) * 512 + c], a1 = lbl[(dir * 2 + 1) * 512 + c];
      const float mx = fmaxf(a0, a1); const float e0 = expf(a0 - mx), e1 = expf(a1 - mx); sm[64 + i] = e0 / (e0 + e1); }
  }
}

struct ProbPlain {
  static constexpr bool TAILS = false, FP8 = false; static constexpr int scale_w = 0, scale_x = 0;
  int K; const char* Abase; const char* Bt; int nM, nN, nwg, G, c;
  __device__ __forceinline__ void init(const void* A, const void* B, int M, int N, int K_, int G_, int c_) { Abase = (const char*)A; Bt = (const char*)B; K = K_; nM = M / BM; nN = N / BM; nwg = nM * nN; G = G_; c = c_; }
  __device__ __forceinline__ bool next(int i, Unit& u) const {
    const long L = (long)i * G + c; if (L >= nwg) return false;
    int wgid = (int)L; { const int q = nwg / NXCD, r = nwg % NXCD, xcd = wgid % NXCD, off = wgid / NXCD; wgid = (xcd < r ? xcd * (q + 1) : r * (q + 1) + (xcd - r) * q) + off; }
    const int nig = WGM * nN, gid = wgid / nig, fm = gid * WGM, gsz = (nM - fm) < WGM ? (nM - fm) : WGM;
    u.pm = fm + ((wgid % nig) % gsz); u.pn = (wgid % nig) / gsz; u.e = 0; u.nrows = 256; u.row0 = u.pm * 256; return true;
  }
  __device__ __forceinline__ unsigned a_row_off(const Unit& u, int r) const { return (unsigned)(u.pm * BM + r) * (unsigned)K * 2u; }
  __device__ __forceinline__ const char* b_rows(const Unit& u) const { return Bt + (size_t)u.pn * BM * K * 2; }
};

struct EpiInProj { static constexpr int ID = 1; static constexpr bool XPF = false;
  unsigned char* ws; const float* cs; const float* sn; const float* out;
  __device__ __forceinline__ void operator()(const f32x4 (&acc)[2][2][4][2], const Unit& u, int wr, int wc, int fr, int fq) const {
    const int row0 = u.pm * BM + wr * 64 + fr, pn = u.pn;
    if (pn < 4) {
      bf16_t* base = (bf16_t*)(ws + (pn < 2 ? WS_Q : WS_K)) + (size_t)(4 * (pn & 1) + wc) * T * 64;
#pragma unroll
      for (int ai = 0; ai < 2; ++ai)
#pragma unroll
        for (int m = 0; m < 4; ++m) { const int t = row0 + ai * HALF + m * 16;
          const f32x4 c0 = *(const f32x4*)(cs + (size_t)t * 32 + 8 * fq), c1 = *(const f32x4*)(cs + (size_t)t * 32 + 8 * fq + 4);
          const f32x4 s0 = *(const f32x4*)(sn + (size_t)t * 32 + 8 * fq), s1 = *(const f32x4*)(sn + (size_t)t * 32 + 8 * fq + 4);
          const f32x4 x1a = acc[ai][0][m][0], x1b = acc[ai][0][m][1], x2a = acc[ai][1][m][0], x2b = acc[ai][1][m][1];
          const float qs = pn < 2 ? 0.125f * LOG2E : 1.f;
          const f32x4 o1a = (x1a * c0 - x2a * s0) * qs, o1b = (x1b * c1 - x2b * s1) * qs, o2a = (x1a * s0 + x2a * c0) * qs, o2b = (x1b * s1 + x2b * c1) * qs;
          u32x4 w1, w2; w1.x = cvt_pk_bf16(o1a[0], o1a[1]); w1.y = cvt_pk_bf16(o1a[2], o1a[3]); w1.z = cvt_pk_bf16(o1b[0], o1b[1]); w1.w = cvt_pk_bf16(o1b[2], o1b[3]);
          w2.x = cvt_pk_bf16(o2a[0], o2a[1]); w2.y = cvt_pk_bf16(o2a[2], o2a[3]); w2.z = cvt_pk_bf16(o2b[0], o2b[1]); w2.w = cvt_pk_bf16(o2b[2], o2b[3]);
          bf16_t* rp = base + (size_t)t * 64 + 8 * fq;
          if (!(wc & 1)) { st16_wt(rp, w1); st16_wt(rp + 32, w2); }
          if (wc & 1) {
            const float f8s = pn < 2 ? 4.f : 0.25f;
            unsigned char* p8 = (pn < 2 ? q8_base(ws) : k8_base(out)) + ((size_t)(2 * (pn & 1) + (wc >> 1)) * T + t) * 64 + 8 * fq;
            u32x2 e1, e2; e1.x = pk4_fp8(o1a[0] * f8s, o1a[1] * f8s, o1a[2] * f8s, o1a[3] * f8s); e1.y = pk4_fp8(o1b[0] * f8s, o1b[1] * f8s, o1b[2] * f8s, o1b[3] * f8s);
            e2.x = pk4_fp8(o2a[0] * f8s, o2a[1] * f8s, o2a[2] * f8s, o2a[3] * f8s); e2.y = pk4_fp8(o2b[0] * f8s, o2b[1] * f8s, o2b[2] * f8s, o2b[3] * f8s);
            *(GAS u32x2*)p8 = e1; *(GAS u32x2*)(p8 + 32) = e2; } }
    } else if (pn < 6) {
      int fr_ = fr, fq_ = fq; asm volatile("" : "+v"(fr_), "+v"(fq_));
      const unsigned dd = (unsigned)((fr_ & 3) + 4 * (fr_ >> 3));
      const unsigned v8lane = (unsigned)((fr_ >> 2) & 1) * 4096u + (dd >> 2) * 2048u + (dd & 3) * 4u + (unsigned)(wc * 32 + 8 * fq_) * 16u;
#pragma unroll
      for (int bj = 0; bj < 2; ++bj) { bf16_t* base = (bf16_t*)(ws + WS_V) + (size_t)(2 * (pn - 4) + bj) * T * 128 + wc * 32 + 8 * fq;
#pragma unroll
        for (int ai = 0; ai < 2; ++ai) {
#pragma unroll
          for (int m = 0; m < 4; ++m) { asm volatile("" ::: "memory"); const int t = row0 + ai * HALF + m * 16; const f32x4 v0 = acc[ai][bj][m][0], v1 = acc[ai][bj][m][1];
            u32x4 w; w.x = cvt_pk_bf16(v0[0], v0[1]); w.y = cvt_pk_bf16(v0[2], v0[3]); w.z = cvt_pk_bf16(v1[0], v1[1]); w.w = cvt_pk_bf16(v1[2], v1[3]);
            st16_wt(base + (size_t)t * 128, w); }
          { unsigned char* v8 = v8_base(out) + (size_t)(2 * (pn - 4) + bj) * (256 * 8192) + (size_t)(u.pm * 4 + ai * 2 + wr) * 8192u + v8lane;
#pragma unroll
            for (int n = 0; n < 2; ++n)
#pragma unroll
              for (int i = 0; i < 4; ++i)
                *(GAS unsigned*)(v8 + (4 * n + i) * 16) = pk4_fp8(acc[ai][bj][0][n][i], acc[ai][bj][1][n][i], acc[ai][bj][2][n][i], acc[ai][bj][3][n][i]); } } }
    } else {
      const int reg = (pn - 6) >> 1; const bool act = (reg == 0) || (reg == 4);
      bf16_t* base = (bf16_t*)(ws + WS_HQ + (size_t)reg * 16 * MiB) + ((pn - 6) & 1) * 256 + wc * 64 + 8 * fq;
#pragma unroll
      for (int ai = 0; ai < 2; ++ai)
#pragma unroll
        for (int m = 0; m < 4; ++m)
#pragma unroll
          for (int bj = 0; bj < 2; ++bj) { const int t = row0 + ai * HALF + m * 16; f32x4 v0 = acc[ai][bj][m][0], v1 = acc[ai][bj][m][1];
            if (act) {
#pragma unroll
              for (int i = 0; i < 4; ++i) { v0[i] = fsilu(v0[i]); v1[i] = fsilu(v1[i]); } }
            u32x4 w; w.x = cvt_pk_bf16(v0[0], v0[1]); w.y = cvt_pk_bf16(v0[2], v0[3]); w.z = cvt_pk_bf16(v1[0], v1[1]); w.w = cvt_pk_bf16(v1[2], v1[3]);
            st16_wt(base + (size_t)t * 512 + bj * 32, w); }
    }
  }
};
}
namespace mk {
namespace att {
constexpr int NW = 8, QBLK = 32, KVBLK = 64, DV = 128, DQK = 64;
constexpr float SCALE = 1.0f / LOG2E;
constexpr float THR = 8.f;
constexpr int SHM_V = KVBLK * DV * 2, SHM_K = KVBLK * DQK * 2;
constexpr int SHM_ATTN = 2 * SHM_V + 2 * SHM_K + NW * 64 * 4;
#define KSWZ(row, colB) ((row) * 128 + ((colB) ^ ((((row) >> 1) & 7) << 4)))
#define SBAR() __builtin_amdgcn_sched_barrier(0)
__device__ __forceinline__ int crow(int r, int hi) { return (r & 3) + 8 * (r >> 2) + 4 * hi; }

__device__ __forceinline__ void partialSM(f32x16& p0, f32x16& p1, float& m_reg, float& mn, float& alpha) {
  constexpr float C = SCALE * LOG2E;
  float pmax = p0[0];
#pragma unroll
  for (int r = 1; r < 16; ++r) pmax = fmaxf(pmax, p0[r]);
#pragma unroll
  for (int r = 0; r < 16; ++r) pmax = fmaxf(pmax, p1[r]);
  { auto rr = __builtin_amdgcn_permlane32_swap(__float_as_uint(pmax), __float_as_uint(pmax), false, false);
    pmax = fmaxf(__uint_as_float(rr[0]), __uint_as_float(rr[1])); }
  if (__builtin_expect(__all(pmax - m_reg <= THR / SCALE), 1)) { mn = m_reg; alpha = 1.f; }
  else { mn = fmaxf(m_reg, pmax); alpha = __builtin_amdgcn_exp2f((m_reg - mn) * C); m_reg = mn; }
  const float mnC = -mn * C;
#pragma unroll
  for (int r = 0; r < 16; ++r) p0[r] = fmaf(p0[r], C, mnC);
#pragma unroll
  for (int r = 0; r < 16; ++r) p1[r] = fmaf(p1[r], C, mnC);
#pragma unroll
  for (int r = 0; r < 16; ++r) p0[r] = __builtin_amdgcn_exp2f(p0[r]);
}
__device__ __forceinline__ void finishSM(f32x16& p0, f32x16& p1, float alpha, float& l_reg, bf16x8& pa0, bf16x8& pa1, bf16x8& pa2, bf16x8& pa3) {
#pragma unroll
  for (int r = 0; r < 16; ++r) p1[r] = __builtin_amdgcn_exp2f(p1[r]);
  float ps = 0;
#pragma unroll
  for (int r = 0; r < 16; ++r) ps += p0[r];
#pragma unroll
  for (int r = 0; r < 16; ++r) ps += p1[r];
  { auto rr = __builtin_amdgcn_permlane32_swap(__float_as_uint(ps), __float_as_uint(ps), false, false);
    ps = __uint_as_float(rr[0]) + __uint_as_float(rr[1]); }
  l_reg = l_reg * alpha + ps;
#define PK4(P, BASE, OUT) do { unsigned a0 = cvt_pk_bf16(P[BASE + 0], P[BASE + 1]), a1 = cvt_pk_bf16(P[BASE + 2], P[BASE + 3]);   \
    unsigned b0 = cvt_pk_bf16(P[BASE + 4], P[BASE + 5]), b1 = cvt_pk_bf16(P[BASE + 6], P[BASE + 7]);                              \
    auto r0 = __builtin_amdgcn_permlane32_swap(a0, b0, false, false); auto r1 = __builtin_amdgcn_permlane32_swap(a1, b1, false, false); \
    u32x4 w = {r0[0], r1[0], r0[1], r1[1]}; OUT = __builtin_bit_cast(bf16x8, w); } while (0)
  PK4(p0, 0, pa0); PK4(p0, 8, pa1); PK4(p1, 0, pa2); PK4(p1, 8, pa3);
#undef PK4
}
__device__ __forceinline__ void qkt(f32x16& p0, f32x16& p1, const LAS char* Ks, const bf16x8* qr, int r32, int hi) {
  p0 = f32x16{}; p1 = f32x16{};
#pragma unroll
  for (int d0 = 0; d0 < 4; ++d0) { const int cb = (d0 * 16 + hi * 8) * 2;
    const bf16x8 b0 = *(const LAS bf16x8*)(Ks + KSWZ(r32, cb));
    const bf16x8 b1 = *(const LAS bf16x8*)(Ks + KSWZ(32 + r32, cb));
    p0 = __builtin_amdgcn_mfma_f32_32x32x16_bf16(b0, qr[d0], p0, 0, 0, 0);
    p1 = __builtin_amdgcn_mfma_f32_32x32x16_bf16(b1, qr[d0], p1, 0, 0, 0); }
}
__device__ __forceinline__ int v_st(int k, int c) { const int kk = (k & ~0xC) | ((k & 4) << 1) | ((k & 8) >> 1); return ((kk >> 3) * 4 + (c >> 5)) * 512 + ((kk & 7) * 32 + (c & 31)) * 2; }
__device__ __forceinline__ int v_rd_base(int lane) { return ((lane & 3) << 3) | (((lane >> 2) & 3) << 6) | (((lane >> 4) & 1) << 5) | (((lane >> 5) & 1) << 8); }
constexpr int v_rd_off(int d0, int ks, int half) { return d0 * 512 + ks * 4096 + half * 2048; }
template <int OFF> __device__ __forceinline__ s16x4 tr_read(int vb) {
  s16x4 r; asm volatile("ds_read_b64_tr_b16 %0, %1 offset:%2" : "=&v"(r) : "v"(vb), "i"(OFF) : "memory"); return r;
}
template <int D0> __device__ __forceinline__ void pv_one(f32x16& od, int vb, bf16x8 pa0, bf16x8 pa1, bf16x8 pa2, bf16x8 pa3) {
  const s16x4 l0 = tr_read<v_rd_off(D0, 0, 0)>(vb), h0 = tr_read<v_rd_off(D0, 0, 1)>(vb), l1 = tr_read<v_rd_off(D0, 1, 0)>(vb), h1 = tr_read<v_rd_off(D0, 1, 1)>(vb);
  const s16x4 l2 = tr_read<v_rd_off(D0, 2, 0)>(vb), h2 = tr_read<v_rd_off(D0, 2, 1)>(vb), l3 = tr_read<v_rd_off(D0, 3, 0)>(vb), h3 = tr_read<v_rd_off(D0, 3, 1)>(vb);
  asm volatile("s_waitcnt lgkmcnt(0)" ::: "memory"); SBAR();
#define PK(L, H) (bf16x8){L[0], L[1], L[2], L[3], H[0], H[1], H[2], H[3]}
  od = __builtin_amdgcn_mfma_f32_32x32x16_bf16(pa0, PK(l0, h0), od, 0, 0, 0);
  od = __builtin_amdgcn_mfma_f32_32x32x16_bf16(pa1, PK(l1, h1), od, 0, 0, 0);
  od = __builtin_amdgcn_mfma_f32_32x32x16_bf16(pa2, PK(l2, h2), od, 0, 0, 0);
  od = __builtin_amdgcn_mfma_f32_32x32x16_bf16(pa3, PK(l3, h3), od, 0, 0, 0);
#undef PK
}
__device__ __forceinline__ void pv_d0(f32x16* o, int vb, bf16x8 pa0, bf16x8 pa1, bf16x8 pa2, bf16x8 pa3) {
  pv_one<0>(o[0], vb, pa0, pa1, pa2, pa3); pv_one<1>(o[1], vb, pa0, pa1, pa2, pa3); pv_one<2>(o[2], vb, pa0, pa1, pa2, pa3); pv_one<3>(o[3], vb, pa0, pa1, pa2, pa3);
}

typedef float f32x2_c __attribute__((ext_vector_type(2)));
__device__ __forceinline__ bf16x8 fp8x8_to_bf16(u32x2 raw) {
  const f32x2_c a = __builtin_amdgcn_cvt_pk_f32_fp8((int)raw.x, false), b = __builtin_amdgcn_cvt_pk_f32_fp8((int)raw.x, true), c = __builtin_amdgcn_cvt_pk_f32_fp8((int)raw.y, false), d = __builtin_amdgcn_cvt_pk_f32_fp8((int)raw.y, true);
  u32x4 w; w.x = cvt_pk_bf16(a[0], a[1]); w.y = cvt_pk_bf16(b[0], b[1]); w.z = cvt_pk_bf16(c[0], c[1]); w.w = cvt_pk_bf16(d[0], d[1]); return __builtin_bit_cast(bf16x8, w);
}
template <bool F8QK>
__device__ __forceinline__ void attn_pass(int tid, const void* __restrict__ Qb_, const void* __restrict__ Kh_, const bf16_t* __restrict__ Vh, int seq, LAS char* lds, f32x16 (&o)[4], float (&rli)[16]) {
  const bf16_t* Qb = (const bf16_t*)Qb_; const bf16_t* Kh = (const bf16_t*)Kh_; const unsigned char* Q8 = (const unsigned char*)Qb_; const unsigned char* K8 = (const unsigned char*)Kh_;
  const int wid = tid >> 6, lane = tid & 63, r32 = lane & 31, hi = lane >> 5;
  LAS char* V_lds = lds; LAS char* K_lds = lds + 2 * SHM_V;
  LAS float* ws = (LAS float*)(lds + 2 * SHM_V + 2 * SHM_K) + wid * 64; LAS float* li_l = ws; LAS float* al_l = ws + 32;
  float m_reg = -1e30f, l_reg = 0;
#pragma unroll
  for (int d = 0; d < 4; ++d) o[d] = f32x16{};
  bf16x8 qr[4];
  const long qoff = (long)(wid * QBLK + r32) * DQK + hi * 8;
#pragma unroll
  for (int d0 = 0; d0 < 4; ++d0) { if (F8QK) qr[d0] = fp8x8_to_bf16(*(const u32x2*)(Q8 + qoff + d0 * 16)); else qr[d0] = *(const bf16x8*)(Qb + qoff + d0 * 16); }
  const int sr = tid >> 4, sc = (tid & 15) * 8, vst0 = v_st(sr, sc), vst1 = v_st(32 + sr, sc);
  const int kr = tid >> 3, kc = (tid & 7) * 8, kst = KSWZ(kr, kc * 2);
  const int vb0 = (int)(uintptr_t)V_lds + v_rd_base(lane);
  struct { bf16x8 vs0, vs1, ks0; } sr_[2];
#define SLOAD(i, k0) do { sr_[i].vs0 = *(const bf16x8*)(&Vh[(long)((k0) + sr) * DV + sc]); sr_[i].vs1 = *(const bf16x8*)(&Vh[(long)((k0) + 32 + sr) * DV + sc]); \
    if (F8QK) sr_[i].ks0 = fp8x8_to_bf16(*(const u32x2*)(K8 + (long)((k0) + kr) * DQK + kc)); else sr_[i].ks0 = *(const bf16x8*)(&Kh[(long)((k0) + kr) * DQK + kc]); } while (0)
#define SWRITE(b, i) do { *(LAS bf16x8*)(V_lds + (b) * SHM_V + vst0) = sr_[i].vs0; *(LAS bf16x8*)(V_lds + (b) * SHM_V + vst1) = sr_[i].vs1; \
    *(LAS bf16x8*)(K_lds + (b) * SHM_K + kst) = sr_[i].ks0; } while (0)
#define SWAIT() asm volatile("s_waitcnt vmcnt(3)" ::: "memory")
#define RESC(a) do { if (__any((a) < 1.f)) { if (hi == 0) al_l[r32] = (a); asm volatile("s_waitcnt lgkmcnt(0)" ::: "memory"); \
    _Pragma("unroll") for (int d = 0; d < 4; ++d) _Pragma("unroll") for (int r = 0; r < 16; ++r) o[d][r] *= al_l[crow(r, hi)]; } } while (0)
  f32x16 pA0, pA1, pB0, pB1; float mnA, mnB, alA, alB; bf16x8 pa0, pa1, pa2, pa3; const int NT = seq / KVBLK;
  constexpr int SE = 0, SO = 1;
  SLOAD(SE, 0); asm volatile("s_waitcnt vmcnt(0)" ::: "memory"); SWRITE(0, SE); __syncthreads();
  qkt(pA0, pA1, K_lds, qr, r32, hi); partialSM(pA0, pA1, m_reg, mnA, alA);
  SLOAD(SO, KVBLK); if (2 < NT) SLOAD(SE, 2 * KVBLK);
  SWAIT(); SWRITE(1, SO); __syncthreads();
  for (int j = 1; j + 1 < NT; j += 2) {
    SBAR(); qkt(pB0, pB1, K_lds + SHM_K, qr, r32, hi);
    finishSM(pA0, pA1, alA, l_reg, pa0, pa1, pa2, pa3); SBAR();
    SLOAD(SO, (j + 2) * KVBLK); SBAR();
    pv_d0(o, vb0, pa0, pa1, pa2, pa3); partialSM(pB0, pB1, m_reg, mnB, alB);
    __syncthreads(); SWAIT(); SWRITE(0, SE);
    RESC(alB); __syncthreads();
    SBAR(); qkt(pA0, pA1, K_lds, qr, r32, hi);
    finishSM(pB0, pB1, alB, l_reg, pa0, pa1, pa2, pa3); SBAR();
    if (j + 3 < NT) SLOAD(SE, (j + 3) * KVBLK); SBAR();
    pv_d0(o, vb0 + SHM_V, pa0, pa1, pa2, pa3); partialSM(pA0, pA1, m_reg, mnA, alA);
    __syncthreads(); SWAIT(); SWRITE(1, SO);
    RESC(alA); __syncthreads();
  }
  SBAR(); qkt(pB0, pB1, K_lds + SHM_K, qr, r32, hi);
  finishSM(pA0, pA1, alA, l_reg, pa0, pa1, pa2, pa3); SBAR();
  pv_d0(o, vb0, pa0, pa1, pa2, pa3); partialSM(pB0, pB1, m_reg, mnB, alB);
  __syncthreads(); RESC(alB);
  finishSM(pB0, pB1, alB, l_reg, pa0, pa1, pa2, pa3); SBAR();
  pv_d0(o, vb0 + SHM_V, pa0, pa1, pa2, pa3);
  if (hi == 0) li_l[r32] = l_reg; asm volatile("s_waitcnt lgkmcnt(0)" ::: "memory");
#pragma unroll
  for (int r = 0; r < 16; ++r) rli[r] = __builtin_amdgcn_rcpf(li_l[crow(r, hi)]);
  __syncthreads();
#undef SLOAD
#undef SWRITE
#undef SWAIT
#undef RESC
}

#undef KSWZ
#undef SBAR
}
}
namespace mk {
namespace atf {
constexpr int NW = 8, KSLOT = 8192, VSLOT = 16384, NKS = 6, NVS = 5;
constexpr int LDS_K = 0, LDS_V = NKS * KSLOT, LDS_WS = 133120, LDS_FLAG = LDS_WS + NW * 64 * 4, LDS_BYTES_ATT = LDS_FLAG + 64;
#define SBAR() __builtin_amdgcn_sched_barrier(0)
#define WAIT_BAR(N) asm volatile("s_waitcnt vmcnt(" #N ") lgkmcnt(0)\n\ts_barrier" ::: "memory")
__device__ __forceinline__ int crow(int r, int hi) { return (r & 3) + 8 * (r >> 2) + 4 * hi; }
__device__ __forceinline__ void glds16s(const void* sbase, unsigned voff, unsigned lds_dst) { unsigned keep;
  const unsigned long long a = (unsigned long long)sbase; const unsigned lo = (unsigned)__builtin_amdgcn_readfirstlane((int)(unsigned)a), hi = (unsigned)__builtin_amdgcn_readfirstlane((int)(unsigned)(a >> 32));
  const unsigned long long sb = ((unsigned long long)hi << 32) | lo;
  asm volatile("s_mov_b32 %0, m0\n\ts_mov_b32 m0, %3\n\ts_nop 0\n\tglobal_load_lds_dwordx4 %1, %2\n\ts_mov_b32 m0, %0" : "=&s"(keep) : "v"(voff), "s"(sb), "s"(lds_dst) : "memory"); }
__device__ __forceinline__ void glds16(const void* gsrc, unsigned lds_dst) { unsigned keep;
  asm volatile("s_mov_b32 %0, m0\n\ts_mov_b32 m0, %2\n\ts_nop 0\n\tglobal_load_lds_dwordx4 %1, off\n\ts_mov_b32 m0, %0" : "=&s"(keep) : "v"(gsrc), "s"(lds_dst) : "memory"); }
typedef float f32x2_t __attribute__((ext_vector_type(2))); typedef __bf16 bf16x2_t __attribute__((ext_vector_type(2)));
__device__ __forceinline__ unsigned cvtpk_s(float lo, float hi) { f32x2_t v = {lo, hi}; bf16x2_t b = __builtin_convertvector(v, bf16x2_t); return __builtin_bit_cast(unsigned, b); }
typedef LAS const char* lds_cptr;
typedef short v4i16_t __attribute__((ext_vector_type(4)));
__device__ __forceinline__ s16x4 vtr(lds_cptr p) { return __builtin_bit_cast(s16x4, __builtin_amdgcn_ds_read_tr16_b64_v4i16((LAS v4i16_t*)p)); }
__device__ __forceinline__ bf16x8 kld(lds_cptr p) { return *(const LAS bf16x8*)p; }

__device__ __forceinline__ bool attn_pass_fast(unsigned long long* stamp_out, int tid, const bf16_t* __restrict__ Qb, const bf16_t* __restrict__ Kh, const bf16_t* __restrict__ Vh, int seq, LAS char* lds, f32x16 (&o)[4], float (&rli)[16]) {
  const int lane = tid & 63, r32 = lane & 31, hi = lane >> 5; const int wid = __builtin_amdgcn_readfirstlane(tid >> 6);
  const unsigned lds0 = (unsigned)(uintptr_t)lds;
  LAS float* wsf = (LAS float*)(lds + LDS_WS) + wid * 64;
  const bf16_t* ksrc = Kh + wid * 8;
  const bf16_t* vsrc = Vh + (long)(16 * (wid & 3)) * 128 + (wid >> 2) * 32;
  const unsigned kvo = (unsigned)lane * 128u, vvo = (unsigned)(lane >> 2) * 256u + (unsigned)(lane & 3) * 16u;
  const unsigned kdst = lds0 + LDS_K + wid * 1024, vdst = lds0 + LDS_V + wid * 1024;
#define DMA_K(t, slot) glds16s(ksrc + (long)(t) * 4096, kvo, (unsigned)__builtin_amdgcn_readfirstlane(kdst + (slot)))
#define DMA_V(t, slot) do { glds16s(vsrc + (long)(t) * 8192, vvo, (unsigned)__builtin_amdgcn_readfirstlane(vdst + (slot))); glds16s(vsrc + (long)(t) * 8192 + 64, vvo, (unsigned)__builtin_amdgcn_readfirstlane(vdst + (slot) + 8192)); } while (0)
  const lds_cptr shm3 = (lds_cptr)lds; const lds_cptr kp0 = shm3 + LDS_K + hi * 1024 + r32 * 16;
  const lds_cptr vp0 = shm3 + LDS_V + ((lane >> 4) & 1) * 32 + (lane & 3) * 8 + (4 * hi + ((lane & 15) >> 2)) * 64;
  const int NT = seq / 64;
  DMA_K(0, 0); DMA_V(0, 0); DMA_K(1, KSLOT); DMA_K(2, 2 * KSLOT); DMA_K(3, 3 * KSLOT); DMA_V(1, VSLOT);
  bf16x8 qr[4];
  { const bf16_t* Qw = Qb + (long)(wid * 32 + r32) * 64 + hi * 8;
#pragma unroll
    for (int d0 = 0; d0 < 4; ++d0) qr[d0] = *(const bf16x8*)(Qw + d0 * 16); }
#pragma unroll
  for (int d = 0; d < 4; ++d) o[d] = f32x16{};
  float l_reg = 0.f; f32x16 negm = f32x16{};
  asm volatile("s_waitcnt vmcnt(0)" ::: "memory");
  WAIT_BAR(0);
  f32x16 pA0, pA1, pB0, pB1;
  bf16x8 kfA[4], kfB[4];
  { f32x16 c0 = f32x16{}, c1 = f32x16{};
#pragma unroll
    for (int d0 = 0; d0 < 4; ++d0) { c0 = __builtin_amdgcn_mfma_f32_32x32x16_bf16(kld(kp0 + d0 * 2048), qr[d0], c0, 0, 0, 0); c1 = __builtin_amdgcn_mfma_f32_32x32x16_bf16(kld(kp0 + d0 * 2048 + 512), qr[d0], c1, 0, 0, 0); }
    float m = c0[0];
#pragma unroll
    for (int r = 1; r < 16; ++r) m = fmaxf(m, c0[r]);
#pragma unroll
    for (int r = 0; r < 16; ++r) m = fmaxf(m, c1[r]);
    { auto rr = __builtin_amdgcn_permlane32_swap(__float_as_uint(m), __float_as_uint(m), false, false); m = fmaxf(__uint_as_float(rr[0]), __uint_as_float(rr[1])); }
#pragma unroll
    for (int r = 0; r < 16; ++r) negm[r] = -m;
    asm volatile("" : "+v"(negm)); }
#pragma unroll
  for (int d0 = 0; d0 < 4; ++d0) { pA0 = __builtin_amdgcn_mfma_f32_32x32x16_bf16(kld(kp0 + d0 * 2048), qr[d0], d0 == 0 ? negm : pA0, 0, 0, 0); pA1 = __builtin_amdgcn_mfma_f32_32x32x16_bf16(kld(kp0 + d0 * 2048 + 512), qr[d0], d0 == 0 ? negm : pA1, 0, 0, 0); }
#pragma unroll
  for (int r = 0; r < 16; ++r) { pA0[r] = __builtin_amdgcn_exp2f(pA0[r]); pA1[r] = __builtin_amdgcn_exp2f(pA1[r]); }
  if (4 < NT) DMA_K(4, 4 * KSLOT);
  if (2 < NT) DMA_V(2, 2 * VSLOT);
#pragma unroll
  for (int d0 = 0; d0 < 4; ++d0) kfA[d0] = kld(kp0 + KSLOT + d0 * 2048);
  WAIT_BAR(0);
  u32x4 pw0, pw1, pw2, pw3; s16x4 vl[4], vh[4];
#define PKW(P, B) cvtpk_s(P[B], P[B + 1])
#define PAF(k) __builtin_bit_cast(bf16x8, pw##k)
#define VFR(i) (bf16x8){vl[i][0], vl[i][1], vl[i][2], vl[i][3], vh[i][0], vh[i][1], vh[i][2], vh[i][3]}
#define PIN(x) asm volatile("" : "+v"(x))
#define GAPA(MF, A0, A1, W0, W1, PW) do { MF; sacc += A0; sacc += A1; PIN(sacc); W0; W1; PIN(PW); SBAR(); } while (0)
#define EX(v) __builtin_amdgcn_exp2f(v)
#define GAPB(MF, X, B, SA) do { MF; X[B] = EX(X[B]); X[B + 1] = EX(X[B + 1]); PIN(X); sacc += SA; PIN(sacc); SBAR(); } while (0)
#define VRD(i, f) do { vl[i] = vtr(vp_ + (f) * 1024); vh[i] = vtr(vp_ + (f) * 1024 + 512); } while (0)
#define STEP(C0, C1, P0, P1, t, svp, svn, GK, GV, GL) do { SBAR(); \
    const lds_cptr kq_ = kp0 + k_0; const lds_cptr kn_ = kp0 + k_1; const lds_cptr vp_ = vp0 + (svp); \
    kfB[0] = kld(kq_ + 512); kfB[1] = kld(kq_ + 2048 + 512); SBAR(); float sacc = 0.f; \
    GAPA(C0 = __builtin_amdgcn_mfma_f32_32x32x16_bf16(kfA[0], qr[0], negm, 0, 0, 0), P0[0], P0[1],   pw0[0] = PKW(P0, 0), pw0[1] = PKW(P0, 2), pw0); \
    kfB[2] = kld(kq_ + 4096 + 512); kfB[3] = kld(kq_ + 6144 + 512); SBAR(); \
    GAPA(C0 = __builtin_amdgcn_mfma_f32_32x32x16_bf16(kfA[1], qr[1], C0, 0, 0, 0),   P0[2], P0[3],   pw0[2] = PKW(P0, 4), pw0[3] = PKW(P0, 6), pw0); \
    VRD(0, 0); SBAR(); \
    GAPA(C0 = __builtin_amdgcn_mfma_f32_32x32x16_bf16(kfA[2], qr[2], C0, 0, 0, 0),   P0[4], P0[5], pw1[0] = PKW(P0, 8), pw1[1] = PKW(P0, 10), pw1); \
    VRD(1, 1); SBAR(); \
    GAPA(C0 = __builtin_amdgcn_mfma_f32_32x32x16_bf16(kfA[3], qr[3], C0, 0, 0, 0),   P0[6], P0[7],   pw1[2] = PKW(P0, 12), pw1[3] = PKW(P0, 14), pw1); \
    VRD(2, 2); SBAR(); \
    GAPA(C1 = __builtin_amdgcn_mfma_f32_32x32x16_bf16(kfB[0], qr[0], negm, 0, 0, 0), P0[8], P0[9],   pw2[0] = PKW(P1, 0), pw2[1] = PKW(P1, 2), pw2); \
    VRD(3, 3); SBAR(); \
    GAPA(C1 = __builtin_amdgcn_mfma_f32_32x32x16_bf16(kfB[1], qr[1], C1, 0, 0, 0),   P0[10], P0[11],   pw2[2] = PKW(P1, 4), pw2[3] = PKW(P1, 6), pw2); \
    GAPA(C1 = __builtin_amdgcn_mfma_f32_32x32x16_bf16(kfB[2], qr[2], C1, 0, 0, 0),   P0[12], P0[13], pw3[0] = PKW(P1, 8), pw3[1] = PKW(P1, 10), pw3); \
    GAPA(C1 = __builtin_amdgcn_mfma_f32_32x32x16_bf16(kfB[3], qr[3], C1, 0, 0, 0),   P0[14], P0[15],     pw3[2] = PKW(P1, 12), pw3[3] = PKW(P1, 14), pw3); \
    if (GK) { DMA_K((t) + 4, k_m2); } if (GV) { DMA_V((t) + 2, (svn)); } \
    SBAR(); \
    GAPB(o[0] = __builtin_amdgcn_mfma_f32_32x32x16_bf16(PAF(0), VFR(0), o[0], 0, 0, 0), C0, 0, P1[0]);  VRD(0, 4); SBAR(); \
    GAPB(o[0] = __builtin_amdgcn_mfma_f32_32x32x16_bf16(PAF(1), VFR(1), o[0], 0, 0, 0), C0, 2, P1[1]);  VRD(1, 5); SBAR(); \
    GAPB(o[0] = __builtin_amdgcn_mfma_f32_32x32x16_bf16(PAF(2), VFR(2), o[0], 0, 0, 0), C0, 4, P1[2]);  VRD(2, 6); SBAR(); \
    GAPB(o[0] = __builtin_amdgcn_mfma_f32_32x32x16_bf16(PAF(3), VFR(3), o[0], 0, 0, 0), C0, 6, P1[3]);  VRD(3, 7); SBAR(); \
    GAPB(o[1] = __builtin_amdgcn_mfma_f32_32x32x16_bf16(PAF(0), VFR(0), o[1], 0, 0, 0), C0, 8, P1[4]);  VRD(0, 8); SBAR(); \
    GAPB(o[1] = __builtin_amdgcn_mfma_f32_32x32x16_bf16(PAF(1), VFR(1), o[1], 0, 0, 0), C0, 10, P1[5]); VRD(1, 9); SBAR(); \
    GAPB(o[1] = __builtin_amdgcn_mfma_f32_32x32x16_bf16(PAF(2), VFR(2), o[1], 0, 0, 0), C0, 12, P1[6]); VRD(2, 10); SBAR(); \
    GAPB(o[1] = __builtin_amdgcn_mfma_f32_32x32x16_bf16(PAF(3), VFR(3), o[1], 0, 0, 0), C0, 14, P1[7]); VRD(3, 11); SBAR(); \
    GAPB(o[2] = __builtin_amdgcn_mfma_f32_32x32x16_bf16(PAF(0), VFR(0), o[2], 0, 0, 0), C1, 0, P1[8]);  VRD(0, 12); SBAR(); \
    GAPB(o[2] = __builtin_amdgcn_mfma_f32_32x32x16_bf16(PAF(1), VFR(1), o[2], 0, 0, 0), C1, 2, P1[9]);  VRD(1, 13); SBAR(); \
    GAPB(o[2] = __builtin_amdgcn_mfma_f32_32x32x16_bf16(PAF(2), VFR(2), o[2], 0, 0, 0), C1, 4, P1[10]);  VRD(2, 14); SBAR(); \
    GAPB(o[2] = __builtin_amdgcn_mfma_f32_32x32x16_bf16(PAF(3), VFR(3), o[2], 0, 0, 0), C1, 6, P1[11]);  VRD(3, 15); SBAR(); \
    if (GL) { kfA[0] = kld(kn_); kfA[1] = kld(kn_ + 2048); SBAR(); } \
    GAPB(o[3] = __builtin_amdgcn_mfma_f32_32x32x16_bf16(PAF(0), VFR(0), o[3], 0, 0, 0), C1, 8, P1[12]); \
    GAPB(o[3] = __builtin_amdgcn_mfma_f32_32x32x16_bf16(PAF(1), VFR(1), o[3], 0, 0, 0), C1, 10, P1[13]); \
    if (GL) { kfA[2] = kld(kn_ + 4096); kfA[3] = kld(kn_ + 6144); SBAR(); } \
    GAPB(o[3] = __builtin_amdgcn_mfma_f32_32x32x16_bf16(PAF(2), VFR(2), o[3], 0, 0, 0), C1, 12, P1[14]); \
    GAPB(o[3] = __builtin_amdgcn_mfma_f32_32x32x16_bf16(PAF(3), VFR(3), o[3], 0, 0, 0), C1, 14, P1[15]); \
    l_reg += sacc; \
  } while (0)
  int svn = 4 * VSLOT, sv_m2 = 3 * VSLOT, svp = 0, svc = VSLOT, svc1 = 2 * VSLOT;
  int k_m2 = 5 * KSLOT, k_m1 = 0, k_0 = KSLOT, k_1 = 2 * KSLOT, k_2 = 3 * KSLOT, k_3 = 4 * KSLOT;
#define ROT() do { const int tmp_ = svn; svn = sv_m2; sv_m2 = svp; svp = svc; svc = svc1; svc1 = tmp_; const int tk_ = k_m2; k_m2 = k_m1; k_m1 = k_0; k_0 = k_1; k_1 = k_2; k_2 = k_3; k_3 = tk_; } while (0)
  int t = 1;
#ifdef MK_STAMP
  unsigned long long st_c0 = 0, st_r0 = 0; if (stamp_out) { st_c0 = __builtin_amdgcn_s_memtime(); st_r0 = __builtin_amdgcn_s_memrealtime(); }
#endif
#if defined(MK_STAMP) && MK_STAMP == 4
  unsigned long long st_bar = 0;
#define TWAIT_BAR3() do { const unsigned long long b0_ = __builtin_amdgcn_s_memtime(); WAIT_BAR(3); const unsigned long long b1_ = __builtin_amdgcn_s_memtime(); asm volatile("s_waitcnt lgkmcnt(0)" ::: "memory"); st_bar += b1_ - b0_; } while (0)
#else
#define TWAIT_BAR3() WAIT_BAR(3)
#endif
  for (; t + 5 < NT; t += 2) {
    STEP(pB0, pB1, pA0, pA1, t, svp, svn, true, true, true);     ROT();
    STEP(pA0, pA1, pB0, pB1, t + 1, svp, svn, true, true, true); TWAIT_BAR3(); ROT();
  }
#if defined(MK_STAMP) && MK_STAMP == 4
  if (stamp_out) stamp_out[4] = st_bar;
#endif
#ifdef MK_STAMP
  if (stamp_out) { const unsigned long long c1 = __builtin_amdgcn_s_memtime(), r1 = __builtin_amdgcn_s_memrealtime(); stamp_out[0] = c1 - st_c0; stamp_out[1] = r1 - st_r0; stamp_out[2] = (unsigned long long)(t - 1); }
#endif
  for (; t + 1 < NT; t += 2) {
    STEP(pB0, pB1, pA0, pA1, t, svp, svn, (t + 4 < NT), (t + 2 < NT), (t + 1 < NT));       WAIT_BAR(0); ROT();
    STEP(pA0, pA1, pB0, pB1, t + 1, svp, svn, (t + 5 < NT), (t + 3 < NT), (t + 2 < NT));   WAIT_BAR(0); ROT();
  }
  STEP(pB0, pB1, pA0, pA1, NT - 1, svp, svn, false, false, false); ROT();
  { float sacc = pB0[0] + pB0[1];
#pragma unroll
    for (int r = 2; r < 16; ++r) sacc += pB0[r];
#pragma unroll
    for (int r = 0; r < 16; ++r) sacc += pB1[r];
    l_reg += sacc;
    pw0 = (u32x4){PKW(pB0, 0), PKW(pB0, 2), PKW(pB0, 4), PKW(pB0, 6)}; pw1 = (u32x4){PKW(pB0, 8), PKW(pB0, 10), PKW(pB0, 12), PKW(pB0, 14)};
    pw2 = (u32x4){PKW(pB1, 0), PKW(pB1, 2), PKW(pB1, 4), PKW(pB1, 6)}; pw3 = (u32x4){PKW(pB1, 8), PKW(pB1, 10), PKW(pB1, 12), PKW(pB1, 14)};
    WAIT_BAR(0);
    const lds_cptr vp_ = vp0 + svp;
#pragma unroll
    for (int d0 = 0; d0 < 4; ++d0) { VRD(0, 4 * d0); VRD(1, 4 * d0 + 1); VRD(2, 4 * d0 + 2); VRD(3, 4 * d0 + 3);
      o[d0] = __builtin_amdgcn_mfma_f32_32x32x16_bf16(PAF(0), VFR(0), o[d0], 0, 0, 0); o[d0] = __builtin_amdgcn_mfma_f32_32x32x16_bf16(PAF(1), VFR(1), o[d0], 0, 0, 0);
      o[d0] = __builtin_amdgcn_mfma_f32_32x32x16_bf16(PAF(2), VFR(2), o[d0], 0, 0, 0); o[d0] = __builtin_amdgcn_mfma_f32_32x32x16_bf16(PAF(3), VFR(3), o[d0], 0, 0, 0); } }
  { auto rr = __builtin_amdgcn_permlane32_swap(__float_as_uint(l_reg), __float_as_uint(l_reg), false, false); l_reg = __uint_as_float(rr[0]) + __uint_as_float(rr[1]); }
  const bool bad = __any(!(l_reg > 1e-30f && l_reg < 1e30f));
  LAS int* flag = (LAS int*)(lds + LDS_FLAG);
  if (hi == 0) wsf[32 + r32] = l_reg;
  if (lane == 0) flag[wid] = bad ? 1 : 0;
  WAIT_BAR(0);
#pragma unroll
  for (int r = 0; r < 16; ++r) rli[r] = __builtin_amdgcn_rcpf(wsf[32 + crow(r, hi)]);
  int anybad = 0;
#pragma unroll
  for (int w = 0; w < 8; ++w) anybad |= flag[w];
  WAIT_BAR(0);
#ifdef MK_FORCE_FALLBACK
  return false;
#else
  return anybad == 0;
#endif
#undef DMA_K
#undef DMA_V
#undef PKW
#undef PAF
#undef VFR
#undef PIN
#undef GAPA
#undef EX
#undef GAPB
#undef VRD
#undef STEP
#undef ROT
}
#undef SBAR
#undef WAIT_BAR
}
}

namespace mk {
namespace at8 {
constexpr int KS8 = 4096, VS8 = 8192, NKS = 8, NVS = 8, LDS_K = 0, LDS_V = NKS * KS8;
constexpr int DK = 6, DV = 4;
constexpr float P_OFF = 2.f;
#define SBAR() __builtin_amdgcn_sched_barrier(0)
#define WAIT_BAR(N) asm volatile("s_waitcnt vmcnt(" #N ") lgkmcnt(0)\n\ts_barrier" ::: "memory")
typedef LAS const char* lds_cptr;
__device__ __forceinline__ v4i_t ld16(lds_cptr p) { return *(const LAS v4i_t*)p; }
__device__ __forceinline__ v8i_t cat8(v4i_t a, v4i_t b) { return __builtin_shufflevector(a, b, 0, 1, 2, 3, 4, 5, 6, 7); }
#define MF8(A, B, C, SA, SB) __builtin_amdgcn_mfma_scale_f32_32x32x64_f8f6f4(A, B, C, 0, 0, 0, SA, 0, SB)

__device__ __forceinline__ bool attn_pass_fp8(int tid, const unsigned char* __restrict__ Q8b, const unsigned char* __restrict__ K8h, const unsigned char* __restrict__ V8h, int seq, LAS char* lds, f32x16 (&o)[4], float (&rli)[16]) {
  const int lane = tid & 63, r32 = lane & 31, hi = lane >> 5; const int wid = __builtin_amdgcn_readfirstlane(tid >> 6);
  const unsigned lds0 = (unsigned)(uintptr_t)lds;
  const unsigned char* ksrc = K8h + (wid & 3) * 16;
  const unsigned char* vsrc = V8h + wid * 1024;
  const unsigned kvo = (unsigned)lane * 64u, vvo = (unsigned)lane * 16u;
  const unsigned kdst = lds0 + LDS_K + (wid & 3) * 1024, vdst = lds0 + LDS_V + wid * 1024;
#define DMA_K(t, slot) atf::glds16s(ksrc + (long)(t) * 4096, kvo, (unsigned)__builtin_amdgcn_readfirstlane(kdst + (slot)))
#define DMA_V(t, slot) atf::glds16s(vsrc + (long)(t) * 8192, vvo, (unsigned)__builtin_amdgcn_readfirstlane(vdst + (slot)))
  const lds_cptr shm3 = (lds_cptr)lds; const lds_cptr kp0 = shm3 + LDS_K + hi * 2048 + r32 * 16; const lds_cptr vp0 = shm3 + LDS_V + hi * 4096 + r32 * 16;
  const int NT = seq / 64;
  DMA_K(0, 0); DMA_V(0, 0); DMA_K(1, KS8); DMA_V(1, VS8); DMA_K(2, 2 * KS8); DMA_K(3, 3 * KS8); DMA_V(2, 2 * VS8); DMA_K(4, 4 * KS8); DMA_V(3, 3 * VS8); DMA_K(5, 5 * KS8);
  v8i_t qf;
  { const unsigned char* Qw = Q8b + (long)(wid * 32 + r32) * 64 + hi * 32; qf = cat8(*(const v4i_t*)Qw, *(const v4i_t*)(Qw + 16)); }
#pragma unroll
  for (int d = 0; d < 4; ++d) o[d] = f32x16{};
  f32x16 lacc = f32x16{}, negm = f32x16{};
  int one_ = 0x38383838; asm volatile("" : "+v"(one_));
  const v8i_t ones = {one_, one_, one_, one_, one_, one_, one_, one_};
  constexpr int SK = 0, SQ = 0, S1 = 0;
  asm volatile("s_waitcnt vmcnt(0)" ::: "memory");
  WAIT_BAR(0);
  f32x16 pA0, pA1, pB0, pB1;
  v8i_t kfA, kfB;
#define KLD(p) cat8(ld16(p), ld16((p) + 1024))
  { kfA = KLD(kp0); kfB = KLD(kp0 + 512);
    const f32x16 c0 = MF8(kfA, qf, f32x16{}, SK, SQ), c1 = MF8(kfB, qf, f32x16{}, SK, SQ);
    float m = c0[0];
#pragma unroll
    for (int r = 1; r < 16; ++r) m = fmaxf(m, c0[r]);
#pragma unroll
    for (int r = 0; r < 16; ++r) m = fmaxf(m, c1[r]);
    { auto rr = __builtin_amdgcn_permlane32_swap(__float_as_uint(m), __float_as_uint(m), false, false); m = fmaxf(__uint_as_float(rr[0]), __uint_as_float(rr[1])); }
#pragma unroll
    for (int r = 0; r < 16; ++r) negm[r] = P_OFF - m;
    asm volatile("" : "+v"(negm));
    pA0 = MF8(kfA, qf, negm, SK, SQ); pA1 = MF8(kfB, qf, negm, SK, SQ); }
#pragma unroll
  for (int r = 0; r < 16; ++r) { pA0[r] = __builtin_amdgcn_exp2f(pA0[r]); pA1[r] = __builtin_amdgcn_exp2f(pA1[r]); }
  if (DK < NT) DMA_K(DK, DK * KS8);
  if (DV < NT) DMA_V(DV, DV * VS8);
  kfA = KLD(kp0 + KS8);
  WAIT_BAR(0);
  v8i_t pw = {0, 0, 0, 0, 0, 0, 0, 0}, vf0, vf1, vf2, vf3;
#define PIN(x) asm volatile("" : "+v"(x))
#define PK4D(W, P0_, P1_, D) do { W = __builtin_amdgcn_cvt_pk_fp8_f32(P0_[D], P0_[(D) + 8], W, false); W = __builtin_amdgcn_cvt_pk_fp8_f32(P1_[D], P1_[(D) + 8], W, true); } while (0)
#define EX(v) __builtin_amdgcn_exp2f(v)
#define EX8(X, B) do { X[B] = EX(X[B]); X[B + 1] = EX(X[B + 1]); X[B + 2] = EX(X[B + 2]); X[B + 3] = EX(X[B + 3]); X[B + 4] = EX(X[B + 4]); X[B + 5] = EX(X[B + 5]); X[B + 6] = EX(X[B + 6]); X[B + 7] = EX(X[B + 7]); PIN(X); } while (0)
#define VLD(d0) cat8(ld16(vp_ + (d0) * 512), ld16(vp_ + (d0) * 512 + 2048))
#ifdef AT8_LSUM_VALU
  float l_reg = 0.f;
#define LSUM_STEP(P0, P1) do { float s0_ = (P0[0] + P0[1]) + (P0[2] + P0[3]), s1_ = (P1[0] + P1[1]) + (P1[2] + P1[3]); \
    s0_ += (P0[4] + P0[5]) + (P0[6] + P0[7]); s1_ += (P1[4] + P1[5]) + (P1[6] + P1[7]); s0_ += (P0[8] + P0[9]) + (P0[10] + P0[11]); s1_ += (P1[8] + P1[9]) + (P1[10] + P1[11]); \
    s0_ += (P0[12] + P0[13]) + (P0[14] + P0[15]); s1_ += (P1[12] + P1[13]) + (P1[14] + P1[15]); l_reg += s0_ + s1_; } while (0)
#else
#define LSUM_STEP(P0, P1) lacc = MF8(pw, ones, lacc, S1, S1)
#endif
#define KSL(x) ((((x)) & 7) * KS8)
#define VSL(x) ((((x)) & 7) * VS8)
#define STEPX(C0, C1, P0, P1, t, ts, GK, GV, GL) do { SBAR(); \
    const lds_cptr kq_ = kp0 + KSL(ts); const lds_cptr kn_ = kp0 + KSL((ts) + 1); const lds_cptr vp_ = vp0 + VSL((ts) - 1); \
    kfB = KLD(kq_ + 512); vf0 = VLD(0); SBAR(); \
    C0 = MF8(kfA, qf, negm, SK, SQ); \
    PK4D(pw[0], P0, P1, 0); PK4D(pw[1], P0, P1, 1); PK4D(pw[2], P0, P1, 2); PK4D(pw[3], P0, P1, 3); PIN(pw); vf1 = VLD(1); SBAR(); \
    C1 = MF8(kfB, qf, negm, SK, SQ); \
    PK4D(pw[4], P0, P1, 4); PK4D(pw[5], P0, P1, 5); PK4D(pw[6], P0, P1, 6); PK4D(pw[7], P0, P1, 7); PIN(pw); vf2 = VLD(2); vf3 = VLD(3); \
    if (GK) { DMA_K((t) + DK, KSL((ts) + DK)); } if (GV) { DMA_V((t) + DV, VSL((ts) + DV)); } \
    SBAR(); \
    o[0] = MF8(pw, vf0, o[0], S1, S1); EX8(C0, 0); SBAR(); \
    o[1] = MF8(pw, vf1, o[1], S1, S1); EX8(C0, 8); SBAR(); \
    o[2] = MF8(pw, vf2, o[2], S1, S1); EX8(C1, 0); SBAR(); \
    if (GL) { kfA = KLD(kn_); SBAR(); } \
    o[3] = MF8(pw, vf3, o[3], S1, S1); EX8(C1, 8); SBAR(); \
    LSUM_STEP(P0, P1); \
  } while (0)
#define STEP(C0, C1, P0, P1, t, GK, GV, GL) STEPX(C0, C1, P0, P1, t, t, GK, GV, GL)
  int t = 1;
  for (; t + 7 + DK < NT; t += 8) {
    STEPX(pB0, pB1, pA0, pA1, t, 1, true, true, true);     STEPX(pA0, pA1, pB0, pB1, t + 1, 2, true, true, true); WAIT_BAR(6);
    STEPX(pB0, pB1, pA0, pA1, t + 2, 3, true, true, true); STEPX(pA0, pA1, pB0, pB1, t + 3, 4, true, true, true); WAIT_BAR(6);
    STEPX(pB0, pB1, pA0, pA1, t + 4, 5, true, true, true); STEPX(pA0, pA1, pB0, pB1, t + 5, 6, true, true, true); WAIT_BAR(6);
    STEPX(pB0, pB1, pA0, pA1, t + 6, 7, true, true, true); STEPX(pA0, pA1, pB0, pB1, t + 7, 8, true, true, true); WAIT_BAR(6);
  }
  for (; t + 1 + DK < NT; t += 2) {
    STEP(pB0, pB1, pA0, pA1, t, true, true, true);
    STEP(pA0, pA1, pB0, pB1, t + 1, true, true, true); WAIT_BAR(6);
  }
  for (; t + 1 < NT; t += 2) {
    STEP(pB0, pB1, pA0, pA1, t, (t + DK < NT), (t + DV < NT), (t + 1 < NT));           WAIT_BAR(0);
    STEP(pA0, pA1, pB0, pB1, t + 1, (t + 1 + DK < NT), (t + 1 + DV < NT), (t + 2 < NT));   WAIT_BAR(0);
  }
  STEP(pB0, pB1, pA0, pA1, NT - 1, false, false, false);
  { PK4D(pw[0], pB0, pB1, 0); PK4D(pw[1], pB0, pB1, 1); PK4D(pw[2], pB0, pB1, 2); PK4D(pw[3], pB0, pB1, 3); PK4D(pw[4], pB0, pB1, 4); PK4D(pw[5], pB0, pB1, 5); PK4D(pw[6], pB0, pB1, 6); PK4D(pw[7], pB0, pB1, 7);
    WAIT_BAR(0);
    const lds_cptr vp_ = vp0 + VSL(NT - 1);
    vf0 = VLD(0); vf1 = VLD(1); vf2 = VLD(2); vf3 = VLD(3);
    o[0] = MF8(pw, vf0, o[0], S1, S1); o[1] = MF8(pw, vf1, o[1], S1, S1); o[2] = MF8(pw, vf2, o[2], S1, S1); o[3] = MF8(pw, vf3, o[3], S1, S1); LSUM_STEP(pB0, pB1); }
  float chk = 0.f; bool bad = false;
#ifdef AT8_LSUM_VALU
  { auto rr = __builtin_amdgcn_permlane32_swap(__float_as_uint(l_reg), __float_as_uint(l_reg), false, false); l_reg = __uint_as_float(rr[0]) + __uint_as_float(rr[1]);
    LAS float* wsf = (LAS float*)(lds + atf::LDS_WS) + wid * 64; if (hi == 0) wsf[32 + r32] = l_reg; asm volatile("s_waitcnt lgkmcnt(0)" ::: "memory");
#pragma unroll
    for (int r = 0; r < 16; ++r) lacc[r] = wsf[32 + atf::crow(r, hi)]; }
#endif
#pragma unroll
  for (int r = 0; r < 16; ++r) { bad |= !(lacc[r] > 1e-30f && lacc[r] < 1e30f); rli[r] = __builtin_amdgcn_rcpf(lacc[r]); chk += (fabsf(o[0][r]) + fabsf(o[1][r])) + (fabsf(o[2][r]) + fabsf(o[3][r])); }
  bad |= !(chk < 1e30f);
  LAS int* flag = (LAS int*)(lds + atf::LDS_FLAG);
  if (lane == 0) flag[wid] = __any(bad) ? 1 : 0;
  else (void)__any(bad);
  WAIT_BAR(0);
  int anybad = 0;
#pragma unroll
  for (int w = 0; w < 8; ++w) anybad |= flag[w];
  WAIT_BAR(0);
#ifdef MK_FORCE_FALLBACK
  return false;
#else
  return anybad == 0;
#endif
#undef DMA_K
#undef DMA_V
#undef KLD
#undef PIN
#undef PK4D
#undef EX
#undef EX8
#undef VLD
#undef STEP
#undef STEPX
#undef KSL
#undef VSL
#undef LSUM_STEP
}
#undef MF8
#undef SBAR
#undef WAIT_BAR
}
}

namespace mk {
namespace att2 {
__device__ __forceinline__ void attn_unit_a(int h, int qb, const unsigned char* ws, float* stash, LAS char* lds) {
  const bf16_t* Q = (const bf16_t*)(ws + WS_Q); const bf16_t* K = (const bf16_t*)(ws + WS_K); const bf16_t* V = (const bf16_t*)(ws + WS_V);
  f32x16 o[4]; float rli[16];
  { int tid = threadIdx.x; asm volatile("" : "+v"(tid));
    if (!atf::attn_pass_fast(nullptr, tid, Q + ((size_t)(2 * h) * T + (size_t)qb * 256) * 64, K + (size_t)(2 * h) * T * 64, V + (size_t)h * T * 128, T, lds, o, rli))
      att::attn_pass<false>(tid, Q + ((size_t)(2 * h) * T + (size_t)qb * 256) * 64, K + (size_t)(2 * h) * T * 64, V + (size_t)h * T * 128, T, lds, o, rli); }
  { int tid = threadIdx.x; asm volatile("" : "+v"(tid));
    float* st = stash + (size_t)(tid >> 6) * 4096 + (tid & 63);
    asm volatile("" : "+v"(st) :: "memory");
#pragma unroll
    for (int d = 0; d < 4; ++d)
#pragma unroll
      for (int r = 0; r < 16; ++r) st[(d * 16 + r) * 64] = o[d][r] * rli[r];
    asm volatile("s_waitcnt vmcnt(0)" ::: "memory"); __builtin_amdgcn_sched_barrier(0); }
}
__device__ __forceinline__ void attn_unit_b(int h, int qb, const unsigned char* ws, const float* __restrict__ subg, float* stash, const unsigned char* q8, const unsigned char* k8, const unsigned char* v8, LAS char* lds) {
  const bf16_t* V = (const bf16_t*)(ws + WS_V);
  f32x16 o[4]; float rli[16];
  { int tid = threadIdx.x; asm volatile("" : "+v"(tid));
    if (!at8::attn_pass_fp8(tid, q8 + ((size_t)h * T + (size_t)qb * 256) * 64, k8 + (size_t)h * T * 64, v8 + (size_t)h * (256 * 8192), T, lds, o, rli))
      att::attn_pass<true>(tid, q8 + ((size_t)h * T + (size_t)qb * 256) * 64, k8 + (size_t)h * T * 64, V + (size_t)h * T * 128, T, lds, o, rli); }
  int tid = threadIdx.x; asm volatile("" : "+v"(tid));
  const int wid = tid >> 6, lane = tid & 63, r32 = lane & 31, hi = lane >> 5;
  const float lam = *(const float*)(ws + WS_SMALL);
  float* st = stash + (size_t)wid * 4096 + lane;
  asm volatile("" : "+v"(st) :: "memory");
  float ss[16];
#pragma unroll
  for (int r = 0; r < 16; ++r) ss[r] = 0.f;
#pragma unroll
  for (int d = 0; d < 4; ++d) {
#pragma unroll
    for (int r = 0; r < 16; ++r) { const float a = st[(d * 16 + r) * 64] - lam * (o[d][r] * rli[r]); o[d][r] = a; ss[r] += a * a; }
    if (d & 1) { asm volatile("" ::: "memory"); __builtin_amdgcn_sched_barrier(0); } }
#pragma unroll
  for (int r = 0; r < 16; ++r) { float s = ss[r]; s += __shfl_xor(s, 1); s += __shfl_xor(s, 2); s += __shfl_xor(s, 4); s += __shfl_xor(s, 8); s += __shfl_xor(s, 16);
    ss[r] = 0.8f / sqrtf(s * (1.f / 128.f) + 1e-5f); }
  bf16_t* mix = (bf16_t*)(ws + WS_XN);
#pragma unroll
  for (int d = 0; d < 4; ++d) { const float g = subg[d * 32 + r32];
#pragma unroll
    for (int r = 0; r < 16; ++r) { const int t = qb * 256 + wid * 32 + att::crow(r, hi);
      mix[(size_t)t * DM + h * 128 + d * 32 + r32] = (bf16_t)(cvt_pk_bf16(o[d][r] * ss[r] * g, 0.f) & 0xffffu); } }
}
}
}
namespace mk {
namespace hg {
constexpr int C = 64, LSC = 512, NCH = LSC / C, NSC = T / LSC;
constexpr int L_QT = 0, L_KT = 16384, L_KH = 32768, L_VT = 49152, L_GB = 65536  , L_AT = 98304  ,
              L_SEG = 106496  , L_DL = 108544  , L_END = 109056;
__device__ __forceinline__ int crow(int r, int hi) { return (r & 3) + 8 * (r >> 2) + 4 * hi; }
__device__ __forceinline__ unsigned off_b(unsigned row, unsigned ch) { return 256u * row + 16u * (ch ^ (((row & 3) << 2) | ((row >> 2) & 3))); }
__device__ __forceinline__ unsigned row_read_addr(unsigned lane, unsigned s) { return off_b(lane & 31, 2 * s + (lane >> 5)); }
__device__ __forceinline__ unsigned tr_read_addr(unsigned lane, unsigned c, unsigned ks, unsigned t) {
  const unsigned h = lane >> 5, blk = (lane >> 4) & 1, q = (lane & 15) >> 2, p = lane & 3;
  return off_b(16 * ks + 8 * h + 4 * t + q, 4 * c + 2 * blk + (p >> 1)) + 8 * (p & 1);
}
__device__ __forceinline__ s16x4 trd(const LAS unsigned char* p) { typedef short v4i16_t __attribute__((ext_vector_type(4))); return __builtin_bit_cast(s16x4, __builtin_amdgcn_ds_read_tr16_b64_v4i16((LAS v4i16_t*)p)); }
__device__ __forceinline__ bf16x8 tr_frag(const LAS unsigned char* img, unsigned lane, unsigned c, unsigned kk) {
  const LAS unsigned char* base = img + 8192u * (kk >> 1);
  const s16x4 lo = trd(base + tr_read_addr(lane, c, kk & 1, 0)), hi = trd(base + tr_read_addr(lane, c, kk & 1, 1));
  return (bf16x8){lo[0], lo[1], lo[2], lo[3], hi[0], hi[1], hi[2], hi[3]};
}
__device__ __forceinline__ bf16x8 row_frag(const LAS unsigned char* img, unsigned lane, unsigned rt, unsigned s) {
  return *(const LAS bf16x8*)(img + 8192u * rt + row_read_addr(lane, s));
}
__device__ __forceinline__ unsigned at_off(unsigned row, unsigned chunk) { return row * 128u + ((chunk ^ ((row >> 1) & 7u)) << 4); }


constexpr int BG_ITEMS = 3 * 16384;
struct BgItem { const float* src; unsigned char* dst; int ldw, kdst; };
__device__ __forceinline__ BgItem bg_decode(int id, const float* wg, const float* wu, const float* wd, unsigned char* ws) {
  BgItem it;
  if (id < 32768) { const int which = id >> 14, r = id & 16383, e = r >> 9, rem = r & 511, kb = rem >> 4, nb = rem & 15, f0 = 32 * nb;
    it.src = (which ? wu : wg) + (size_t)e * DM * FE + (size_t)(32 * kb) * FE + f0; it.ldw = FE;
    it.dst = ws + WS_WGU + (size_t)e * 1024 * DM + (size_t)((f0 >> 7) * 256 + which * 128 + (f0 & 127)) * DM + 32 * kb; it.kdst = DM;
  } else { const int r = id - 32768, e = r >> 9, rem = r & 511, kb = rem >> 5, nb = rem & 31;
    it.src = wd + (size_t)e * FE * DM + (size_t)(32 * kb) * DM + 32 * nb; it.ldw = DM;
    it.dst = ws + WS_WD + (size_t)e * DM * FE + (size_t)(32 * nb) * FE + 32 * kb; it.kdst = FE; }
  return it;
}
struct BgRegs { float v[16]; };
__device__ __forceinline__ const char* sgpr_ptr(const void* p) { const unsigned long long a = (unsigned long long)p;
  const unsigned lo = (unsigned)__builtin_amdgcn_readfirstlane((int)(unsigned)a), hi = (unsigned)__builtin_amdgcn_readfirstlane((int)(unsigned)(a >> 32)); return (const char*)(((unsigned long long)hi << 32) | lo); }
__device__ __forceinline__ void bg_load(BgRegs& R, const BgItem& it, int lane) {
  const char* sb = sgpr_ptr(it.src); const unsigned ldb = (unsigned)__builtin_amdgcn_readfirstlane(it.ldw) * 4u;
  const unsigned lo = (unsigned)(lane >> 5) * ldb + (unsigned)(lane & 31) * 4u;
#pragma unroll
  for (int i = 0; i < 16; ++i) R.v[i] = __builtin_nontemporal_load((const GAS float*)(sb + (size_t)(2u * i) * ldb + lo));
}
__device__ __forceinline__ void bg_store(const BgRegs& R, const BgItem& it, LAS float* scr, int lane) {
#pragma unroll
  for (int i = 0; i < 16; ++i) scr[(2 * i + (lane >> 5)) * 33 + (lane & 31)] = R.v[i];
  LDS_WAIT(); asm volatile("" ::: "memory");
  { const int c = lane & 1, n = lane >> 1; const LAS float* s = scr + (16 * c) * 33 + n;
    u32x4 o; o.x = pk4_fp8(s[0 * 33] * 32.f, s[1 * 33] * 32.f, s[2 * 33] * 32.f, s[3 * 33] * 32.f); o.y = pk4_fp8(s[4 * 33] * 32.f, s[5 * 33] * 32.f, s[6 * 33] * 32.f, s[7 * 33] * 32.f);
    o.z = pk4_fp8(s[8 * 33] * 32.f, s[9 * 33] * 32.f, s[10 * 33] * 32.f, s[11 * 33] * 32.f); o.w = pk4_fp8(s[12 * 33] * 32.f, s[13 * 33] * 32.f, s[14 * 33] * 32.f, s[15 * 33] * 32.f);
    const char* db = sgpr_ptr(it.dst); const unsigned kd = (unsigned)__builtin_amdgcn_readfirstlane(it.kdst);
    __builtin_nontemporal_store(o, (GAS u32x4*)(db + ((unsigned)n * kd + 16u * (unsigned)c))); }
  LDS_WAIT(); asm volatile("" ::: "memory");
}

template <bool OUT, int NBG>
__device__ __forceinline__ void hgrn_item(int tid, int h, int dir, int p, unsigned char* ws, float* Sbuf, float* Dbuf, LAS unsigned char* lds, int bg_first, int bg_stride, const float* wg, const float* wu, const float* wd) {
  const int wid = __builtin_amdgcn_readfirstlane(tid >> 6), lane = tid & 63, r32 = lane & 31, hi = lane >> 5;
  const bf16_t* HQ = (const bf16_t*)(ws + WS_HQ); const bf16_t* Z = (const bf16_t*)(ws + (dir ? WS_ZB : WS_ZF)); const bf16_t* HI = (const bf16_t*)(ws + WS_HI);
  const float* lbp = (const float*)(ws + WS_SMALL) + 64 + dir * 512 + h * 128;
  bf16_t* Od = (bf16_t*)(ws + WS_Q) + ((size_t)(dir * 4 + h) * T) * 128;
  const int sc = dir ? (NSC - 1 - p) : p, tok0 = sc * LSC;
  float* Sg = Sbuf + ((size_t)((h * 2 + dir) * NSC + p)) * 16384;
  float* Dg = Dbuf + ((size_t)((h * 2 + dir) * NSC + p)) * 128;
  const int sr = tid >> 4, c8 = (tid & 15) * 8;
  float lb8[8];
#pragma unroll
  for (int i = 0; i < 8; ++i) lb8[i] = lbp[c8 + i];
  const int vj = wid & 3, kt0 = 2 * (wid >> 2);
  f32x16 S0, S1;
  if (OUT) {
#pragma unroll
    for (int r = 0; r < 16; ++r) { S0[r] = Sg[(size_t)(32 * kt0 + crow(r, hi)) * 128 + 32 * vj + r32]; S1[r] = Sg[(size_t)(32 * (kt0 + 1) + crow(r, hi)) * 128 + 32 * vj + r32]; }
  } else { S0 = f32x16{}; S1 = f32x16{}; }
  float bsum[8];
#pragma unroll
  for (int i = 0; i < 8; ++i) bsum[i] = 1.f;
  LAS float* Gb = (LAS float*)(lds + L_GB); LAS float* Seg = (LAS float*)(lds + L_SEG); LAS float* Dl = (LAS float*)(lds + L_DL);
  LAS float* bscr = (LAS float*)(lds + (wid < 5 ? L_END + wid * 4224 : 133120 + (wid - 5) * 4224));
  BgRegs bgr0, bgr1, bgr2, bgr3, bgr4, bgr5;
#define BG_ONE(j, R) do { \
    const int idp_ = __builtin_amdgcn_readfirstlane(bg_first + bg_stride * (NBG * (step - 1) + (j))), idn_ = __builtin_amdgcn_readfirstlane(bg_first + bg_stride * (NBG * step + (j))); \
    if (step > 0 && idp_ < BG_ITEMS) { const BgItem it_ = bg_decode(idp_, wg, wu, wd, ws); bg_store(R, it_, bscr, lane); } \
    if (step < NCH && idn_ < BG_ITEMS) { const BgItem it_ = bg_decode(idn_, wg, wu, wd, ws); bg_load(R, it_, lane); } } while (0)
#define BG_POINT(i, R, R2) do { if (NBG > 0 && bg_first >= 0) { if (NBG > (i)) BG_ONE((i), R); if (NBG > 3 + (i)) BG_ONE(3 + (i), R2); } } while (0)
  u32x4 z0, z1, v0, v1, q0 = {0, 0, 0, 0}, q1 = {0, 0, 0, 0};
#define HG_LOAD(step_) do { const int ci_ = dir ? (NCH - 1 - (step_)) : (step_), ctok_ = tok0 + ci_ * C; \
    const int t0_ = ctok_ + (dir ? (63 - sr) : sr), t1_ = ctok_ + (dir ? (31 - sr) : (sr + 32)); \
    const size_t g0_ = (size_t)t0_ * 512 + h * 128 + c8, g1_ = (size_t)t1_ * 512 + h * 128 + c8; \
    z0 = *(const u32x4*)(Z + g0_); z1 = *(const u32x4*)(Z + g1_); v0 = *(const u32x4*)(HI + g0_); v1 = *(const u32x4*)(HI + g1_); \
    if (OUT) { q0 = *(const u32x4*)(HQ + g0_); q1 = *(const u32x4*)(HQ + g1_); } } while (0)
#define HG_LOAD_Z(step_) do { const int ci_ = dir ? (NCH - 1 - (step_)) : (step_), ctok_ = tok0 + ci_ * C; \
    const int t0_ = ctok_ + (dir ? (63 - sr) : sr), t1_ = ctok_ + (dir ? (31 - sr) : (sr + 32)); \
    z0 = *(const u32x4*)(Z + (size_t)t0_ * 512 + h * 128 + c8); z1 = *(const u32x4*)(Z + (size_t)t1_ * 512 + h * 128 + c8); } while (0)
#define HG_LOAD_VQ(step_) do { const int ci_ = dir ? (NCH - 1 - (step_)) : (step_), ctok_ = tok0 + ci_ * C; \
    const int t0_ = ctok_ + (dir ? (63 - sr) : sr), t1_ = ctok_ + (dir ? (31 - sr) : (sr + 32)); \
    const size_t g0_ = (size_t)t0_ * 512 + h * 128 + c8, g1_ = (size_t)t1_ * 512 + h * 128 + c8; \
    v0 = *(const u32x4*)(HI + g0_); v1 = *(const u32x4*)(HI + g1_); q0 = *(const u32x4*)(HQ + g0_); q1 = *(const u32x4*)(HQ + g1_); } while (0)
  if (!OUT) HG_LOAD(0); else HG_LOAD_Z(0);
  for (int step = 0; step < NCH; ++step) {
    const int ci = dir ? (NCH - 1 - step) : step, ctok = tok0 + ci * C;
    if (OUT) HG_LOAD_VQ(step);
    BG_POINT(0, bgr0, bgr3);
    float k0[8], k1[8];
#pragma unroll
    for (int i = 0; i < 4; ++i) {
      { const float za = bflo(z0[i]), zb = bfhi(z0[i]); const float sa = fsigm(za), sb = fsigm(zb); const float fa = lb8[2 * i] + (1.f - lb8[2 * i]) * sa, fb = lb8[2 * i + 1] + (1.f - lb8[2 * i + 1]) * sb;
        k0[2 * i] = 1.f - fa; k0[2 * i + 1] = 1.f - fb; Gb[sr * 128 + c8 + 2 * i] = fa; Gb[sr * 128 + c8 + 2 * i + 1] = fb; }
      { const float za = bflo(z1[i]), zb = bfhi(z1[i]); const float sa = fsigm(za), sb = fsigm(zb); const float fa = lb8[2 * i] + (1.f - lb8[2 * i]) * sa, fb = lb8[2 * i + 1] + (1.f - lb8[2 * i + 1]) * sb;
        k1[2 * i] = 1.f - fa; k1[2 * i + 1] = 1.f - fb; Gb[(sr + 32) * 128 + c8 + 2 * i] = fa; Gb[(sr + 32) * 128 + c8 + 2 * i + 1] = fb; }
    }
    BG_POINT(1, bgr1, bgr4);
    __syncthreads();
    { const int ch = tid & 127, seg = tid >> 7; float run = 1.f;
#pragma unroll
      for (int r = 0; r < 16; ++r) { run *= Gb[(16 * seg + r) * 128 + ch]; Gb[(16 * seg + r) * 128 + ch] = run; }
      Seg[seg * 128 + ch] = run; }
    __syncthreads();
    float bl[8], o0[8], o1[8];
    { const int sg0 = sr >> 4, sg1 = (sr + 32) >> 4;
#pragma unroll
      for (int i = 0; i < 8; ++i) { const float s0 = Seg[c8 + i], s1 = Seg[128 + c8 + i], s2 = Seg[256 + c8 + i], s3 = Seg[384 + c8 + i];
        bl[i] = (s0 * s1) * (s2 * s3); o0[i] = sg0 == 0 ? 1.f : s0; o1[i] = sg1 == 2 ? (s0 * s1) : ((s0 * s1) * s2); } }
    float b0[8], b1[8];
#pragma unroll
    for (int i = 0; i < 8; ++i) { b0[i] = Gb[sr * 128 + c8 + i] * o0[i]; b1[i] = Gb[(sr + 32) * 128 + c8 + i] * o1[i]; }
    float r0[8], r1[8];
#pragma unroll
    for (int i = 0; i < 8; ++i) { r0[i] = __builtin_amdgcn_rcpf(b0[i]); r1[i] = __builtin_amdgcn_rcpf(b1[i]); }
    if (sr == 0) {
#pragma unroll
      for (int i = 0; i < 8; ++i) { Dl[c8 + i] = bl[i]; bsum[i] *= bl[i]; } }
    { u32x4 kh0, kh1;
#pragma unroll
      for (int i = 0; i < 4; ++i) { kh0[i] = cvt_pk_bf16(k0[2 * i] * (bl[2 * i] * r0[2 * i]), k0[2 * i + 1] * (bl[2 * i + 1] * r0[2 * i + 1]));
        kh1[i] = cvt_pk_bf16(k1[2 * i] * (bl[2 * i] * r1[2 * i]), k1[2 * i + 1] * (bl[2 * i + 1] * r1[2 * i + 1])); }
      const unsigned a0 = off_b(sr, tid & 15), a1 = 8192u + off_b(sr, tid & 15);
      *(LAS u32x4*)(lds + L_KH + a0) = kh0; *(LAS u32x4*)(lds + L_KH + a1) = kh1;
      *(LAS u32x4*)(lds + L_VT + a0) = v0; *(LAS u32x4*)(lds + L_VT + a1) = v1;
      if (OUT) { u32x4 qt0, qt1, kt0_, kt1_;
#pragma unroll
        for (int i = 0; i < 4; ++i) { qt0[i] = cvt_pk_bf16(bflo(q0[i]) * b0[2 * i], bfhi(q0[i]) * b0[2 * i + 1]); qt1[i] = cvt_pk_bf16(bflo(q1[i]) * b1[2 * i], bfhi(q1[i]) * b1[2 * i + 1]);
          kt0_[i] = cvt_pk_bf16(k0[2 * i] * r0[2 * i], k0[2 * i + 1] * r0[2 * i + 1]); kt1_[i] = cvt_pk_bf16(k1[2 * i] * r1[2 * i], k1[2 * i + 1] * r1[2 * i + 1]); }
        *(LAS u32x4*)(lds + L_QT + a0) = qt0; *(LAS u32x4*)(lds + L_QT + a1) = qt1; *(LAS u32x4*)(lds + L_KT + a0) = kt0_; *(LAS u32x4*)(lds + L_KT + a1) = kt1_; } }
    BG_POINT(2, bgr2, bgr5);
    __syncthreads();
    if (!OUT && step + 1 < NCH) HG_LOAD(step + 1);
    if (OUT && step + 1 < NCH) HG_LOAD_Z(step + 1);
    if (OUT) {
      { LAS unsigned char* sb = lds + L_GB + 8192u * vj;
#pragma unroll
        for (int g = 0; g < 4; ++g) { u32x2 w0, w1; w0.x = cvt_pk_bf16(S0[4 * g], S0[4 * g + 1]); w0.y = cvt_pk_bf16(S0[4 * g + 2], S0[4 * g + 3]); w1.x = cvt_pk_bf16(S1[4 * g], S1[4 * g + 1]); w1.y = cvt_pk_bf16(S1[4 * g + 2], S1[4 * g + 3]);
          *(LAS u32x2*)(sb + off_b(r32, 4 * kt0 + g) + 8 * hi) = w0;
          *(LAS u32x2*)(sb + off_b(r32, 4 * (kt0 + 1) + g) + 8 * hi) = w1; } }
      if (wid < 4 && !(wid == 1)) { const int ti = wid >> 1, si = wid & 1; f32x16 a = f32x16{};
#pragma unroll
        for (int s = 0; s < 8; ++s) a = __builtin_amdgcn_mfma_f32_32x32x16_bf16(row_frag(lds + L_KT, lane, si, s), row_frag(lds + L_QT, lane, ti, s), a, 0, 0, 0);
        const int tcol = 32 * ti + r32;
#pragma unroll
        for (int g = 0; g < 4; ++g) { const int s0 = 32 * si + 8 * g + 4 * hi; float x[4];
#pragma unroll
          for (int e = 0; e < 4; ++e) x[e] = (s0 + e <= tcol) ? a[4 * g + e] : 0.f;
          u32x2 w; w.x = cvt_pk_bf16(x[0], x[1]); w.y = cvt_pk_bf16(x[2], x[3]);
          *(LAS u32x2*)(lds + L_AT + at_off(tcol, 4 * si + g) + 8 * hi) = w; } }
      __syncthreads();
      { const int ti = wid >> 2; f32x16 o = f32x16{};
#pragma unroll
        for (int kk = 0; kk < 8; ++kk) o = __builtin_amdgcn_mfma_f32_32x32x16_bf16(row_frag(lds + L_QT, lane, ti, kk), row_frag(lds + L_GB, lane, vj, kk), o, 0, 0, 0);
        const int nks = ti == 0 ? 2 : 4;
        for (int kk = 0; kk < nks; ++kk) { const bf16x8 af = *(const LAS bf16x8*)(lds + L_AT + at_off(32 * ti + r32, 2 * kk + hi));
          o = __builtin_amdgcn_mfma_f32_32x32x16_bf16(af, tr_frag(lds + L_VT, lane, vj, kk), o, 0, 0, 0); }
        {
          const char* ob = sgpr_ptr(Od); const int rl = 32 * ti + 4 * hi;
          const unsigned lo = (unsigned)(ctok + (dir ? 63 - rl : rl)) * 256u + (unsigned)(32 * vj + r32) * 2u;
#pragma unroll
          for (int r = 0; r < 16; ++r) { const int dr = (r & 3) + 8 * (r >> 2);
            *(GAS bf16_t*)(ob + (lo + (unsigned)((dir ? -dr : dr) * 256))) = (bf16_t)(cvt_pk_bf16(o[r], 0.f) & 0xffffu); } } }
    }
    { float d0[16], d1[16];
#pragma unroll
      for (int r = 0; r < 16; ++r) { d0[r] = Dl[32 * kt0 + crow(r, hi)]; d1[r] = Dl[32 * (kt0 + 1) + crow(r, hi)]; }
#pragma unroll
      for (int r = 0; r < 16; ++r) { S0[r] *= d0[r]; S1[r] *= d1[r]; }
#pragma unroll
      for (int kk = 0; kk < 4; ++kk) { const bf16x8 vf = tr_frag(lds + L_VT, lane, vj, kk);
        S0 = __builtin_amdgcn_mfma_f32_32x32x16_bf16(tr_frag(lds + L_KH, lane, kt0, kk), vf, S0, 0, 0, 0);
        S1 = __builtin_amdgcn_mfma_f32_32x32x16_bf16(tr_frag(lds + L_KH, lane, kt0 + 1, kk), vf, S1, 0, 0, 0); } }
    __syncthreads();
  }
  { const int step = NCH; BG_POINT(0, bgr0, bgr3); BG_POINT(1, bgr1, bgr4); BG_POINT(2, bgr2, bgr5); }
#undef BG_POINT
#undef BG_ONE
#undef HG_LOAD
#undef HG_LOAD_Z
#undef HG_LOAD_VQ
  if (!OUT) {
#pragma unroll
    for (int r = 0; r < 16; ++r) { Sg[(size_t)(32 * kt0 + crow(r, hi)) * 128 + 32 * vj + r32] = S0[r]; Sg[(size_t)(32 * (kt0 + 1) + crow(r, hi)) * 128 + 32 * vj + r32] = S1[r]; }
    if (sr == 0) {
#pragma unroll
      for (int i = 0; i < 8; ++i) Dg[c8 + i] = bsum[i]; }
  }
}

__device__ __forceinline__ void hgrn_scan(int gthread, int nthreads, float* Sbuf, const float* Dbuf) {
  for (int e = gthread; e < 8 * 16384; e += nthreads) { const int hd = e >> 14, kv = e & 16383, k = kv >> 7;
    float* Sp = Sbuf + (size_t)hd * NSC * 16384 + kv; const float* Dp = Dbuf + (size_t)hd * NSC * 128 + k;
    float sv[NSC], dv[NSC];
#pragma unroll
    for (int p = 0; p < NSC; ++p) { sv[p] = __builtin_nontemporal_load(Sp + (size_t)p * 16384); dv[p] = Dp[p * 128]; }
    float run = 0.f;
#pragma unroll
    for (int p = 0; p < NSC; ++p) { Sp[(size_t)p * 16384] = run; run = dv[p] * run + sv[p]; } }
}
__device__ __forceinline__ void hgrn_combine(int gwave, int nwaves, int lane, const unsigned char* ws, const float* __restrict__ gg) {
  const bf16_t* Of = (const bf16_t*)(ws + WS_Q); const bf16_t* Ob = Of + (size_t)4 * T * 128; const bf16_t* HG = (const bf16_t*)(ws + WS_HG); bf16_t* mix = (bf16_t*)(ws + WS_XN);
  const int sub = lane >> 4, c8 = (lane & 15) * 8;
  float g8[8];
#pragma unroll
  for (int i = 0; i < 8; ++i) g8[i] = gg[c8 + i];
  for (int w4 = gwave; w4 < T; w4 += 4 * nwaves) { const int h = sub;
    u32x4 f[4], b[4], gt[4];
#pragma unroll
    for (int u = 0; u < 4; ++u) { const int t = w4 + u * nwaves; if (t < T) {
      f[u] = __builtin_nontemporal_load((const GAS u32x4*)(Of + ((size_t)h * T + t) * 128 + c8)); b[u] = __builtin_nontemporal_load((const GAS u32x4*)(Ob + ((size_t)h * T + t) * 128 + c8));
      gt[u] = __builtin_nontemporal_load((const GAS u32x4*)(HG + (size_t)t * 512 + h * 128 + c8)); } }
#pragma unroll
    for (int u = 0; u < 4; ++u) { const int t = w4 + u * nwaves; if (t < T) {
      float a[8]; float ss = 0.f;
#pragma unroll
      for (int i = 0; i < 4; ++i) { a[2 * i] = bflo(f[u][i]) + bflo(b[u][i]); a[2 * i + 1] = bfhi(f[u][i]) + bfhi(b[u][i]); ss += a[2 * i] * a[2 * i] + a[2 * i + 1] * a[2 * i + 1]; }
      ss += __shfl_xor(ss, 1); ss += __shfl_xor(ss, 2); ss += __shfl_xor(ss, 4); ss += __shfl_xor(ss, 8);
      const float r = 1.f / sqrtf(ss * (1.f / 128.f) + 1e-6f);
      u32x4 o;
#pragma unroll
      for (int i = 0; i < 4; ++i) o[i] = cvt_pk_bf16(a[2 * i] * r * g8[2 * i] * bflo(gt[u][i]), a[2 * i + 1] * r * g8[2 * i + 1] * bfhi(gt[u][i]));
      *(GAS u32x4*)(mix + (size_t)t * DM + 512 + h * 128 + c8) = o; } } }
}
}
}
namespace mk {
struct EpiOutProj { static constexpr int ID = 2; static constexpr bool XPF = true;
  const float* x; bf16_t* hb;
  __device__ __forceinline__ const float* xpf_src(const Unit& u, int p, int wr, int wc, int fr, int fq) const {
    const int n = p & 1, bj = (p >> 1) & 1, m = (p >> 2) & 3, ai = p >> 4;
    return x + (size_t)(u.pm * BM + wr * 64 + fr + ai * HALF + m * 16) * DM + u.pn * BM + wc * 32 + 8 * fq + bj * HALF + 4 * n;
  }
  template <bool PF>
  __device__ __forceinline__ void run(const f32x4 (&acc)[2][2][4][2], const Unit& u, int wr, int wc, int fr, int fq, const LAS unsigned char* lp, const unsigned* xb) const {
    const int row0 = u.pm * BM + wr * 64 + fr, col0 = u.pn * BM + wc * 32 + 8 * fq;
#pragma unroll
    for (int ai = 0; ai < 2; ++ai)
#pragma unroll
      for (int m = 0; m < 4; ++m) { const size_t ro = (size_t)(row0 + ai * HALF + m * 16) * DM + col0;
#pragma unroll
        for (int bj = 0; bj < 2; ++bj) { const GAS f32x4* xp = (const GAS f32x4*)(x + ro + bj * HALF);
          const int p0 = ((ai * 4 + m) * 2 + bj) * 2;
          f32x4 x0, x1;
          if (PF && p0 < 14) { x0 = *(const LAS f32x4*)(lp + xb[p0 >> 1]); x1 = *(const LAS f32x4*)(lp + xb[p0 >> 1] + 8192); }
          else { x0 = __builtin_nontemporal_load(xp); x1 = __builtin_nontemporal_load(xp + 1); }
          x0 += acc[ai][bj][m][0]; x1 += acc[ai][bj][m][1];
          u32x4 w; w.x = cvt_pk_bf16(x0.x, x0.y); w.y = cvt_pk_bf16(x0.z, x0.w); w.z = cvt_pk_bf16(x1.x, x1.y); w.w = cvt_pk_bf16(x1.z, x1.w);
          *(GAS u32x4*)(hb + ro + bj * HALF) = w; } }
  }
  __device__ __forceinline__ void operator()(const f32x4 (&acc)[2][2][4][2], const Unit& u, int wr, int wc, int fr, int fq) const { run<false>(acc, u, wr, wc, fr, fq, nullptr, nullptr); }
  __device__ __forceinline__ void run_pf(const f32x4 (&acc)[2][2][4][2], const Unit& u, int wr, int wc, int fr, int fq, const LAS unsigned char* lp, const unsigned* xb) const { run<true>(acc, u, wr, wc, fr, fq, lp, xb); }
};

namespace rt {
constexpr size_t WS_WR = WS_SMALL + 64 * 1024;
constexpr size_t R_LIST = WS_ROUTE, R_CWL = WS_ROUTE + 2 * MiB, R_TINFO = WS_ROUTE + 4 * MiB;
__device__ __forceinline__ void build_wr(int gthread, int nthreads, const Args& a) {
  bf16_t* WR = (bf16_t*)(a.ws + WS_WR); const float* g = a.in[8]; const float* wgr = a.in[9]; const float* wer = a.in[11];
  for (int idx = gthread; idx < 1024 * 48; idx += nthreads) { const int k = idx & 1023, j = idx >> 10; float w = 0.f;
    if (j < 4) w = wgr[k * 4 + j]; else if (j < 36) { const int gi = (j - 4) >> 3, e = (j - 4) & 7; w = wer[((size_t)gi * 1024 + k) * 8 + e]; }
    w *= g[k];
    const unsigned hi = cvt_pk_bf16(w, 0.f) & 0xffffu; const float lo = w - __uint_as_float(hi << 16);
    WR[idx] = (bf16_t)hi; WR[48 * 1024 + idx] = (bf16_t)(cvt_pk_bf16(lo, 0.f) & 0xffffu); }
}
__device__ __forceinline__ void router_phase(Frame& F, const Args& a, gu32* gcnt, bool dry = false) {
  const bf16_t* hres = (const bf16_t*)(a.ws + WS_HI); const float* g = a.in[8]; const bf16_t* WR = (const bf16_t*)(a.ws + WS_WR);
  const float* bgr = a.in[10]; const float* ber = a.in[12];
  bf16_t* XT = (bf16_t*)(a.ws + WS_XN); int* list = (int*)(a.ws + R_LIST); float* cwl = (float*)(a.ws + R_CWL); int* tinfo = (int*)(a.ws + R_TINFO);
  constexpr int WROW = 528, TERM_B = 48 * WROW, HALF_B = 2 * TERM_B;
  LAS unsigned char* wl = F.lds; LAS float* lgx = (LAS float*)(F.lds + 110592); LAS float* ssx = lgx + 4 * 16 * 48; LAS int* lcnt = (LAS int*)(F.lds + 124416); LAS int* lbase = lcnt + 32;
  const int lane = F.lane, j = lane & 15, q = lane >> 4, tl = F.wave & 3, kh = F.wave >> 2;
  const int ntile = T / 16, tpb = (ntile + F.G - 1) / F.G;
  if (F.tid < 64) lcnt[F.tid] = 0;
  LAS float* gls = (LAS float*)(F.lds + 126976);
  for (int i = F.tid; i < DM; i += NTHR) gls[i] = g[i];
  const int tile = F.vcu * tpb + tl; const bool active = (tl < tpb) && (tile < ntile);
  const int t0 = (active ? tile : 0) * 16;
  const bf16_t* xr = hres + (size_t)(t0 + j) * DM + 512 * kh + 8 * q;
  f32x4 acc0 = {0.f, 0.f, 0.f, 0.f}, acc1 = acc0, acc2 = acc0; float ssq = 0.f;
  u32x4 xh[16];
#pragma unroll
  for (int s = 0; s < 16; ++s) xh[s] = *(const GAS u32x4*)(xr + 32 * s);
  u32x4 wv[12];
#define RT_LOAD_WR(c_) do { _Pragma("unroll") for (int it = 0; it < 12; ++it) { const int idx = F.tid + it * NTHR; const int hh = idx / 3072, rem = idx % 3072, term = rem / 1536, r2 = rem % 1536, col = r2 >> 5, pc = r2 & 31; \
      wv[it] = *(const GAS u32x4*)(WR + (size_t)term * 48 * 1024 + (size_t)col * 1024 + 512 * hh + 256 * (c_) + 8 * pc); } } while (0)
  RT_LOAD_WR(0);
  for (int c = 0; c < 2; ++c) {
    __syncthreads();
#pragma unroll
    for (int it = 0; it < 12; ++it) { const int idx = F.tid + it * NTHR; const int hh = idx / 3072, rem = idx % 3072, term = rem / 1536, r2 = rem % 1536, col = r2 >> 5, pc = r2 & 31;
      *(LAS u32x4*)(wl + hh * HALF_B + term * TERM_B + col * WROW + 16 * pc) = wv[it]; }
    if (c == 0) RT_LOAD_WR(1);
    __syncthreads();
    const LAS unsigned char* wk = wl + kh * HALF_B + j * WROW + 16 * q;
#pragma unroll
    for (int s = 0; s < 8; ++s) { const u32x4 xb = xh[8 * c + s]; const bf16x8 xa = __builtin_bit_cast(bf16x8, xb);
#pragma unroll
      for (int e = 0; e < 4; ++e) { const float a0 = bflo(xb[e]), a1 = bfhi(xb[e]); ssq += a0 * a0 + a1 * a1; }
#pragma unroll
      for (int term = 0; term < 2; ++term) { const LAS unsigned char* wp = wk + term * TERM_B + 64 * s;
        acc0 = __builtin_amdgcn_mfma_f32_16x16x32_bf16(xa, *(const LAS bf16x8*)(wp), acc0, 0, 0, 0);
        acc1 = __builtin_amdgcn_mfma_f32_16x16x32_bf16(xa, *(const LAS bf16x8*)(wp + 16 * WROW), acc1, 0, 0, 0);
        acc2 = __builtin_amdgcn_mfma_f32_16x16x32_bf16(xa, *(const LAS bf16x8*)(wp + 32 * WROW), acc2, 0, 0, 0); } }
  }
#undef RT_LOAD_WR
  ssq += __shfl_xor(ssq, 16); ssq += __shfl_xor(ssq, 32);
  if (lane < 16) ssx[(tl * 2 + kh) * 16 + lane] = ssq;
  if (kh == 1) {
#pragma unroll
    for (int r = 0; r < 4; ++r) { lgx[(tl * 16 + 4 * q + r) * 48 + j] = acc0[r]; lgx[(tl * 16 + 4 * q + r) * 48 + 16 + j] = acc1[r]; lgx[(tl * 16 + 4 * q + r) * 48 + 32 + j] = acc2[r]; } }
  __syncthreads();
  const float rstd = 1.f / sqrtf((ssx[(tl * 2) * 16 + j] + ssx[(tl * 2 + 1) * 16 + j]) * (1.f / DM) + 1e-6f);
  if (kh == 0) {
#pragma unroll
    for (int r = 0; r < 4; ++r) { lgx[(tl * 16 + 4 * q + r) * 48 + j] += acc0[r]; lgx[(tl * 16 + 4 * q + r) * 48 + 16 + j] += acc1[r]; lgx[(tl * 16 + 4 * q + r) * 48 + 32 + j] += acc2[r]; } }
  LDS_WAIT();
  int e1 = 0, e2 = 0, lr1 = 0, lr2 = 0; float c1 = 0.f, c2 = 0.f; int tok = 0;
  if (active && kh == 0 && lane < 16) {
    tok = t0 + lane; const LAS float* lg = lgx + (tl * 16 + lane) * 48;
    float gl[4];
#pragma unroll
    for (int i = 0; i < 4; ++i) gl[i] = lg[i] * rstd + bgr[i];
    int gi = 0; float gm = gl[0];
#pragma unroll
    for (int i = 1; i < 4; ++i) if (gl[i] > gm) { gm = gl[i]; gi = i; }
    float den = 0.f;
#pragma unroll
    for (int i = 0; i < 4; ++i) den += __expf(gl[i] - gm);
    const float pg = 1.f / den;
    float el[8];
#pragma unroll
    for (int i = 0; i < 8; ++i) el[i] = lg[4 + 8 * gi + i] * rstd + ber[gi * 8 + i];
    int i1 = 0; float m1 = el[0];
#pragma unroll
    for (int i = 1; i < 8; ++i) if (el[i] > m1) { m1 = el[i]; i1 = i; }
    int i2 = 0; float m2 = -3.0e38f;
#pragma unroll
    for (int i = 0; i < 8; ++i) if (i != i1 && el[i] > m2) { m2 = el[i]; i2 = i; }
    const float ex = __expf(m2 - m1); const float w1 = 1.f / (1.f + ex), w2 = ex / (1.f + ex);
    e1 = gi * 8 + i1; e2 = gi * 8 + i2; c1 = w1 * pg; c2 = w2 * pg;
    if (!dry) { lr1 = __hip_atomic_fetch_add(lcnt + e1, 1, __ATOMIC_RELAXED, __HIP_MEMORY_SCOPE_WORKGROUP); lr2 = __hip_atomic_fetch_add(lcnt + e2, 1, __ATOMIC_RELAXED, __HIP_MEMORY_SCOPE_WORKGROUP); }
  }
  __syncthreads();
  if (dry) return;
  int nbase = 0; if (F.tid < 32) { const int n = lcnt[F.tid]; nbase = n ? (int)__hip_atomic_fetch_add(gcnt + F.tid, (unsigned)n, __ATOMIC_RELAXED, __HIP_MEMORY_SCOPE_AGENT) : 0; }
  if (active) {
#pragma unroll
    for (int u = 0; u < 16; ++u) { const u32x4 xb = xh[u]; const LAS f32x4* gp = (const LAS f32x4*)(gls + 512 * kh + 32 * u + 8 * q); const f32x4 g0 = gp[0], g1 = gp[1];
      u32x2 w; w.x = pk4_fp8(bflo(xb.x) * rstd * g0.x, bfhi(xb.x) * rstd * g0.y, bflo(xb.y) * rstd * g0.z, bfhi(xb.y) * rstd * g0.w);
      w.y = pk4_fp8(bflo(xb.z) * rstd * g1.x, bfhi(xb.z) * rstd * g1.y, bflo(xb.w) * rstd * g1.z, bfhi(xb.w) * rstd * g1.w);
      *(GAS u32x2*)((unsigned char*)XT + (size_t)(t0 + j) * DM + 512 * kh + 32 * u + 8 * q) = w; } }
  if (F.tid < 32) lbase[F.tid] = nbase;
  __syncthreads();
  if (active && kh == 0 && lane < 16) { const int p1 = lbase[e1] + lr1, p2 = lbase[e2] + lr2;
    list[(size_t)e1 * T + p1] = tok; list[(size_t)e2 * T + p2] = tok; cwl[(size_t)e1 * T + p1] = c1; cwl[(size_t)e2 * T + p2] = c2;
    typedef int i32x4 __attribute__((ext_vector_type(4))); *(GAS i32x4*)(tinfo + (size_t)tok * 4) = (i32x4){e1, p1, e2, p2}; }
}
}

constexpr int MOE_TAB = RING_BYTES + 512;
__device__ __forceinline__ void moe_tables(Frame& F, gu32* gcnt) {
  LAS int* tab = (LAS int*)(F.lds + MOE_TAB);
  if (F.tid < 64) {
    const int e = F.tid; const int n = e < NEXP ? (int)__hip_atomic_load(gcnt + e, __ATOMIC_RELAXED, __HIP_MEMORY_SCOPE_AGENT) : 0;
    const int te = (n + 255) >> 8, rem = n - 256 * (te - 1), sm = (te > 0 && rem <= 128) ? 1 : 0, big = te - sm;
    int so = n, sb = big, ss = sm;
#pragma unroll
    for (int d = 1; d < 32; d <<= 1) { const int a = __shfl_up(so, d), b = __shfl_up(sb, d), c = __shfl_up(ss, d); if (e >= d) { so += a; sb += b; ss += c; } }
    if (e < NEXP) { tab[e] = n; tab[32 + e] = so - n; tab[66 + e] = sb - big; tab[100 + e] = ss - sm; }
    if (e == NEXP - 1) { tab[64] = so; tab[98] = sb; tab[132] = ss; } }
  __syncthreads();
}
template <bool DOWN>
struct ProbMoE {
  int K; const char* Abase; const char* Wt; const int* list; const LAS int* tab; int G, c;
  static constexpr bool TAILS = true, FP8 = true;
  int scale_w, scale_x;
  __device__ __forceinline__ bool next(int i, Unit& u) const {
    const int nB = tab[98] * 4, nS = tab[132] * 4;
    const int rbase = i * G; int p0 = nB - rbase; p0 = p0 < 0 ? 0 : (p0 > G ? G : p0);
    int pos = c;
    if (c >= p0 && (G & 7) == 0) { const int PX = G >> 3, q0 = p0 / PX, r0 = p0 % PX, qc = c / PX, rc = c % PX, lo = (rc >= r0) ? q0 : q0 + 1;
      pos = p0 + rc * (7 - q0) + (rc > r0 ? rc - r0 : 0) + (qc > lo ? qc - lo : 0); }
    int L = rbase + pos; if (L >= nB + nS) return false;
    const bool small = L >= nB; if (small) L -= nB;
    const int tile = L >> 2, base = small ? 100 : 66; u.pn = L & 3;
    int e = 0;
#pragma unroll 1
    for (int s = 16; s >= 1; s >>= 1) if (e + s < NEXP && tab[base + e + s] <= tile) e += s;
    u.e = e; const int nbig = tab[66 + e + 1] - tab[66 + e];
    u.pm = small ? nbig : tile - tab[66 + e]; u.nrows = tab[e] - u.pm * 256; if (u.nrows > 256) u.nrows = 256; u.row0 = tab[32 + e] + u.pm * 256;
    u.e = __builtin_amdgcn_readfirstlane(u.e); u.pm = __builtin_amdgcn_readfirstlane(u.pm); u.pn = __builtin_amdgcn_readfirstlane(u.pn);
    u.nrows = __builtin_amdgcn_readfirstlane(u.nrows); u.row0 = __builtin_amdgcn_readfirstlane(u.row0); return true;
  }
  __device__ __forceinline__ unsigned a_row_off(const Unit& u, int r) const {
    const int rr = r < u.nrows ? r : (u.nrows - 1);
    if (DOWN) return (unsigned)(u.row0 + rr) * (unsigned)K * 2u;
    const int tok = list[(size_t)u.e * T + u.pm * 256 + rr]; return (unsigned)tok * (unsigned)K * 2u;
  }
  __device__ __forceinline__ const char* b_rows(const Unit& u) const { return Wt + ((size_t)u.e * 1024 + (size_t)u.pn * 256) * K * 2; }
};
struct EpiGateUp { static constexpr int ID = 3; static constexpr bool XPF = false;
  bf16_t* hid; const float* cwl;
  __device__ __forceinline__ void operator()(const f32x4 (&acc)[2][2][4][2], const Unit& u, int wr, int wc, int fr, int fq) const {
    const int f0 = u.pn * 128 + wc * 32 + 8 * fq;
#pragma unroll
    for (int ai = 0; ai < 2; ++ai)
#pragma unroll
      for (int m = 0; m < 4; ++m) { const int r = ai * HALF + wr * 64 + m * 16 + fr;
        if (r < u.nrows) { const float cw = cwl[(size_t)u.e * T + u.pm * 256 + r];
          const f32x4 a0 = acc[ai][0][m][0], a1 = acc[ai][0][m][1], u0 = acc[ai][1][m][0], u1 = acc[ai][1][m][1]; float hv[8];
#pragma unroll
          for (int i = 0; i < 4; ++i) { hv[i] = fsilu(a0[i]) * u0[i] * cw; hv[4 + i] = fsilu(a1[i]) * u1[i] * cw; }
          u32x2 w; w.x = pk4_fp8(hv[0] * 16.f, hv[1] * 16.f, hv[2] * 16.f, hv[3] * 16.f); w.y = pk4_fp8(hv[4] * 16.f, hv[5] * 16.f, hv[6] * 16.f, hv[7] * 16.f);
          *(GAS u32x2*)((unsigned char*)hid + (size_t)(u.row0 + r) * FE + f0) = w; } }
  }
};
struct EpiDown { static constexpr int ID = 4; static constexpr bool XPF = false;
  bf16_t* y;
  __device__ __forceinline__ void operator()(const f32x4 (&acc)[2][2][4][2], const Unit& u, int wr, int wc, int fr, int fq) const {
    const int col0 = u.pn * BM + wc * 32 + 8 * fq;
#pragma unroll
    for (int ai = 0; ai < 2; ++ai)
#pragma unroll
      for (int m = 0; m < 4; ++m) { const int r = ai * HALF + wr * 64 + m * 16 + fr;
        if (r < u.nrows) {
#pragma unroll
          for (int bj = 0; bj < 2; ++bj) { const f32x4 v0 = acc[ai][bj][m][0], v1 = acc[ai][bj][m][1];
            u32x4 w; w.x = cvt_pk_bf16(v0[0], v0[1]); w.y = cvt_pk_bf16(v0[2], v0[3]); w.z = cvt_pk_bf16(v1[0], v1[1]); w.w = cvt_pk_bf16(v1[2], v1[3]);
            *(GAS u32x4*)(y + (size_t)(u.row0 + r) * DM + col0 + bj * HALF) = w; } } }
  }
};
__device__ __forceinline__ void final_phase(Frame& F, const Args& a, const bf16_t* y, float* outp) {
  const LAS int* tab = (const LAS int*)(F.lds + MOE_TAB); const int* tinfo = (const int*)(a.ws + rt::R_TINFO); const float* gf = a.in[16];
  const int gw = F.vcu * NWAVES + F.wave, NGW = F.G * NWAVES, lane = F.lane;
  typedef int i32x4 __attribute__((ext_vector_type(4)));
  f32x4 gg[4];
#pragma unroll
  for (int jj = 0; jj < 4; ++jj) gg[jj] = ((const GAS f32x4*)gf)[lane + 64 * jj];
  for (int t0 = gw; t0 < T; t0 += 2 * NGW) {
    i32x4 ti[2]; u32x2 hb_[2][4], p[2][4], q2[2][4];
#pragma unroll
    for (int u = 0; u < 2; ++u) { const int t = t0 + u * NGW; if (t < T) ti[u] = *(const GAS i32x4*)(tinfo + (size_t)t * 4); }
#pragma unroll
    for (int u = 0; u < 2; ++u) { const int t = t0 + u * NGW; if (t < T) {
      const int s1 = tab[32 + ti[u][0]] + ti[u][1], s2 = tab[32 + ti[u][2]] + ti[u][3];
      const GAS u32x2* hp = (const GAS u32x2*)((const bf16_t*)(a.ws + WS_HI) + (size_t)t * DM) + lane; const GAS u32x2* y1 = (const GAS u32x2*)(y + (size_t)s1 * DM) + lane; const GAS u32x2* y2 = (const GAS u32x2*)(y + (size_t)s2 * DM) + lane;
#pragma unroll
      for (int jj = 0; jj < 4; ++jj) { hb_[u][jj] = __builtin_nontemporal_load(hp + 64 * jj); p[u][jj] = __builtin_nontemporal_load(y1 + 64 * jj); q2[u][jj] = __builtin_nontemporal_load(y2 + 64 * jj); } } }
#pragma unroll
    for (int u = 0; u < 2; ++u) { const int t = t0 + u * NGW; if (t < T) {
      GAS f32x4* op = (GAS f32x4*)(outp + (size_t)t * DM) + lane;
      f32x4 v[4]; float s = 0.f;
#pragma unroll
      for (int jj = 0; jj < 4; ++jj) { const u32x2 hh = hb_[u][jj], pp = p[u][jj], qq = q2[u][jj];
        v[jj].x = bflo(hh.x) + bflo(pp.x) + bflo(qq.x); v[jj].y = bfhi(hh.x) + bfhi(pp.x) + bfhi(qq.x); v[jj].z = bflo(hh.y) + bflo(pp.y) + bflo(qq.y); v[jj].w = bfhi(hh.y) + bfhi(pp.y) + bfhi(qq.y);
        s += (v[jj].x * v[jj].x + v[jj].y * v[jj].y) + (v[jj].z * v[jj].z + v[jj].w * v[jj].w); }
      const float rstd = 1.f / sqrtf(wave_sum(s) * (1.f / DM) + 1e-6f);
#pragma unroll
      for (int jj = 0; jj < 4; ++jj) __builtin_nontemporal_store(v[jj] * rstd * gg[jj], op + 64 * jj); } } }
}
}
namespace mk {
#ifndef MK_STAGE
#define MK_STAGE 1
#endif
constexpr int N_PHASES = 11;

__global__ void __launch_bounds__(NTHR, 2) mk_fwd(Args args) {
  extern __shared__ __attribute__((aligned(16))) unsigned char lds_raw[];
  Frame F;
  F.lds = (LAS unsigned char*)lds_raw;
  F.MISC = (volatile LAS unsigned*)(F.lds + MISC_OFF);
  F.tid = threadIdx.x; F.lane = F.tid & 63; F.wave = __builtin_amdgcn_readfirstlane(F.tid >> 6);
  F.G = gridDim.x; { const int bx = blockIdx.x; F.vcu = (F.G % 8 == 0) ? (bx % 8) * (F.G / 8) + bx / 8 : bx; }
  unsigned char* ws = args.ws;
  gu32* ctl = (gu32*)(ws + WS_CTL);
  for (int u = F.tid; u < (LDS_BYTES - RING_BYTES) / 4; u += NTHR) ((LAS unsigned*)(F.lds + RING_BYTES))[u] = 0u;
  __syncthreads();
  constexpr unsigned CW_READY = 16, READY_MAGIC = 0x600DCAFEu;
  XcdBarrier bar; bar.bar = (unsigned*)(ctl + CW_BAR); bar.x = xb_xcc_id(); bar.st = F.MISC + 8;
  if (blockIdx.x == 0 && F.wave == 0) {
    if (F.lane < 16) { __hip_atomic_store(ctl + CW_BAR + XB_XCNT(F.lane), 0u, __ATOMIC_RELAXED, __HIP_MEMORY_SCOPE_AGENT); __hip_atomic_store(ctl + CW_BAR + XB_XSUB(F.lane), 0u, __ATOMIC_RELAXED, __HIP_MEMORY_SCOPE_AGENT);
      __hip_atomic_store(ctl + CW_BAR + XB_XGEN(F.lane), 0u, __ATOMIC_RELAXED, __HIP_MEMORY_SCOPE_AGENT); }
    if (F.lane < 32) __hip_atomic_store(ctl + CW_CNT + F.lane, 0u, __ATOMIC_RELAXED, __HIP_MEMORY_SCOPE_AGENT);
    if (F.lane == 32) __hip_atomic_store(ctl + CW_BAR + XB_TMO, 0u, __ATOMIC_RELAXED, __HIP_MEMORY_SCOPE_AGENT);
    if (F.lane == 33) __hip_atomic_store(ctl + CW_BAR + XB_TOP, 0u, __ATOMIC_RELAXED, __HIP_MEMORY_SCOPE_AGENT);
    if (F.lane == 34) __hip_atomic_store(ctl + CW_BAR + XB_TOPGEN, 0u, __ATOMIC_RELAXED, __HIP_MEMORY_SCOPE_AGENT);
    asm volatile("s_waitcnt vmcnt(0)" ::: "memory");
    if (F.lane == 0) __hip_atomic_store(ctl + CW_READY, READY_MAGIC, __ATOMIC_RELAXED, __HIP_MEMORY_SCOPE_AGENT);
  }
  const int lo = args.ph_lo, hi = args.ph_hi;
#ifndef MK_REPEAT_MASK
#define MK_REPEAT_MASK 0
#endif
#define REP(k) for (int rep_ = 0; rep_ < (((MK_REPEAT_MASK) >> (k)) & 1) + 1; ++rep_)
#define REP2(k, stmt) do { stmt; if (((MK_REPEAT_MASK) >> (k)) & 1) { asm volatile("" ::: "memory"); stmt; } } while (0)
#ifndef MK_PHASE_MASK
#define MK_PHASE_MASK 0xfff
#endif
#define IN(k) ((((MK_PHASE_MASK) >> (k)) & 1) && lo <= (k) && (k) < hi)
#define BOTH(k) (IN(k) && IN((k) + 1))
#define GRID_BAR() xcd_barrier(bar)
#define GRID_BAR_NA() xcd_barrier<false>(bar)

  if (IN(0)) { REP2(0, (p0_prologue<false>(F, args))); if (MK_STAGE >= 5) rt::build_wr(F.vcu * NTHR + F.tid, F.G * NTHR, args); }
  {
    if (F.tid == 0) { unsigned sp = 0; while (__hip_atomic_load(ctl + CW_READY, __ATOMIC_RELAXED, __HIP_MEMORY_SCOPE_AGENT) != READY_MAGIC) { __builtin_amdgcn_s_sleep(2); if (++sp > (1u << 24)) break; }
      (void)xb_add(&bar.bar[XB_XCNT(bar.x)], 1u); }
    __syncthreads(); }
  if (BOTH(0)) GRID_BAR_NA();

  if (IN(1)) {
    ProbPlain P; P.init(ws + WS_XN, ws + WS_WIN, T, NCOL, DM, F.G, (int)blockIdx.x);
    EpiInProj E{ws, (const float*)(ws + WS_ROPE), (const float*)(ws + WS_ROPE) + (size_t)T * 32, args.out};
    REP2(1, (gemm_phase<ProbPlain, EpiInProj, true>(F.lds, P, E)));
    if (BOTH(1)) GRID_BAR_NA();
  }
  if (IN(2)) {
    const int grp = F.vcu % 3;
    for (int u = F.vcu; u < 256; u += F.G) {
#pragma unroll 1
      for (int slot = 0; slot < 3; ++slot) {
        if (slot == grp && u == F.vcu && MK_STAGE >= 3) {
          for (int it = F.vcu; it < 256; it += F.G) { int tid_ = threadIdx.x; asm volatile("" : "+v"(tid_));
            const int bg_gw = F.vcu * NWAVES + F.wave, bg_ngw = F.G * NWAVES;
            hg::hgrn_item<false, 3>(tid_, it >> 6, (it >> 5) & 1, it & 31, ws, args.out + 8 * 1048576, args.out + 12 * 1048576, F.lds, (it == F.vcu) ? bg_gw : -1, bg_ngw, args.in[13], args.in[14], args.in[15]); }
          __syncthreads(); }
        if (slot == 0) { att2::attn_unit_a(u >> 6, u & 63, ws, args.out + (size_t)blockIdx.x * 32768, (LAS char*)F.lds); __syncthreads(); }
        if (slot == 1) { att2::attn_unit_b(u >> 6, u & 63, ws, args.in[5], args.out + (size_t)blockIdx.x * 32768, q8_base(ws), k8_base(args.out), v8_base(args.out), (LAS char*)F.lds); __syncthreads(); }
      }
    }
    if (BOTH(2)) GRID_BAR_NA();
  }
  if (IN(3)) { hg::hgrn_scan(F.vcu * NTHR + F.tid, F.G * NTHR, args.out + 8 * 1048576, args.out + 12 * 1048576); if (BOTH(3)) GRID_BAR(); }
  if (IN(4)) {
    REP(4) for (int it = F.vcu; it < 256; it += F.G) { int tid_ = threadIdx.x; asm volatile("" : "+v"(tid_));
      hg::hgrn_item<true, 0>(tid_, it >> 6, (it >> 5) & 1, it & 31, ws, args.out + 8 * 1048576, args.out + 12 * 1048576, F.lds, -1, 0, nullptr, nullptr, nullptr); }
    if (BOTH(4)) GRID_BAR_NA();
  }
  if (IN(5)) { REP(5) hg::hgrn_combine(F.vcu * NWAVES + F.wave, F.G * NWAVES, F.lane, ws, args.in[6]); if (BOTH(5)) GRID_BAR_NA(); }
  if (IN(6)) {
    ProbPlain P; P.init(ws + WS_XN, ws + WS_WOUT, T, DM, DM, F.G, (int)blockIdx.x);
    EpiOutProj E{args.in[0], (bf16_t*)(ws + WS_HI)};
    REP2(6, (gemm_phase<ProbPlain, EpiOutProj, true>(F.lds, P, E)));
    if (BOTH(6)) GRID_BAR();
  }
  if (IN(7)) { if ((MK_REPEAT_MASK >> 7) & 1) { rt::router_phase(F, args, ctl + CW_CNT, true); __syncthreads(); } rt::router_phase(F, args, ctl + CW_CNT); if (BOTH(7)) GRID_BAR(); }
  if (IN(8)) {
    moe_tables(F, ctl + CW_CNT);
    ProbMoE<false> P{DM / 2, (const char*)(ws + WS_XN), (const char*)(ws + WS_WGU), (const int*)(ws + rt::R_LIST), (const LAS int*)(F.lds + MOE_TAB), F.G, F.vcu, 0x7A7A7A7A, 0x7F7F7F7F};
    EpiGateUp E{(bf16_t*)(ws + WS_Q), (const float*)(ws + rt::R_CWL)};
    REP2(8, (gemm_phase<ProbMoE<false>, EpiGateUp, true>(F.lds, P, E)));
    if (BOTH(8)) GRID_BAR_NA();
  }
  if (IN(9)) {
    if (!IN(8)) moe_tables(F, ctl + CW_CNT);
    ProbMoE<true> P{FE / 2, (const char*)(ws + WS_Q), (const char*)(ws + WS_WD), (const int*)(ws + rt::R_LIST), (const LAS int*)(F.lds + MOE_TAB), F.G, F.vcu, 0x7A7A7A7A, 0x7B7B7B7B};
    EpiDown E{(bf16_t*)(ws + WS_V)};
    REP2(9, (gemm_phase<ProbMoE<true>, EpiDown, true>(F.lds, P, E)));
    if (BOTH(9)) GRID_BAR_NA();
  }
  if (IN(10)) { if (!IN(8) && !IN(9)) moe_tables(F, ctl + CW_CNT); if ((MK_REPEAT_MASK >> 10) & 1) { final_phase(F, args, (const bf16_t*)(ws + WS_V), (float*)(ws + WS_XN)); __syncthreads(); } final_phase(F, args, (const bf16_t*)(ws + WS_V), args.out); }
  if (blockIdx.x == 0 && F.tid == 0) __hip_atomic_store(ctl + CW_READY, 0u, __ATOMIC_RELAXED, __HIP_MEMORY_SCOPE_AGENT);
#undef IN
#undef BOTH
#undef GRID_BAR
#undef GRID_BAR_NA
}
}

extern "C" void kernel_launch(void* const* d_in, const int* in_sizes, int n_in, void* d_out, int out_size, void* d_ws, size_t ws_size, hipStream_t stream) {
  using namespace mk;
  static int grid = 0;
  if (grid == 0) {
    if (n_in != 17 || in_sizes[0] != T * DM || out_size != T * DM || ws_size < WS_END) { fprintf(stderr, "kernel_launch: unexpected shapes n_in %d out %d ws %zu (need %zu)\n", n_in, out_size, ws_size, (size_t)WS_END); grid = -1; return; }
    int dev = 0, cus = 0, per_cu = 0;
    if (hipGetDevice(&dev) != hipSuccess || hipDeviceGetAttribute(&cus, hipDeviceAttributeMultiprocessorCount, dev) != hipSuccess) { grid = -1; return; }
    if (hipFuncSetAttribute((const void*)mk_fwd, hipFuncAttributeMaxDynamicSharedMemorySize, LDS_BYTES) != hipSuccess) { fprintf(stderr, "kernel_launch: hipFuncSetAttribute failed\n"); grid = -1; return; }
    if (hipOccupancyMaxActiveBlocksPerMultiprocessor(&per_cu, (const void*)mk_fwd, NTHR, LDS_BYTES) != hipSuccess || per_cu < 1) { fprintf(stderr, "kernel_launch: occupancy query says %d blocks/CU\n", per_cu); per_cu = 1; }
    (void)hipGetLastError();
    if (cus != 256) { fprintf(stderr, "kernel_launch: built for a 256-CU device (work distribution of the fused phases), found %d CUs; nothing launched\n", cus); grid = -1; return; }
    grid = cus;
  }
  if (grid < 0) return;
  Args a{};
  for (int i = 0; i < 17; ++i) a.in[i] = (const float*)d_in[i];
  a.out = (float*)d_out; a.ws = (unsigned char*)d_ws;
  const int stage_hi[6] = {0, 2, 3, 6, 7, N_PHASES};
  a.ph_lo = 0; a.ph_hi = stage_hi[MK_STAGE];
  hipLaunchKernelGGL(mk_fwd, dim3(grid), dim3(NTHR), LDS_BYTES, stream, a);
#if MK_STAGE < 5
  { unsigned char* ws = (unsigned char*)d_ws; nv::Bufs b{};
    int* rt = (int*)(ws + WS_ROUTE);
    b.cnt = rt; b.off = rt + 64; b.tpos = rt + 1024; b.tcw = (float*)(rt + 1024 + 4 * T); b.cw = (float*)(rt + 1024 + 6 * T); b.list = rt + 1024 + 8 * T;
    b.scratch = (float*)d_out;
    b.Qb = (const unsigned short*)(ws + WS_Q); b.Kb = (const unsigned short*)(ws + WS_K); b.Vb = (const unsigned short*)(ws + WS_V);
    b.HQ = (const unsigned short*)(ws + WS_HQ); b.ZF = (const unsigned short*)(ws + WS_ZF); b.ZB = (const unsigned short*)(ws + WS_ZB); b.HI = (const unsigned short*)(ws + WS_HI); b.HG = (const unsigned short*)(ws + WS_HG);
    b.mixb = (unsigned short*)(ws + WS_XN);
    b.xt = (float*)(ws + WS_Q); b.hid = (float*)(ws + WS_Q + 64 * MiB);
    nv::run(d_in, (float*)d_out, b, MK_STAGE, stream); }
#endif
}
```
